# Optimizing an MI355X kernel written in HIP

```python
import math
import jax, jax.numpy as jnp
from jax import lax
import numpy as np

D_MODEL = 1024
BATCH = 2
SEQ = 16384
DEPTH = 4

CTX_LEN = 256
GRID_W = 64

F32 = jnp.float32
EPS = 1e-6

N_EVEN = (DEPTH + 1) // 2
N_ODD = DEPTH // 2

FFN_DIM = 2816

GDN_HEAD_DIM = 128
GDN_WIDTH = D_MODEL // 2
GDN_HEADS = GDN_WIDTH // GDN_HEAD_DIM
GDN_CONV = 5
GDN_CHUNK = 64

S5_WIDTH = D_MODEL - GDN_WIDTH
S5_GROUP = 16
S5_GROUPS = S5_WIDTH // S5_GROUP
S5_STATE = 64

CONV_WIDTH = D_MODEL // 2
CONV_K = 31

HGRN_KEY_DIM = 128
HGRN_VAL_DIM = 128
HGRN_HEADS = (D_MODEL - CONV_WIDTH) // HGRN_VAL_DIM
HGRN_KW = HGRN_HEADS * HGRN_KEY_DIM
HGRN_VW = HGRN_HEADS * HGRN_VAL_DIM
HGRN_CHUNK = 16

GDN_IN = 4 * GDN_WIDTH + 4 * GDN_HEADS
AB_IN = GDN_IN + S5_WIDTH
AB_OUT = GDN_WIDTH + S5_WIDTH
CONV_IN = 2 * CONV_WIDTH
CD_IN = CONV_IN + 3 * HGRN_KW + 2 * HGRN_VW
CD_OUT = CONV_WIDTH + HGRN_VW

kernel_name = "hybrid_gdn_s5_conformer_hgrn2_prefix_dit"


def rmsnorm(x, g):
    xf = x.astype(F32)
    y = xf * lax.rsqrt(jnp.mean(xf * xf, axis=-1, keepdims=True) + EPS)
    return (y * g.astype(F32)).astype(x.dtype)


def layernorm(x, g, b):
    xf = x.astype(F32)
    xc = xf - jnp.mean(xf, axis=-1, keepdims=True)
    y = xc * lax.rsqrt(jnp.mean(xc * xc, axis=-1, keepdims=True) + EPS)
    return (y * g.astype(F32) + b.astype(F32)).astype(x.dtype)


def l2norm(x):
    return x * lax.rsqrt(jnp.sum(x * x, axis=-1, keepdims=True) + EPS)


def ada_norm(x, g, mod, j):
    return rmsnorm(x, g) * (1.0 + mod[:, j, 1, None]) + mod[:, j, 0, None]


def swiglu(h, w_up, w_down):
    gt, up = jnp.split(h @ w_up, 2, axis=-1)
    return (jax.nn.silu(gt) * up) @ w_down


def to_heads(t, n_heads):
    b, L, w = t.shape
    return jnp.transpose(t.reshape(b, L, n_heads, w // n_heads), (0, 2, 1, 3))


def rev(t):
    return jnp.flip(t, axis=2)


def head_out_norm(o, gate, g):
    b, H, L, d = o.shape
    o = jnp.transpose(o, (0, 2, 1, 3))
    o = o * lax.rsqrt(jnp.mean(o * o, axis=-1, keepdims=True) + EPS) * g.astype(F32)
    o = o * jax.nn.silu(gate.astype(F32).reshape(b, L, H, d))
    return o.reshape(b, L, H * d).astype(gate.dtype)


def dwconv1d(x, w):
    k = w.shape[0]
    return lax.conv_general_dilated(x, w[:, None, :], (1,), [(k // 2, k // 2)],
                                    dimension_numbers=('NWC', 'WIO', 'NWC'),
                                    feature_group_count=x.shape[-1])


def axial_dwconv(x, w, rows):
    b, L, ch = x.shape
    half = ch // 2
    pad = w.shape[0] // 2
    img = x.reshape(b, rows, GRID_W, ch)
    dn = ('NHWC', 'HWIO', 'NHWC')
    xh = lax.conv_general_dilated(img[..., :half], w[None, :, None, :half], (1, 1),
                                  [(0, 0), (pad, pad)], dimension_numbers=dn,
                                  feature_group_count=half)
    xv = lax.conv_general_dilated(img[..., half:], w[:, None, None, half:], (1, 1),
                                  [(pad, pad), (0, 0)], dimension_numbers=dn,
                                  feature_group_count=ch - half)
    return jnp.concatenate([xh, xv], axis=-1).reshape(b, L, ch)


def gated_delta_chunks(q, k, v, log_a, beta, s0):
    b, h, L, dk = q.shape
    dv = v.shape[-1]
    c = GDN_CHUNK
    n = L // c
    q = q.reshape(b, h, n, c, dk)
    k = k.reshape(b, h, n, c, dk)
    v = v.reshape(b, h, n, c, dv)
    beta = beta.reshape(b, h, n, c)
    g = jnp.cumsum(log_a.reshape(b, h, n, c), axis=-1)
    pos = jnp.arange(c)
    incl = pos[:, None] >= pos[None, :]
    strict = pos[:, None] > pos[None, :]
    decay = jnp.where(incl, jnp.exp(jnp.where(incl, g[..., :, None] - g[..., None, :], 0.0)), 0.0)
    kk = jnp.einsum('bhntd,bhnjd->bhntj', k, k) * decay
    lhs = jnp.eye(c, dtype=F32) + jnp.where(strict, kk, 0.0) * beta[..., :, None]
    rhs = jnp.concatenate([v * beta[..., None], k * (beta * jnp.exp(g))[..., None]], axis=-1)
    sol = lax.linalg.triangular_solve(lhs, rhs, left_side=True, lower=True, unit_diagonal=True)
    u_t, w = sol[..., :dv], sol[..., dv:]
    qk = jnp.einsum('bhntd,bhnjd->bhntj', q, k) * decay
    q_dec = q * jnp.exp(g)[..., None]
    k_dec = k * jnp.exp(g[..., -1:] - g)[..., None]
    chunk_decay = jnp.exp(g[..., -1])

    def step(s, xs):
        u_c, w_c, qk_c, qd_c, kd_c, cd_c = xs
        u = u_c - jnp.einsum('bhcd,bhde->bhce', w_c, s)
        o = jnp.einsum('bhcd,bhde->bhce', qd_c, s) + jnp.einsum('bhtj,bhje->bhte', qk_c, u)
        s = s * cd_c[..., None, None] + jnp.einsum('bhcd,bhce->bhde', kd_c, u)
        return s, o

    xs = tuple(jnp.moveaxis(t, 2, 0) for t in (u_t, w, qk, q_dec, k_dec, chunk_decay))
    s_fin, o = lax.scan(step, s0, xs)
    return jnp.moveaxis(o, 0, 2).reshape(b, h, L, dv), s_fin


def gdn_prepare(p, conv_w, a_log, dt_bias):
    b, L, _ = p.shape
    W, H = GDN_WIDTH, GDN_HEADS
    qkv = jax.nn.silu(dwconv1d(p[..., :3 * W], conv_w)).astype(F32)
    q = l2norm(to_heads(qkv[..., :W], H)) * (GDN_HEAD_DIM ** -0.5)
    k = l2norm(to_heads(qkv[..., W:2 * W], H))
    v = to_heads(qkv[..., 2 * W:], H)
    z = p[..., 3 * W:4 * W]
    gates = p[..., 4 * W:].astype(F32).reshape(b, L, 4, H)
    log_a = -jnp.exp(a_log.astype(F32)) * jax.nn.softplus(gates[:, :, :2] + dt_bias.astype(F32))
    beta = jax.nn.sigmoid(gates[:, :, 2:])
    return q, k, v, jnp.transpose(log_a, (2, 0, 3, 1)), jnp.transpose(beta, (2, 0, 3, 1)), z


def gdn_mixer(p, pc, conv_w, a_log, dt_bias, norm_g, need_ctx):
    q, k, v, la, bt, z = gdn_prepare(p, conv_w, a_log, dt_bias)
    qc, kc, vc, lac, btc, zc = gdn_prepare(pc, conv_w, a_log, dt_bias)
    s0 = jnp.zeros(kc.shape[:2] + (GDN_HEAD_DIM, GDN_HEAD_DIM), F32)
    oc_f, sc_f = gated_delta_chunks(qc, kc, vc, lac[0], btc[0], s0)
    oc_b, sc_b = gated_delta_chunks(rev(qc), rev(kc), rev(vc), rev(lac[1]), rev(btc[1]), s0)
    o_f, _ = gated_delta_chunks(q, k, v, la[0], bt[0], sc_f)
    o_b, _ = gated_delta_chunks(rev(q), rev(k), rev(v), rev(la[1]), rev(bt[1]), sc_b)
    y = head_out_norm(o_f + rev(o_b), z, norm_g)
    yc = head_out_norm(oc_f + rev(oc_b), zc, norm_g) if need_ctx else None
    return y, yc


def s5_discretize(lam_re, lam_im, log_step, b_re, b_im):
    lr, li = lam_re.astype(F32), lam_im.astype(F32)
    step = jnp.exp(log_step.astype(F32))[:, None]
    mag = jnp.exp(lr * step)
    abr, abi = mag * jnp.cos(li * step), mag * jnp.sin(li * step)
    den = lr * lr + li * li
    nr, ni = abr - 1.0, abi
    cr = (nr * lr + ni * li) / den
    ci = (ni * lr - nr * li) / den
    br, bi = b_re.astype(F32), b_im.astype(F32)
    bbr = cr[..., None] * br - ci[..., None] * bi
    bbi = cr[..., None] * bi + ci[..., None] * br
    return abr, abi, bbr, bbi


def s5_combine(e1, e2):
    a1r, a1i, b1r, b1i = e1
    a2r, a2i, b2r, b2i = e2
    ar = a1r * a2r - a1i * a2i
    ai = a1r * a2i + a1i * a2r
    xr, xi = a2r[:, None], a2i[:, None]
    br = xr * b1r - xi * b1i + b2r
    bi = xr * b1i + xi * b1r + b2i
    return ar, ai, br, bi


def s5_direction(ug, disc, h0, c_re, c_im):
    abr, abi, bbr, bbi = disc
    h0r, h0i = h0
    bur = jnp.einsum('blgc,gpc->lbgp', ug, bbr)
    bui = jnp.einsum('blgc,gpc->lbgp', ug, bbi)
    bur = bur.at[0].add(abr * h0r - abi * h0i)
    bui = bui.at[0].add(abr * h0i + abi * h0r)
    L = ug.shape[1]
    ar = jnp.broadcast_to(abr, (L,) + abr.shape)
    ai = jnp.broadcast_to(abi, (L,) + abi.shape)
    _, _, hr, hi = lax.associative_scan(s5_combine, (ar, ai, bur, bui))
    y = jnp.einsum('lbgp,gcp->blgc', hr, c_re) - jnp.einsum('lbgp,gcp->blgc', hi, c_im)
    return y, (hr[-1], hi[-1])


def s5_readout(yg, u, d_skip, glu_w, glu_b):
    b, L, _ = u.shape
    y = yg.reshape(b, L, S5_WIDTH) + d_skip.astype(F32) * u.astype(F32)
    y = jax.nn.gelu(y)
    y = y * jax.nn.sigmoid(y @ glu_w.astype(F32) + glu_b.astype(F32))
    return y.astype(u.dtype)


def s5_mixer(u, uc, lam_re, lam_im, log_step, b_re, b_im, c_re, c_im, d_skip, glu_w, glu_b, need_ctx):
    disc_f = s5_discretize(lam_re[0], lam_im[0], log_step[0], b_re, b_im)
    disc_b = s5_discretize(lam_re[1], lam_im[1], log_step[1], b_re, b_im)
    cr, ci = c_re.astype(F32), c_im.astype(F32)
    ug = u.astype(F32).reshape(u.shape[0], u.shape[1], S5_GROUPS, S5_GROUP)
    ucg = uc.astype(F32).reshape(uc.shape[0], uc.shape[1], S5_GROUPS, S5_GROUP)
    h0 = jnp.zeros((u.shape[0], S5_GROUPS, S5_STATE), F32)
    yc_f, hc_f = s5_direction(ucg, disc_f, (h0, h0), cr, ci)
    yc_b, hc_b = s5_direction(jnp.flip(ucg, 1), disc_b, (h0, h0), cr, ci)
    y_f, _ = s5_direction(ug, disc_f, hc_f, cr, ci)
    y_b, _ = s5_direction(jnp.flip(ug, 1), disc_b, hc_b, cr, ci)
    y = s5_readout(y_f + jnp.flip(y_b, 1), u, d_skip, glu_w, glu_b)
    yc = s5_readout(yc_f + jnp.flip(yc_b, 1), uc, d_skip, glu_w, glu_b) if need_ctx else None
    return y, yc


def mixer_ab(hn, hcn, w_in, w_out, conv_w, a_log, dt_bias, gdn_g, lam_re, lam_im, log_step,
             b_re, b_im, c_re, c_im, d_skip, glu_w, glu_b, need_ctx):
    p = hn @ w_in
    pc = hcn @ w_in
    a_l, a_c = gdn_mixer(p[..., :GDN_IN], pc[..., :GDN_IN], conv_w, a_log, dt_bias, gdn_g, need_ctx)
    b_l, b_c = s5_mixer(p[..., GDN_IN:], pc[..., GDN_IN:], lam_re, lam_im, log_step, b_re, b_im,
                        c_re, c_im, d_skip, glu_w, glu_b, need_ctx)
    y = jnp.concatenate([a_l, b_l], axis=-1) @ w_out
    yc = jnp.concatenate([a_c, b_c], axis=-1) @ w_out if need_ctx else None
    return y, yc


def conformer_conv(p, dw_w, dw_b, ln_g, ln_b, rows):
    a, gt = jnp.split(p, 2, axis=-1)
    x = a * jax.nn.sigmoid(gt)
    x = axial_dwconv(x, dw_w, rows) if rows > 0 else dwconv1d(x, dw_w)
    x = layernorm(x + dw_b, ln_g, ln_b)
    return jax.nn.silu(x)


def gla_chunks(q, k, v, log_f, s0):
    b, h, L, dk = q.shape
    dv = v.shape[-1]
    c = HGRN_CHUNK
    n = L // c
    q, k, log_f = (t.reshape(b, h, n, c, dk) for t in (q, k, log_f))
    v = v.reshape(b, h, n, c, dv)
    bc = jnp.cumsum(log_f, axis=3)
    q_in = q * jnp.exp(bc)
    k_in = k * jnp.exp(-bc)
    pos = jnp.arange(c)
    incl = pos[:, None] >= pos[None, :]
    attn = jnp.where(incl, jnp.einsum('bhntd,bhnjd->bhntj', q_in, k_in), 0.0)
    o_intra = jnp.einsum('bhntj,bhnje->bhnte', attn, v)
    k_out = k * jnp.exp(bc[..., -1:, :] - bc)
    chunk_decay = jnp.exp(bc[..., -1, :])

    def step(s, xs):
        qi, oi, ko, vc, cd = xs
        o = jnp.einsum('bhcd,bhde->bhce', qi, s) + oi
        s = s * cd[..., None] + jnp.einsum('bhcd,bhce->bhde', ko, vc)
        return s, o

    xs = tuple(jnp.moveaxis(t, 2, 0) for t in (q_in, o_intra, k_out, v, chunk_decay))
    s_fin, o = lax.scan(step, s0, xs)
    return jnp.moveaxis(o, 0, 2).reshape(b, h, L, dv), s_fin


def hgrn_prepare(p, lb):
    b, L, _ = p.shape
    H, KW = HGRN_HEADS, HGRN_KW
    pf = p.astype(F32)
    q = to_heads(pf[..., :KW], H)
    f = lb + (1.0 - lb) * jax.nn.sigmoid(pf[..., KW:3 * KW].reshape(b, L, 2, KW))
    f = jnp.transpose(f.reshape(b, L, 2, H, HGRN_KEY_DIM), (2, 0, 3, 1, 4))
    i = to_heads(pf[..., 3 * KW:3 * KW + HGRN_VW], H)
    g = p[..., 3 * KW + HGRN_VW:]
    return q, 1.0 - f, jnp.log(f), i, g


def hgrn2_mixer(p, pc, lb, norm_g, need_ctx):
    q, k, lf, i, g = hgrn_prepare(p, lb)
    qc, kc, lfc, ic, gc = hgrn_prepare(pc, lb)
    s0 = jnp.zeros(qc.shape[:2] + (HGRN_KEY_DIM, HGRN_VAL_DIM), F32)
    oc_f, sc_f = gla_chunks(qc, kc[0], ic, lfc[0], s0)
    oc_b, sc_b = gla_chunks(rev(qc), rev(kc[1]), rev(ic), rev(lfc[1]), s0)
    o_f, _ = gla_chunks(q, k[0], i, lf[0], sc_f)
    o_b, _ = gla_chunks(rev(q), rev(k[1]), rev(i), rev(lf[1]), sc_b)
    y = head_out_norm(o_f + rev(o_b), g, norm_g)
    yc = head_out_norm(oc_f + rev(oc_b), gc, norm_g) if need_ctx else None
    return y, yc


def mixer_cd(hn, hcn, rows, w_in, w_out, dw_w, dw_b, ln_g, ln_b, lb, hgrn_g, need_ctx):
    p = hn @ w_in
    pc = hcn @ w_in
    c_l = conformer_conv(p[..., :CONV_IN], dw_w, dw_b, ln_g, ln_b, rows)
    d_l, d_c = hgrn2_mixer(p[..., CONV_IN:], pc[..., CONV_IN:], lb, hgrn_g, need_ctx)
    y = jnp.concatenate([c_l, d_l], axis=-1) @ w_out
    if need_ctx:
        c_c = conformer_conv(pc[..., :CONV_IN], dw_w, dw_b, ln_g, ln_b, 0)
        yc = jnp.concatenate([c_c, d_c], axis=-1) @ w_out
    else:
        yc = None
    return y, yc


def setup_inputs(seed: int = 0) -> dict:
    key = jax.random.key(seed)
    ks = iter(jax.random.split(key, 64))

    def nrm(shape, scale):
        return jax.random.normal(next(ks), shape, F32) * scale

    def unif(shape, lo, hi):
        return jax.random.uniform(next(ks), shape, F32, lo, hi)

    D, NE, NO = D_MODEL, N_EVEN, N_ODD
    dt = jnp.exp(unif((NE, 2, GDN_HEADS), math.log(1e-3), math.log(1e-1)))
    return {
        "x": nrm((BATCH, SEQ, D), 1.0),
        "c": nrm((BATCH, D), 1.0),
        "ctx": nrm((BATCH, CTX_LEN, D), 1.0),
        "c_ctx": nrm((D,), 1.0),
        "ada_w": nrm((DEPTH, D, 9 * D), 0.5 * D ** -0.5),
        "ada_b": nrm((DEPTH, 9 * D), 0.02),
        "norm_g": 1.0 + nrm((DEPTH, 3, D), 0.02),
        "ffn_w_up": nrm((DEPTH, 2, D, 2 * FFN_DIM), D ** -0.5),
        "ffn_w_down": nrm((DEPTH, 2, FFN_DIM, D), FFN_DIM ** -0.5),
        "ab_w_in": nrm((NE, D, AB_IN), D ** -0.5),
        "ab_w_out": nrm((NE, AB_OUT, D), AB_OUT ** -0.5),
        "gdn_conv_w": nrm((NE, GDN_CONV, 3 * GDN_WIDTH), GDN_CONV ** -0.5),
        "gdn_a_log": jnp.log(unif((NE, 2, GDN_HEADS), 1.0, 16.0)),
        "gdn_dt_bias": dt + jnp.log(-jnp.expm1(-dt)),
        "gdn_norm_g": 1.0 + nrm((NE, GDN_HEAD_DIM), 0.02),
        "s5_lambda_re": -0.5 + nrm((NE, 2, S5_GROUPS, S5_STATE), 0.01),
        "s5_lambda_im": math.pi * jnp.arange(S5_STATE, dtype=F32) + nrm((NE, 2, S5_GROUPS, S5_STATE), 0.01),
        "s5_log_step": unif((NE, 2, S5_GROUPS), math.log(1e-3), math.log(1e-1)),
        "s5_b_re": nrm((NE, S5_GROUPS, S5_STATE, S5_GROUP), (2 * S5_GROUP) ** -0.5),
        "s5_b_im": nrm((NE, S5_GROUPS, S5_STATE, S5_GROUP), (2 * S5_GROUP) ** -0.5),
        "s5_c_re": nrm((NE, S5_GROUPS, S5_GROUP, S5_STATE), S5_STATE ** -0.5),
        "s5_c_im": nrm((NE, S5_GROUPS, S5_GROUP, S5_STATE), S5_STATE ** -0.5),
        "s5_d": nrm((NE, S5_WIDTH), 1.0),
        "s5_glu_w": nrm((NE, S5_WIDTH, S5_WIDTH), S5_WIDTH ** -0.5),
        "s5_glu_b": nrm((NE, S5_WIDTH), 0.01),
        "cd_w_in": nrm((NO, D, CD_IN), D ** -0.5),
        "cd_w_out": nrm((NO, CD_OUT, D), CD_OUT ** -0.5),
        "conv_dw_w": nrm((NO, CONV_K, CONV_WIDTH), CONV_K ** -0.5),
        "conv_dw_b": nrm((NO, CONV_WIDTH), 0.01),
        "conv_ln_g": 1.0 + nrm((NO, CONV_WIDTH), 0.02),
        "conv_ln_b": nrm((NO, CONV_WIDTH), 0.01),
        "hgrn_lb_logits": nrm((NO + 1, HGRN_KW), 0.1),
        "hgrn_norm_g": 1.0 + nrm((NO, HGRN_VAL_DIM), 0.02),
        "final_norm_g": 1.0 + nrm((D,), 0.02),
    }


def reference(x, c, ctx, c_ctx, ada_w, ada_b, norm_g, ffn_w_up, ffn_w_down,
              ab_w_in, ab_w_out, gdn_conv_w, gdn_a_log, gdn_dt_bias, gdn_norm_g,
              s5_lambda_re, s5_lambda_im, s5_log_step, s5_b_re, s5_b_im, s5_c_re, s5_c_im,
              s5_d, s5_glu_w, s5_glu_b,
              cd_w_in, cd_w_out, conv_dw_w, conv_dw_b, conv_ln_g, conv_ln_b,
              hgrn_lb_logits, hgrn_norm_g, final_norm_g):
    rows = x.shape[1] // GRID_W
    sc = jax.nn.silu(c)
    scc = jax.nn.silu(c_ctx)[None]
    lb_all = jnp.cumsum(jax.nn.softmax(hgrn_lb_logits.astype(F32), axis=0), axis=0)
    h, hc = x, ctx
    for l in range(DEPTH):
        last = l == DEPTH - 1
        m = (sc @ ada_w[l] + ada_b[l]).reshape(-1, 3, 3, D_MODEL)
        mc = (scc @ ada_w[l] + ada_b[l]).reshape(-1, 3, 3, D_MODEL)
        h = h + 0.5 * m[:, 0, 2, None] * swiglu(ada_norm(h, norm_g[l, 0], m, 0), ffn_w_up[l, 0], ffn_w_down[l, 0])
        hc = hc + 0.5 * mc[:, 0, 2, None] * swiglu(ada_norm(hc, norm_g[l, 0], mc, 0), ffn_w_up[l, 0], ffn_w_down[l, 0])
        hn = ada_norm(h, norm_g[l, 1], m, 1)
        hcn = ada_norm(hc, norm_g[l, 1], mc, 1)
        if l % 2 == 0:
            e = l // 2
            y, yc = mixer_ab(hn, hcn, ab_w_in[e], ab_w_out[e], gdn_conv_w[e], gdn_a_log[e], gdn_dt_bias[e],
                             gdn_norm_g[e], s5_lambda_re[e], s5_lambda_im[e], s5_log_step[e], s5_b_re[e],
                             s5_b_im[e], s5_c_re[e], s5_c_im[e], s5_d[e], s5_glu_w[e], s5_glu_b[e], not last)
        else:
            o = l // 2
            y, yc = mixer_cd(hn, hcn, rows, cd_w_in[o], cd_w_out[o], conv_dw_w[o], conv_dw_b[o],
                             conv_ln_g[o], conv_ln_b[o], lb_all[o], hgrn_norm_g[o], not last)
        h = h + m[:, 1, 2, None] * y
        h = h + 0.5 * m[:, 2, 2, None] * swiglu(ada_norm(h, norm_g[l, 2], m, 2), ffn_w_up[l, 1], ffn_w_down[l, 1])
        if not last:
            hc = hc + mc[:, 1, 2, None] * yc
            hc = hc + 0.5 * mc[:, 2, 2, None] * swiglu(ada_norm(hc, norm_g[l, 2], mc, 2), ffn_w_up[l, 1], ffn_w_down[l, 1])
    return rmsnorm(h, final_norm_g)
```

```cpp
#include <hip/hip_runtime.h>
#include <hip/hip_cooperative_groups.h>
#include <cstdio>
#include <cstring>
namespace cg = cooperative_groups;

#define DEV __device__ __forceinline__
typedef unsigned short bf16_t;

constexpr int D = 1024, SEQ = 16384, CTXL = 256, NB = 2;
constexpr int NLAT = NB * SEQ;
constexpr int NTOK = NLAT + NB * CTXL;
constexpr int FFN = 2816;
constexpr int ABN = 2816;
constexpr int ABIN = 2576;
constexpr int CDN = 3584;
constexpr int MODW = 9216;
constexpr int NCH = 260;
constexpr int NBC = 65;

constexpr size_t SZ_WUP = (size_t)2 * FFN * D * 2, SZ_WDN = (size_t)D * FFN * 2;
constexpr size_t OFF_WUP = 0;
constexpr size_t OFF_WDN = OFF_WUP + 8 * SZ_WUP;
constexpr size_t OFF_WABIN = OFF_WDN + 8 * SZ_WDN;
constexpr size_t OFF_WCDIN = OFF_WABIN + (size_t)2 * ABN * D * 2;
constexpr size_t OFF_WABOUT = OFF_WCDIN + (size_t)2 * CDN * D * 2;
constexpr size_t OFF_WCDOUT = OFF_WABOUT + (size_t)2 * D * D * 2;
constexpr size_t OFF_WGLU = OFF_WCDOUT + (size_t)2 * D * D * 2;
constexpr size_t OFF_MOD = OFF_WGLU + (size_t)2 * 512 * 512 * 2;
constexpr size_t OFF_LB = OFF_MOD + (size_t)4 * 3 * MODW * 4;
constexpr size_t OFF_H = OFF_LB + 8192;
constexpr size_t OFF_HN = OFF_H + (size_t)NTOK * D * 4;
constexpr size_t OFF_P = OFF_HN + (size_t)NTOK * D * 2;
constexpr size_t SZ_PAB = (size_t)NTOK * ABN * 2;
constexpr size_t OFF_QN = OFF_P + SZ_PAB;
constexpr size_t OFF_KN = OFF_QN + (size_t)NTOK * 512 * 2;
constexpr size_t SZ_PREG = SZ_PAB + (size_t)2 * NTOK * 512 * 2;
constexpr size_t OFF_SCR = OFF_P + SZ_PREG;
constexpr size_t SCR_T = 0, SCR_QK = (size_t)4160 * 4096 * 2, SCR_GB = 2 * SCR_QK;
constexpr size_t SCR_YB = 0, SCR_CARRY = (size_t)NTOK * 512 * 2;
constexpr size_t SCR_DS = 0, SCR_DD = (size_t)1040 * 16384 * 4;
constexpr size_t SZ_SCR = (size_t)72 * 1024 * 1024;
constexpr size_t WS_NEED = OFF_SCR + SZ_SCR;
static_assert((size_t)2 * NTOK * 512 * 2 <= (size_t)NLAT * D * 4, "o scratch must fit in d_out");
static_assert(SCR_GB + (size_t)4160 * 128 * 4 <= SZ_SCR, "scr");
static_assert(SCR_CARRY + (size_t)128 * 260 * 128 * 4 <= SZ_SCR, "scr");
static_assert(SCR_DD + (size_t)1040 * 128 * 4 <= SZ_SCR, "scr");
static_assert(WS_NEED <= (size_t)737 * 1000 * 1000, "ws");

struct Params { const float* in[34]; float* out; char* ws; int nsteps; int steps[127]; };
enum { I_X = 0, I_C, I_CTX, I_CCTX, I_ADAW, I_ADAB, I_NORMG, I_WUP, I_WDN, I_ABIN, I_ABOUT, I_GCONV, I_GALOG, I_GDT, I_GNG,
       I_LRE, I_LIM, I_LSTEP, I_BRE, I_BIM, I_CRE, I_CIM, I_S5D, I_GLUW, I_GLUB, I_CDIN, I_CDOUT, I_DWW, I_DWB, I_LNG, I_LNB, I_LB, I_HNG, I_FNG };
enum { PH_INIT = 0, PH_NORM, PH_UP, PH_DOWN, PH_ABIN, PH_CDIN, PH_OUT, PH_S1, PH_S2, PH_S3, PH_GLU, PH_G1, PH_G2, PH_G3, PH_CH1, PH_H2, PH_H3, PH_H4, PH_FINAL };

DEV int TID() { int t = threadIdx.x; asm volatile("" : "+v"(t)); return t; }
DEV float bf2f(bf16_t b) { return __uint_as_float(((unsigned)b) << 16); }
DEV bf16_t f2bf(float f) { unsigned u = __float_as_uint(f); u += 0x7FFFu + ((u >> 16) & 1u); return (bf16_t)(u >> 16); }
DEV unsigned pack2(float lo, float hi) { return (unsigned)f2bf(lo) | ((unsigned)f2bf(hi) << 16); }
DEV float sigm(float x) { return 1.f / (1.f + __expf(-x)); }
DEV float silu(float x) { return x / (1.f + __expf(-x)); }
DEV float wave_sum(float v) {
#pragma unroll
    for (int o = 32; o > 0; o >>= 1) v += __shfl_xor(v, o, 64);
    return v;
}
DEV int mod_row(int row) { return row < NLAT ? (row >> 14) : 2; }

namespace pg8 {
#define PG8_LAS __attribute__((address_space(3)))
typedef unsigned short bf16_t;
typedef short bf16x8 __attribute__((ext_vector_type(8)));
typedef float f32x4 __attribute__((ext_vector_type(4)));
typedef unsigned u32x4 __attribute__((ext_vector_type(4)));
constexpr int BM = 256, BK = 64, HALF = 128, HTB = HALF * BK * 2  , STAGE_BYTES = 8 * HTB, NXCD = 8, WGM = 8;

__host__ __device__ __forceinline__ int lds_byte(int r, int c) { const int st = (r >> 4) * 2 + (c >> 5), rr = r & 15, cc = c & 31, ob = rr * 64 + cc * 2; return st * 1024 + (ob ^ (((ob >> 9) & 1) << 5)); }
__host__ __device__ __forceinline__ void stage_rc(int b, int& R, int& C) { const int st = b / 1024, sb = b % 1024, swz = sb ^ (((sb >> 9) & 1) << 5); R = (st >> 1) * 16 + swz / 64; C = (st & 1) * 32 + (swz % 64) / 2; }
__host__ __device__ __forceinline__ int perm32(int rho) { const int n = rho >> 4, i = rho & 15; return 8 * (i >> 2) + 4 * n + (i & 3); }

struct Unit { int pm, pn; };
struct Gemm { const bf16_t* A; const bf16_t* Bt; int M, N, K; };
struct StaticOrder {
    int nM, nN, nwg, G, c;
    __host__ __device__ void init(int M, int N, int G_, int c_) { nM = M / BM; nN = N / BM; nwg = nM * nN; G = G_; c = c_; }
    __host__ __device__ bool next(int i, Unit& u) const {
        const long L = (long)i * G + c; if (L >= nwg) return false;
        int wgid = (int)L; { const int q = nwg / NXCD, r = nwg % NXCD, xcd = wgid % NXCD, off = wgid / NXCD; wgid = (xcd < r ? xcd * (q + 1) : r * (q + 1) + (xcd - r) * q) + off; }
        const int nig = WGM * nN, gid = wgid / nig, fm = gid * WGM, gsz = (nM - fm) < WGM ? (nM - fm) : WGM;
        u.pm = fm + ((wgid % nig) % gsz); u.pn = (wgid % nig) / gsz; return true;
    }
    __device__ __forceinline__ void a_ready(const Unit&) const {}
    __device__ __forceinline__ void done(const Unit&) const {}
};
__device__ __forceinline__ unsigned cvt_pk_bf16(float lo, float hi) { unsigned r; asm volatile("v_cvt_pk_bf16_f32 %0, %1, %2" : "=v"(r) : "v"(lo), "v"(hi)); return r; }
template <class Epi, class Sched, bool STAMP = false>
__device__ __forceinline__ void gemm_phase(PG8_LAS unsigned char* lds, const Gemm g, const Sched& S, const Epi& E, unsigned long long* stamps) {
    const int tid = TID(), wid = __builtin_amdgcn_readfirstlane(tid >> 6), lane = tid & 63, wr = wid >> 2, wc = wid & 3, fr = lane & 15, fq = lane >> 4;
    const int K = g.K, nt = K / BK;
    int ts_lo = 0, ts_hi = 0, nts = 0; const unsigned long long rt_entry = STAMP ? (unsigned long long)wall_clock64() : 0ull;
#define PG8_STAMP() do { if (STAMP && wid == 0 && nts < 64) { const unsigned long long _c = (unsigned long long)clock64(); \
        ts_lo = (lane == nts) ? (int)(unsigned)_c : ts_lo; ts_hi = (lane == nts) ? (int)(unsigned)(_c >> 32) : ts_hi; ++nts; } } while (0)
    PG8_STAMP();
    unsigned voffA[2], voffB[2];
#pragma unroll
    for (int i = 0; i < 2; ++i) { int R, C; stage_rc(tid * 16 + i * 8192, R, C); const int Rb = Epi::PERM ? ((R & ~31) + perm32(R & 31)) : R;
        voffA[i] = (unsigned)(R * K + C) * 2u; voffB[i] = (unsigned)(Rb * K + C) * 2u; }
    const size_t kstep = (size_t)(BK * 2);
    const size_t hstep = (size_t)HALF * K * 2;
    const size_t tstep = 2 * hstep;
    const unsigned ldsw = (unsigned)wid * 1024u;
    const int aoff = lds_byte(wr * 64 + fr, fq * 8), boff = lds_byte(wc * 32 + fr, fq * 8);
#define PG8_SA(b, h) (((b) * 2 + (h)) * HTB)
#define PG8_SB(b, h) ((4 + (b) * 2 + (h)) * HTB)
#define PG8_STAGE(bufoff, gbase, voff) do { _Pragma("unroll") for (int _i = 0; _i < 2; ++_i) \
        __builtin_amdgcn_global_load_lds((const unsigned*)((const char*)(gbase) + (voff)[_i]), (PG8_LAS unsigned*)(lds + (bufoff) + ldsw + _i * 8192), 16, 0, 0); } while (0)
#define PG8_LDA(dst, b, h) do { _Pragma("unroll") for (int m = 0; m < 4; ++m) _Pragma("unroll") for (int k = 0; k < 2; ++k) dst[m][k] = *(const PG8_LAS bf16x8*)(lds + PG8_SA(b, h) + aoff + m * 2048 + k * 1024); } while (0)
#define PG8_LDB(dst, b, h) do { _Pragma("unroll") for (int n = 0; n < 2; ++n) _Pragma("unroll") for (int k = 0; k < 2; ++k) dst[n][k] = *(const PG8_LAS bf16x8*)(lds + PG8_SB(b, h) + boff + n * 2048 + k * 1024); } while (0)
#define PG8_MMA(ai, bj, At, Bt) do { __builtin_amdgcn_s_setprio(1); _Pragma("unroll") for (int m = 0; m < 4; ++m) _Pragma("unroll") for (int n = 0; n < 2; ++n) _Pragma("unroll") for (int k = 0; k < 2; ++k) \
        acc[ai][bj][m][n] = __builtin_amdgcn_mfma_f32_16x16x32_bf16(Bt[n][k], At[m][k], acc[ai][bj][m][n], 0, 0, 0); __builtin_amdgcn_s_setprio(0); } while (0)
#define PG8_WAIT_V(n) asm volatile("s_waitcnt vmcnt(" #n ")" ::: "memory")
#define PG8_WAIT_L(n) asm volatile("s_waitcnt lgkmcnt(" #n ")" ::: "memory")
#define PG8_BAR __builtin_amdgcn_s_barrier()
#define PG8_SCHED __builtin_amdgcn_sched_barrier(0)
    Unit cur, nxt; int ui = 0;
    if (!S.next(0, cur)) return;
    f32x4 acc[2][2][4][2];
#pragma unroll
    for (int a = 0; a < 2; ++a)
#pragma unroll
        for (int b = 0; b < 2; ++b)
#pragma unroll
            for (int m = 0; m < 4; ++m)
#pragma unroll
                for (int n = 0; n < 2; ++n) acc[a][b][m][n] = (f32x4){0.f, 0.f, 0.f, 0.f};
    bf16x8 At[4][2], B0[2][2], B1[2][2];
    const char* cA = (const char*)g.A + (size_t)cur.pm * tstep; const char* cB = (const char*)g.Bt + (size_t)cur.pn * tstep;
    S.a_ready(cur);
    PG8_STAGE(PG8_SB(0, 0), cB, voffB); PG8_STAGE(PG8_SA(0, 0), cA, voffA); PG8_STAGE(PG8_SB(0, 1), cB + hstep, voffB); PG8_STAGE(PG8_SA(0, 1), cA + hstep, voffA);
    if (wr == 1) PG8_BAR;
    PG8_WAIT_V(4); PG8_BAR;
    PG8_STAGE(PG8_SB(1, 0), cB + kstep, voffB); PG8_STAGE(PG8_SA(1, 0), cA + kstep, voffA); PG8_STAGE(PG8_SB(1, 1), cB + hstep + kstep, voffB);
    PG8_WAIT_V(6); PG8_BAR;
    PG8_STAMP();
    for (;;) {
        const bool has_next = S.next(ui + 1, nxt);
        const char* nA = has_next ? (const char*)g.A + (size_t)nxt.pm * tstep : cA; const char* nB = has_next ? (const char*)g.Bt + (size_t)nxt.pn * tstep : cB;
        for (int t = 0; t < nt; t += 2) {
            const bool last = (t == nt - 2);
            const char* a1 = cA + (size_t)(t + 1) * kstep;
            const char* a2 = last ? nA : cA + (size_t)(t + 2) * kstep; const char* b2 = last ? nB : cB + (size_t)(t + 2) * kstep;
            const char* a3 = a2 + kstep; const char* b3 = b2 + kstep;
            if (last && has_next) S.a_ready(nxt);
            PG8_LDB(B0, 0, 0); PG8_SCHED; PG8_LDA(At, 0, 0); PG8_STAGE(PG8_SA(1, 1), a1 + hstep, voffA);
            PG8_WAIT_L(8); PG8_BAR; PG8_WAIT_L(0); PG8_MMA(0, 0, At, B0); PG8_BAR; PG8_SCHED;
            PG8_LDB(B1, 0, 1); PG8_STAGE(PG8_SB(0, 0), b2, voffB);
            PG8_BAR; PG8_WAIT_L(0); PG8_MMA(0, 1, At, B1); PG8_BAR;
            PG8_LDA(At, 0, 1); PG8_STAGE(PG8_SA(0, 0), a2, voffA);
            PG8_BAR; PG8_WAIT_L(0); PG8_MMA(1, 0, At, B0); PG8_BAR; PG8_SCHED;
            PG8_STAGE(PG8_SB(0, 1), b2 + hstep, voffB);
            PG8_WAIT_V(6); PG8_BAR; PG8_MMA(1, 1, At, B1); PG8_BAR;
            PG8_LDB(B0, 1, 0); PG8_SCHED; PG8_LDA(At, 1, 0); PG8_STAGE(PG8_SA(0, 1), a2 + hstep, voffA);
            PG8_WAIT_L(8); PG8_BAR; PG8_WAIT_L(0); PG8_MMA(0, 0, At, B0); PG8_BAR; PG8_SCHED;
            PG8_LDB(B1, 1, 1); PG8_STAGE(PG8_SB(1, 0), b3, voffB);
            PG8_BAR; PG8_WAIT_L(0); PG8_MMA(0, 1, At, B1); PG8_BAR;
            PG8_LDA(At, 1, 1); PG8_STAGE(PG8_SA(1, 0), a3, voffA);
            PG8_BAR; PG8_WAIT_L(0); PG8_MMA(1, 0, At, B0); PG8_BAR; PG8_SCHED;
            PG8_STAGE(PG8_SB(1, 1), b3 + hstep, voffB);
            PG8_WAIT_V(6); PG8_BAR; PG8_MMA(1, 1, At, B1); PG8_BAR;
        }
        PG8_STAMP();
        if constexpr (!Epi::AFTER_DRAIN) { E(acc, cur, wr, wc, fr, fq); S.done(cur); }
        PG8_STAMP();
        if (!has_next) break;
#pragma unroll
        for (int a = 0; a < 2; ++a)
#pragma unroll
            for (int b = 0; b < 2; ++b)
#pragma unroll
                for (int m = 0; m < 4; ++m)
#pragma unroll
                    for (int n = 0; n < 2; ++n) acc[a][b][m][n] = (f32x4){0.f, 0.f, 0.f, 0.f};
        cur = nxt; cA = nA; cB = nB; ++ui;
    }
    PG8_WAIT_V(0);
    if (wr == 0) PG8_BAR;
    PG8_BAR;
    if constexpr (Epi::AFTER_DRAIN) { E.fused(acc, cur, wr, wc, fr, fq, lds, wid, lane); S.done(cur); }
    PG8_STAMP();
    if (STAMP && wid == 0) { stamps[lane] = lane < nts ? (((unsigned long long)(unsigned)ts_hi << 32) | (unsigned)ts_lo) : 0ull;
        if (lane == 62) stamps[62] = rt_entry; if (lane == 63) stamps[63] = (unsigned long long)wall_clock64(); }
#undef PG8_STAMP
#undef PG8_SA
#undef PG8_SB
#undef PG8_STAGE
#undef PG8_LDA
#undef PG8_LDB
#undef PG8_MMA
#undef PG8_WAIT_V
#undef PG8_WAIT_L
#undef PG8_BAR
#undef PG8_SCHED
}
}

using pg8::f32x4; using pg8::u32x4; using pg8::Unit; using pg8::cvt_pk_bf16;
typedef unsigned u32x2 __attribute__((ext_vector_type(2)));

struct EpiUp {
    static constexpr bool PERM = true, AFTER_DRAIN = false;
    bf16_t* O;
    DEV void operator()(const f32x4 (&acc)[2][2][4][2], const Unit& u, int wr, int wc, int fr, int fq) const {
        const int row0 = u.pm * 256 + wr * 64 + fr, vcol0 = u.pn * 256 + wc * 32 + 8 * fq;
#pragma unroll
        for (int ai = 0; ai < 2; ++ai)
#pragma unroll
            for (int m = 0; m < 4; ++m) {
                bf16_t* rowp = O + (size_t)(row0 + ai * 128 + m * 16) * FFN;
#pragma unroll
                for (int bj = 0; bj < 2; ++bj) {
                    const f32x4 g = acc[ai][bj][m][0], v = acc[ai][bj][m][1];
                    u32x2 w; w.x = cvt_pk_bf16(silu(g[0]) * v[0], silu(g[1]) * v[1]); w.y = cvt_pk_bf16(silu(g[2]) * v[2], silu(g[3]) * v[3]);
                    *(u32x2*)(rowp + ((vcol0 + bj * 128) >> 1)) = w;
                }
            }
    }
};
struct EpiRes {
    static constexpr bool PERM = false, AFTER_DRAIN = false;
    float* H; const float* gate; float scale;
    DEV void operator()(const f32x4 (&acc)[2][2][4][2], const Unit& u, int wr, int wc, int fr, int fq) const {
        const int row0 = u.pm * 256 + wr * 64 + fr, col0 = u.pn * 256 + wc * 32 + 4 * fq;
        const int r = u.pm < 64 ? 0 : (u.pm < 128 ? 1 : 2);
        f32x4 gv[2][2];
#pragma unroll
        for (int bj = 0; bj < 2; ++bj)
#pragma unroll
            for (int n = 0; n < 2; ++n) gv[bj][n] = *(const f32x4*)(gate + (size_t)r * MODW + col0 + bj * 128 + n * 16) * scale;
#pragma unroll
        for (int ai = 0; ai < 2; ++ai)
#pragma unroll
            for (int m = 0; m < 4; ++m) {
                float* rowp = H + (size_t)(row0 + ai * 128 + m * 16) * D + col0;
#pragma unroll
                for (int bj = 0; bj < 2; ++bj)
#pragma unroll
                    for (int n = 0; n < 2; ++n) { f32x4* q = (f32x4*)(rowp + bj * 128 + n * 16); *q = *q + gv[bj][n] * acc[ai][bj][m][n]; }
            }
    }
};
struct EpiP {
    static constexpr bool PERM = true, AFTER_DRAIN = false;
    bf16_t* O; int ldc;
    DEV void operator()(const f32x4 (&acc)[2][2][4][2], const Unit& u, int wr, int wc, int fr, int fq) const {
        const int row0 = u.pm * 256 + wr * 64 + fr, col0 = u.pn * 256 + wc * 32 + 8 * fq;
#pragma unroll
        for (int ai = 0; ai < 2; ++ai)
#pragma unroll
            for (int m = 0; m < 4; ++m) {
                bf16_t* rowp = O + (size_t)(row0 + ai * 128 + m * 16) * ldc + col0;
#pragma unroll
                for (int bj = 0; bj < 2; ++bj) {
                    const f32x4 v0 = acc[ai][bj][m][0], v1 = acc[ai][bj][m][1];
                    u32x4 w; w.x = cvt_pk_bf16(v0[0], v0[1]); w.y = cvt_pk_bf16(v0[2], v0[3]); w.z = cvt_pk_bf16(v1[0], v1[1]); w.w = cvt_pk_bf16(v1[2], v1[3]);
                    *(u32x4*)(rowp + bj * 128) = w;
                }
            }
    }
};
struct EpiGlu {
    static constexpr bool PERM = true, AFTER_DRAIN = false;
    const bf16_t* Y; const float* bias; bf16_t* O;
    DEV void operator()(const f32x4 (&acc)[2][2][4][2], const Unit& u, int wr, int wc, int fr, int fq) const {
        const int row0 = u.pm * 256 + wr * 64 + fr, col0 = u.pn * 256 + wc * 32 + 8 * fq;
#pragma unroll
        for (int ai = 0; ai < 2; ++ai)
#pragma unroll
            for (int m = 0; m < 4; ++m) {
                const int row = row0 + ai * 128 + m * 16;
#pragma unroll
                for (int bj = 0; bj < 2; ++bj) {
                    const int col = col0 + bj * 128;
                    const u32x4 yv = *(const u32x4*)(Y + (size_t)row * 512 + col);
                    const f32x4 b0 = *(const f32x4*)(bias + col), b1 = *(const f32x4*)(bias + col + 4);
                    const f32x4 v0 = acc[ai][bj][m][0] + b0, v1 = acc[ai][bj][m][1] + b1;
                    float y[8];
#pragma unroll
                    for (int j = 0; j < 4; ++j) { y[2 * j] = __uint_as_float(yv[j] << 16); y[2 * j + 1] = __uint_as_float(yv[j] & 0xffff0000u); }
                    u32x4 w;
                    w.x = cvt_pk_bf16(y[0] * sigm(v0[0]), y[1] * sigm(v0[1])); w.y = cvt_pk_bf16(y[2] * sigm(v0[2]), y[3] * sigm(v0[3]));
                    w.z = cvt_pk_bf16(y[4] * sigm(v1[0]), y[5] * sigm(v1[1])); w.w = cvt_pk_bf16(y[6] * sigm(v1[2]), y[7] * sigm(v1[3]));
                    *(u32x4*)(O + (size_t)row * D + 512 + col) = w;
                }
            }
    }
};

DEV void convert_job(const float* __restrict__ src, int Nsrc, int K, bf16_t* __restrict__ dst, int Nv, int mode, int& base, float* tile) {
    const int tid = TID(), G = gridDim.x;
    const int tv = Nv / 64, ntiles = (K / 64) * tv;
    const int first = (int)(((long)blockIdx.x - (long)(base % G) + G) % G);
    for (int t = first; t < ntiles; t += G) {
        const int v0 = (t % tv) * 64, k0 = (t / tv) * 64;
        {
            const int v = tid & 63, kk = tid >> 6, vv = v0 + v;
            int sc;
            if (mode == 1) { const int q = vv >> 3, s = vv & 7; sc = s < 4 ? 4 * q + s : FFN + 4 * q + (s - 4); }
            else sc = vv < Nsrc ? vv : -1;
#pragma unroll
            for (int i = 0; i < 8; ++i) { const int k = kk + 8 * i; tile[k * 65 + v] = sc >= 0 ? src[(size_t)(k0 + k) * Nsrc + sc] : 0.f; }
        }
        __syncthreads();
        {
            const int vo = tid >> 3, kq = (tid & 7) * 8;
            pg8::u32x4 w;
            w.x = pack2(tile[(kq + 0) * 65 + vo], tile[(kq + 1) * 65 + vo]); w.y = pack2(tile[(kq + 2) * 65 + vo], tile[(kq + 3) * 65 + vo]);
            w.z = pack2(tile[(kq + 4) * 65 + vo], tile[(kq + 5) * 65 + vo]); w.w = pack2(tile[(kq + 6) * 65 + vo], tile[(kq + 7) * 65 + vo]);
            *(pg8::u32x4*)(dst + (size_t)(v0 + vo) * K + k0 + kq) = w;
        }
        __syncthreads();
    }
    base += ntiles;
}

DEV void phase_init(const Params& p, char* smem) {
    const int tid = TID(), G = gridDim.x, bid = blockIdx.x;
    char* ws = p.ws;
    float* tile = (float*)smem;
    int base = 0;
    for (int i = 0; i < 8; ++i) convert_job(p.in[I_WUP] + (size_t)i * D * 2 * FFN, 2 * FFN, D, (bf16_t*)(ws + OFF_WUP + i * SZ_WUP), 2 * FFN, 1, base, tile);
    for (int i = 0; i < 8; ++i) convert_job(p.in[I_WDN] + (size_t)i * FFN * D, D, FFN, (bf16_t*)(ws + OFF_WDN + i * SZ_WDN), D, 0, base, tile);
    for (int i = 0; i < 2; ++i) {
        convert_job(p.in[I_ABIN] + (size_t)i * D * ABIN, ABIN, D, (bf16_t*)(ws + OFF_WABIN + (size_t)i * ABN * D * 2), ABN, 0, base, tile);
        convert_job(p.in[I_CDIN] + (size_t)i * D * CDN, CDN, D, (bf16_t*)(ws + OFF_WCDIN + (size_t)i * CDN * D * 2), CDN, 0, base, tile);
        convert_job(p.in[I_ABOUT] + (size_t)i * D * D, D, D, (bf16_t*)(ws + OFF_WABOUT + (size_t)i * D * D * 2), D, 0, base, tile);
        convert_job(p.in[I_CDOUT] + (size_t)i * D * D, D, D, (bf16_t*)(ws + OFF_WCDOUT + (size_t)i * D * D * 2), D, 0, base, tile);
        convert_job(p.in[I_GLUW] + (size_t)i * 512 * 512, 512, 512, (bf16_t*)(ws + OFF_WGLU + (size_t)i * 512 * 512 * 2), 512, 0, base, tile);
    }
    {
        float* sc = (float*)smem;
        float* red = sc + 3 * 1024;
        __syncthreads();
        for (int i = tid; i < 3 * 1024; i += 512) { const float v = i < 2048 ? p.in[I_C][i] : p.in[I_CCTX][i - 2048]; sc[i] = silu(v); }
        __syncthreads();
        float* mod = (float*)(ws + OFF_MOD);
        const int col = tid & 63, ks = tid >> 6;
        for (int u = bid; u < 4 * 144; u += G) {
            const int l = u / 144, cg0 = (u % 144) * 64;
            const float* w = p.in[I_ADAW] + ((size_t)l * D + ks * 128) * MODW + cg0 + col;
            float a0 = 0.f, a1 = 0.f, a2 = 0.f;
#pragma unroll 8
            for (int k = 0; k < 128; ++k) { const float wv = w[(size_t)k * MODW]; const int kk = ks * 128 + k; a0 += sc[kk] * wv; a1 += sc[1024 + kk] * wv; a2 += sc[2048 + kk] * wv; }
            red[(ks * 3 + 0) * 64 + col] = a0; red[(ks * 3 + 1) * 64 + col] = a1; red[(ks * 3 + 2) * 64 + col] = a2;
            __syncthreads();
            if (tid < 192) {
                const int r = tid >> 6, cc = tid & 63; float s = p.in[I_ADAB][(size_t)l * MODW + cg0 + cc];
#pragma unroll
                for (int k = 0; k < 8; ++k) s += red[(k * 3 + r) * 64 + cc];
                mod[((size_t)l * 3 + r) * MODW + cg0 + cc] = s;
            }
            __syncthreads();
        }
    }
    if (bid == G - 1) {
        float* lb = (float*)(ws + OFF_LB);
        const float a = p.in[I_LB][tid], b = p.in[I_LB][512 + tid], c = p.in[I_LB][1024 + tid];
        const float mx = fmaxf(a, fmaxf(b, c)); const float ea = expf(a - mx), eb = expf(b - mx), ec = expf(c - mx); const float inv = 1.f / (ea + eb + ec);
        lb[tid] = ea * inv; lb[512 + tid] = (ea + eb) * inv; lb[1024 + tid] = 1.f;
    }
    {
        float4* h4 = (float4*)(ws + OFF_H);
        const float4* x4 = (const float4*)p.in[I_X]; const float4* c4 = (const float4*)p.in[I_CTX];
        const size_t nx = (size_t)NLAT * D / 4, nc = (size_t)NB * CTXL * D / 4;
        for (size_t i = (size_t)bid * 512 + tid; i < nx + nc; i += (size_t)G * 512) h4[i] = i < nx ? x4[i] : c4[i - nx];
    }
}

DEV void phase_norm(const Params& p, int l, int j) {
    const int tid = TID(), lane = tid & 63, wid = tid >> 6;
    const float* h = (const float*)(p.ws + OFF_H);
    bf16_t* hn = (bf16_t*)(p.ws + OFF_HN);
    const float* g = p.in[I_NORMG] + (size_t)(l * 3 + j) * D;
    const float* mod = (const float*)(p.ws + OFF_MOD) + (size_t)l * 3 * MODW;
    for (int row = blockIdx.x * 8 + wid; row < NTOK; row += gridDim.x * 8) {
        const float* hr = h + (size_t)row * D;
        float4 v[4]; float ss = 0.f;
#pragma unroll
        for (int i = 0; i < 4; ++i) { v[i] = *(const float4*)(hr + i * 256 + lane * 4); ss += v[i].x * v[i].x + v[i].y * v[i].y + v[i].z * v[i].z + v[i].w * v[i].w; }
        ss = wave_sum(ss);
        const float rstd = rsqrtf(ss * (1.f / D) + 1e-6f);
        const float* m = mod + (size_t)mod_row(row) * MODW + (j * 3) * D;
#pragma unroll
        for (int i = 0; i < 4; ++i) {
            const int c = i * 256 + lane * 4;
            const float4 gg = *(const float4*)(g + c), sh = *(const float4*)(m + c), sc = *(const float4*)(m + D + c);
            u32x2 w;
            w.x = pack2(v[i].x * rstd * gg.x * (1.f + sc.x) + sh.x, v[i].y * rstd * gg.y * (1.f + sc.y) + sh.y);
            w.y = pack2(v[i].z * rstd * gg.z * (1.f + sc.z) + sh.z, v[i].w * rstd * gg.w * (1.f + sc.w) + sh.w);
            *(u32x2*)(hn + (size_t)row * D + c) = w;
        }
    }
}

DEV void phase_final(const Params& p) {
    const int tid = TID(), lane = tid & 63, wid = tid >> 6;
    const float* h = (const float*)(p.ws + OFF_H);
    const float* g = p.in[I_FNG];
    for (int row = blockIdx.x * 8 + wid; row < NLAT; row += gridDim.x * 8) {
        const float* hr = h + (size_t)row * D;
        float4 v[4]; float ss = 0.f;
#pragma unroll
        for (int i = 0; i < 4; ++i) { v[i] = *(const float4*)(hr + i * 256 + lane * 4); ss += v[i].x * v[i].x + v[i].y * v[i].y + v[i].z * v[i].z + v[i].w * v[i].w; }
        ss = wave_sum(ss);
        const float rstd = rsqrtf(ss * (1.f / D) + 1e-6f);
#pragma unroll
        for (int i = 0; i < 4; ++i) {
            const int c = i * 256 + lane * 4;
            const float4 gg = *(const float4*)(g + c);
            float4 o; o.x = v[i].x * rstd * gg.x; o.y = v[i].y * rstd * gg.y; o.z = v[i].z * rstd * gg.z; o.w = v[i].w * rstd * gg.w;
            *(float4*)(p.out + (size_t)row * D + c) = o;
        }
    }
}

DEV int stream_row64(int b, int dir, int sc, int s) {
    if (sc < 4) { const int oc = dir ? 3 - sc : sc; return NLAT + b * CTXL + oc * 64 + (dir ? 63 - s : s); }
    const int lc = sc - 4, oc = dir ? 255 - lc : lc; return b * SEQ + oc * 64 + (dir ? 63 - s : s);
}

DEV void s5_disc(const Params& p, int e, int dir, int g, int pp, float& abr, float& abi, float& cr, float& ci) {
    const int i = ((e * 2 + dir) * 32 + g) * 64 + pp;
    const double lr = (double)p.in[I_LRE][i], li = (double)p.in[I_LIM][i], step = exp((double)p.in[I_LSTEP][(e * 2 + dir) * 32 + g]);
    const double mag = exp(lr * step), ar = mag * cos(li * step), ai = mag * sin(li * step);
    const double den = lr * lr + li * li, nr = ar - 1.0, ni = ai;
    abr = (float)ar; abi = (float)ai; cr = (float)((nr * lr + ni * li) / den); ci = (float)((ni * lr - nr * li) / den);
}
DEV void s5_bbar(const Params& p, int e, int g, int pp, float cr, float ci, float (&bbr)[16], float (&bbi)[16]) {
    const float* br = p.in[I_BRE] + ((size_t)(e * 32 + g) * 64 + pp) * 16; const float* bi = p.in[I_BIM] + ((size_t)(e * 32 + g) * 64 + pp) * 16;
#pragma unroll
    for (int c4 = 0; c4 < 4; ++c4) {
        const float4 r = *(const float4*)(br + c4 * 4), q = *(const float4*)(bi + c4 * 4);
        bbr[c4 * 4 + 0] = cr * r.x - ci * q.x; bbi[c4 * 4 + 0] = cr * q.x + ci * r.x;
        bbr[c4 * 4 + 1] = cr * r.y - ci * q.y; bbi[c4 * 4 + 1] = cr * q.y + ci * r.y;
        bbr[c4 * 4 + 2] = cr * r.z - ci * q.z; bbi[c4 * 4 + 2] = cr * q.z + ci * r.z;
        bbr[c4 * 4 + 3] = cr * r.w - ci * q.w; bbi[c4 * 4 + 3] = cr * q.w + ci * r.w;
    }
}
template <class RowF> DEV void s5_load_u(const Params& p, bf16_t* us, int gq, RowF rowf) {
    const int tid = TID(), s = tid >> 3, part = tid & 7;
    const bf16_t* P = (const bf16_t*)(p.ws + OFF_P);
    const pg8::u32x4* src = (const pg8::u32x4*)(P + (size_t)rowf(s) * ABN + 2064 + gq * 128 + part * 16);
    pg8::u32x4* dst = (pg8::u32x4*)(us + s * 128 + part * 16);
    dst[0] = src[0]; dst[1] = src[1];
}
DEV void s5_step(const bf16_t* urow, const float (&bbr)[16], const float (&bbi)[16], float abr, float abi, float& hr, float& hi) {
    float bur = 0.f, bui = 0.f;
#pragma unroll
    for (int c8 = 0; c8 < 2; ++c8) {
        const pg8::u32x4 uv = *(const pg8::u32x4*)(urow + c8 * 8);
#pragma unroll
        for (int j = 0; j < 4; ++j) {
            const float u0 = __uint_as_float(uv[j] << 16), u1 = __uint_as_float(uv[j] & 0xffff0000u);
            bur += bbr[c8 * 8 + 2 * j] * u0 + bbr[c8 * 8 + 2 * j + 1] * u1; bui += bbi[c8 * 8 + 2 * j] * u0 + bbi[c8 * 8 + 2 * j + 1] * u1;
        }
    }
    const float nr = abr * hr - abi * hi + bur, ni = abr * hi + abi * hr + bui;
    hr = nr; hi = ni;
}

DEV void phase_s1(const Params& p, int e, char* smem) {
    const int tid = TID(), lane = tid & 63, w = tid >> 6;
    bf16_t* us = (bf16_t*)smem;
    float2* carry = (float2*)(p.ws + OFF_SCR + SCR_CARRY);
    for (int ib = blockIdx.x; ib < 4 * NCH * 4; ib += gridDim.x) {
        const int gq = ib & 3, rest = ib >> 2, sc = rest % NCH, bd = rest / NCH, dir = bd & 1, b = bd >> 1, g = gq * 8 + w;
        __syncthreads();
        s5_load_u(p, us, gq, [&](int s) { return stream_row64(b, dir, sc, s); });
        float abr, abi, cr, ci; s5_disc(p, e, dir, g, lane, abr, abi, cr, ci);
        float bbr[16], bbi[16]; s5_bbar(p, e, g, lane, cr, ci, bbr, bbi);
        __syncthreads();
        float hr = 0.f, hi = 0.f;
        for (int s = 0; s < 64; ++s) s5_step(us + s * 128 + w * 16, bbr, bbi, abr, abi, hr, hi);
        carry[((size_t)((b * 2 + dir) * 32 + g) * NCH + sc) * 64 + lane] = make_float2(hr, hi);
    }
}

DEV void phase_s2(const Params& p, int e) {
    const int gid = blockIdx.x * 512 + TID();
    if (gid >= 128 * 64) return;
    const int pp = gid & 63, chain = gid >> 6, dir = (chain >> 5) & 1, g = chain & 31;
    const int i = ((e * 2 + dir) * 32 + g) * 64 + pp;
    const double lr = (double)p.in[I_LRE][i], li = (double)p.in[I_LIM][i], step = exp((double)p.in[I_LSTEP][(e * 2 + dir) * 32 + g]);
    const double mag = exp(64.0 * lr * step);
    const float ar = (float)(mag * cos(64.0 * li * step)), ai = (float)(mag * sin(64.0 * li * step));
    float2* E = (float2*)(p.ws + OFF_SCR + SCR_CARRY) + (size_t)chain * NCH * 64 + pp;
    float hr = 0.f, hi = 0.f;
    for (int sc = 0; sc < NCH; ++sc) {
        const float2 t = E[(size_t)sc * 64];
        E[(size_t)sc * 64] = make_float2(hr, hi);
        const float nr = ar * hr - ai * hi + t.x, ni = ar * hi + ai * hr + t.y;
        hr = nr; hi = ni;
    }
}

DEV float gelu_tanh(float x) {
    const float z = 0.7978845608028654f * (x + 0.044715f * x * x * x);
    const float t = 1.f - 2.f / (__expf(2.f * z) + 1.f);
    return 0.5f * x * (1.f + t);
}

DEV void phase_s3(const Params& p, int e, char* smem) {
    const int tid = TID(), lane = tid & 63, w = tid >> 6;
    bf16_t* us = (bf16_t*)smem;
    float* wbase = (float*)(smem + 16384) + (size_t)w * 4224;
    float* hre = wbase; float* him = wbase + 520; float* Cre = wbase + 1040; float* Cim = wbase + 2064; float* yacc = wbase + 3088;
    const float2* carry = (const float2*)(p.ws + OFF_SCR + SCR_CARRY);
    bf16_t* ybuf = (bf16_t*)(p.ws + OFF_SCR + SCR_YB);
    for (int ib = blockIdx.x; ib < NB * NCH * 4; ib += gridDim.x) {
        const int gq = ib & 3, rest = ib >> 2, qc = rest % NCH, b = rest / NCH, g = gq * 8 + w;
        const int row0 = qc < 4 ? NLAT + b * CTXL + qc * 64 : b * SEQ + (qc - 4) * 64;
        __syncthreads();
        s5_load_u(p, us, gq, [&](int s) { return row0 + s; });
        {
            const float* cre = p.in[I_CRE] + (size_t)(e * 32 + g) * 1024; const float* cim = p.in[I_CIM] + (size_t)(e * 32 + g) * 1024;
#pragma unroll
            for (int c = 0; c < 16; ++c) { Cre[lane * 16 + c] = cre[c * 64 + lane]; Cim[lane * 16 + c] = cim[c * 64 + lane]; }
            for (int i = lane; i < 64 * 17; i += 64) yacc[i] = 0.f;
        }
        __syncthreads();
        const int tl = lane >> 3, cq = lane & 7;
        for (int dir = 0; dir < 2; ++dir) {
            float abr, abi, cr, ci; s5_disc(p, e, dir, g, lane, abr, abi, cr, ci);
            float bbr[16], bbi[16]; s5_bbar(p, e, g, lane, cr, ci, bbr, bbi);
            const int sc = dir ? (qc < 4 ? 3 - qc : 4 + (255 - (qc - 4))) : qc;
            const float2 h0 = carry[((size_t)((b * 2 + dir) * 32 + g) * NCH + sc) * 64 + lane];
            float hr = h0.x, hi = h0.y;
            for (int k = 0; k < 8; ++k) {
#pragma unroll
                for (int j = 0; j < 8; ++j) {
                    const int ss = k * 8 + j, sn = dir ? 63 - ss : ss;
                    s5_step(us + sn * 128 + w * 16, bbr, bbi, abr, abi, hr, hi);
                    hre[j * 65 + lane] = hr; him[j * 65 + lane] = hi;
                }
                __builtin_amdgcn_fence(__ATOMIC_RELEASE, "wavefront"); __builtin_amdgcn_wave_barrier(); __builtin_amdgcn_fence(__ATOMIC_ACQUIRE, "wavefront");
                float y0 = 0.f, y1 = 0.f;
#pragma unroll 8
                for (int q = 0; q < 64; ++q) {
                    const float a = hre[tl * 65 + q], bb = him[tl * 65 + q];
                    const float2 c_r = *(const float2*)(Cre + q * 16 + cq * 2), c_i = *(const float2*)(Cim + q * 16 + cq * 2);
                    y0 += a * c_r.x - bb * c_i.x; y1 += a * c_r.y - bb * c_i.y;
                }
                const int ssn = k * 8 + tl, snn = dir ? 63 - ssn : ssn;
                yacc[snn * 17 + cq * 2] += y0; yacc[snn * 17 + cq * 2 + 1] += y1;
                __builtin_amdgcn_fence(__ATOMIC_RELEASE, "wavefront"); __builtin_amdgcn_wave_barrier(); __builtin_amdgcn_fence(__ATOMIC_ACQUIRE, "wavefront");
            }
        }
        {
            const float* dsk = p.in[I_S5D] + (size_t)e * 512 + g * 16;
            unsigned o[8];
#pragma unroll
            for (int c2 = 0; c2 < 8; ++c2) {
                const float u0 = bf2f(us[lane * 128 + w * 16 + c2 * 2]), u1 = bf2f(us[lane * 128 + w * 16 + c2 * 2 + 1]);
                const float y0 = yacc[lane * 17 + c2 * 2] + dsk[c2 * 2] * u0, y1 = yacc[lane * 17 + c2 * 2 + 1] + dsk[c2 * 2 + 1] * u1;
                o[c2] = pack2(gelu_tanh(y0), gelu_tanh(y1));
            }
            pg8::u32x4* dst = (pg8::u32x4*)(ybuf + (size_t)(row0 + lane) * 512 + g * 16);
            pg8::u32x4 w0, w1; w0.x = o[0]; w0.y = o[1]; w0.z = o[2]; w0.w = o[3]; w1.x = o[4]; w1.y = o[5]; w1.z = o[6]; w1.w = o[7];
            dst[0] = w0; dst[1] = w1;
        }
    }
}

DEV float gdn_conv(const bf16_t* P, const float* cw, int row, int t, int L, int col) {
    float acc = 0.f;
#pragma unroll
    for (int j = 0; j < 5; ++j) { const int tt = t + j - 2; if (tt >= 0 && tt < L) acc += bf2f(P[(size_t)(row + j - 2) * ABN + col]) * cw[j * 1536 + col]; }
    return acc;
}

DEV void phase_g1(const Params& p, int e, char* smem) {
    const int tid = TID(), lane = tid & 63, w = tid >> 6;
    float* qs = (float*)smem; float* ks = qs + 64 * 132; float* As = ks + 64 * 132; float* Xs = As + 64 * 65; float* gc = Xs + 64 * 65; float* bt = gc + 64;
    const bf16_t* P = (const bf16_t*)(p.ws + OFF_P);
    bf16_t* qn = (bf16_t*)(p.ws + OFF_QN); bf16_t* kn = (bf16_t*)(p.ws + OFF_KN);
    bf16_t* Tg = (bf16_t*)(p.ws + OFF_SCR + SCR_T); bf16_t* QKg = (bf16_t*)(p.ws + OFF_SCR + SCR_QK); float* gb = (float*)(p.ws + OFF_SCR + SCR_GB);
    const float* cw = p.in[I_GCONV] + (size_t)e * 5 * 1536;
    for (int item = blockIdx.x; item < 4160; item += gridDim.x) {
        const int dir = item & 1, r_ = item >> 1, sc = r_ % NCH, bh = r_ / NCH, h = bh & 3, b = bh >> 2;
        const int ci = ((b * 4 + h) * 2 + dir) * NCH + sc;
        const int base = sc < 4 ? NLAT + b * CTXL : b * SEQ, L = sc < 4 ? CTXL : SEQ;
        __syncthreads();
        {
            const int cidx = tid & 255, tg = tid >> 8;
            const int col = cidx < 128 ? h * 128 + cidx : 512 + h * 128 + (cidx - 128);
            float* dst = cidx < 128 ? qs : ks;
            for (int ss = 0; ss < 32; ++ss) {
                const int s = tg * 32 + ss, row = stream_row64(b, dir, sc, s);
                dst[s * 132 + (cidx & 127)] = silu(gdn_conv(P, cw, row, row - base, L, col));
            }
            for (int i = tid; i < 64 * 65; i += 512) Xs[i] = 0.f;
        }
        __syncthreads();
        {
            for (int vv = 0; vv < 16; ++vv) {
                const int v = w * 16 + vv, isk = v >> 6, s = v & 63;
                float* x = (isk ? ks : qs) + s * 132;
                const float x0 = x[lane], x1 = x[lane + 64];
                const float ss = wave_sum(x0 * x0 + x1 * x1);
                const float scl = rsqrtf(ss + 1e-6f) * (isk ? 1.f : 0.08838834764831845f);
                x[lane] = x0 * scl; x[lane + 64] = x1 * scl;
                if (dir == 0) {
                    const int row = stream_row64(b, dir, sc, s);
                    bf16_t* o = (isk ? kn : qn) + (size_t)row * 512 + h * 128;
                    o[lane] = f2bf(x0 * scl); o[lane + 64] = f2bf(x1 * scl);
                }
            }
        }
        if (tid < 64) {
            const int row = stream_row64(b, dir, sc, tid);
            const float a = bf2f(P[(size_t)row * ABN + 2048 + dir * 4 + h]), bb = bf2f(P[(size_t)row * ABN + 2056 + dir * 4 + h]);
            const float x = a + p.in[I_GDT][(e * 2 + dir) * 4 + h];
            const float sp = x > 20.f ? x : log1pf(expf(x));
            float la = -expf(p.in[I_GALOG][(e * 2 + dir) * 4 + h]) * sp;
#pragma unroll
            for (int o = 1; o < 64; o <<= 1) { const float t = __shfl_up(la, o, 64); if (lane >= o) la += t; }
            const float be = sigm(bb);
            gc[tid] = la; bt[tid] = be; gb[(size_t)ci * 128 + tid] = la; gb[(size_t)ci * 128 + 64 + tid] = be;
        }
        __syncthreads();
        {
            const int i = tid >> 3, jg = tid & 7;
            float kk[8], qk[8];
#pragma unroll
            for (int j = 0; j < 8; ++j) { kk[j] = 0.f; qk[j] = 0.f; }
            if (jg * 8 <= i) {
                for (int d = 0; d < 128; d += 4) {
                    const float4 ki = *(const float4*)(ks + i * 132 + d), qi = *(const float4*)(qs + i * 132 + d);
#pragma unroll
                    for (int j = 0; j < 8; ++j) {
                        const float4 kj = *(const float4*)(ks + (jg * 8 + j) * 132 + d);
                        kk[j] += ki.x * kj.x + ki.y * kj.y + ki.z * kj.z + ki.w * kj.w;
                        qk[j] += qi.x * kj.x + qi.y * kj.y + qi.z * kj.z + qi.w * kj.w;
                    }
                }
            }
            const float gi = gc[i], bi = bt[i];
            unsigned o[4];
#pragma unroll
            for (int j2 = 0; j2 < 4; ++j2) {
                float q2[2];
#pragma unroll
                for (int jj = 0; jj < 2; ++jj) {
                    const int j = j2 * 2 + jj, jc = jg * 8 + j;
                    const float dec = jc <= i ? __expf(gi - gc[jc]) : 0.f;
                    As[i * 65 + jc] = jc < i ? kk[j] * dec * bi : 0.f;
                    q2[jj] = qk[j] * dec;
                }
                o[j2] = pack2(q2[0], q2[1]);
            }
            pg8::u32x4 wv; wv.x = o[0]; wv.y = o[1]; wv.z = o[2]; wv.w = o[3];
            *(pg8::u32x4*)(QKg + (size_t)ci * 4096 + i * 64 + jg * 8) = wv;
        }
        __syncthreads();
        if (tid < 64) {
            const int c = tid;
            for (int i = 0; i < 64; ++i) {
                float a0 = (i == c) ? 1.f : 0.f, a1 = 0.f, a2 = 0.f, a3 = 0.f;
                for (int j = 0; j < i; j += 4) {
                    a0 -= As[i * 65 + j] * Xs[j * 65 + c]; a1 -= As[i * 65 + j + 1] * Xs[(j + 1) * 65 + c];
                    a2 -= As[i * 65 + j + 2] * Xs[(j + 2) * 65 + c]; a3 -= As[i * 65 + j + 3] * Xs[(j + 3) * 65 + c];
                }
                Xs[i * 65 + c] = (a0 + a1) + (a2 + a3);
            }
        }
        __syncthreads();
        {
            const int i = tid >> 3, jg = tid & 7;
            pg8::u32x4 wv;
            wv.x = pack2(Xs[i * 65 + jg * 8 + 0], Xs[i * 65 + jg * 8 + 1]); wv.y = pack2(Xs[i * 65 + jg * 8 + 2], Xs[i * 65 + jg * 8 + 3]);
            wv.z = pack2(Xs[i * 65 + jg * 8 + 4], Xs[i * 65 + jg * 8 + 5]); wv.w = pack2(Xs[i * 65 + jg * 8 + 6], Xs[i * 65 + jg * 8 + 7]);
            *(pg8::u32x4*)(Tg + (size_t)ci * 4096 + i * 64 + jg * 8) = wv;
        }
    }
}

DEV void phase_g2(const Params& p, int e, char* smem) {
    const int tid = TID();
    float* qs = (float*)smem; float* ks = qs + 64 * 132; float* Ts = ks + 64 * 132; float* QKs = Ts + 64 * 68; float* Ss = QKs + 64 * 68;
    float* rb = Ss + 8 * 132; float* ub = rb + 512; float* u2 = ub + 512; float* vs = u2 + 512; float* gc = vs + 512; float* bt = gc + 64;
    const bf16_t* P = (const bf16_t*)(p.ws + OFF_P);
    const bf16_t* qn = (const bf16_t*)(p.ws + OFF_QN); const bf16_t* kn = (const bf16_t*)(p.ws + OFF_KN);
    const bf16_t* Tg = (const bf16_t*)(p.ws + OFF_SCR + SCR_T); const bf16_t* QKg = (const bf16_t*)(p.ws + OFF_SCR + SCR_QK); const float* gb = (const float*)(p.ws + OFF_SCR + SCR_GB);
    bf16_t* ob = (bf16_t*)p.out;
    const float* cw = p.in[I_GCONV] + (size_t)e * 5 * 1536;
    for (int item = blockIdx.x; item < 256; item += gridDim.x) {
        const int chain = item >> 4, e0 = (item & 15) * 8, dir = chain & 1, h = (chain >> 1) & 3, b = chain >> 3;
        const int t = tid >> 3, ee = tid & 7;
        const int sd = tid >> 2, sp = (tid & 3) * 2;
        float S0 = 0.f, S1 = 0.f;
        __syncthreads();
        for (int i = tid; i < 8 * 132; i += 512) Ss[i] = 0.f;
        for (int sc = 0; sc < NCH; ++sc) {
            const int ci = chain * NCH + sc;
            const int base = sc < 4 ? NLAT + b * CTXL : b * SEQ, L = sc < 4 ? CTXL : SEQ;
            const int row = stream_row64(b, dir, sc, t);
            __syncthreads();
            {
                const int part = ee;
                const pg8::u32x4* sq = (const pg8::u32x4*)(qn + (size_t)row * 512 + h * 128 + part * 16);
                const pg8::u32x4* sk = (const pg8::u32x4*)(kn + (size_t)row * 512 + h * 128 + part * 16);
#pragma unroll
                for (int hh = 0; hh < 2; ++hh) {
                    const pg8::u32x4 a = sq[hh], c = sk[hh];
#pragma unroll
                    for (int j = 0; j < 4; ++j) {
                        qs[t * 132 + part * 16 + hh * 8 + 2 * j] = __uint_as_float(a[j] << 16); qs[t * 132 + part * 16 + hh * 8 + 2 * j + 1] = __uint_as_float(a[j] & 0xffff0000u);
                        ks[t * 132 + part * 16 + hh * 8 + 2 * j] = __uint_as_float(c[j] << 16); ks[t * 132 + part * 16 + hh * 8 + 2 * j + 1] = __uint_as_float(c[j] & 0xffff0000u);
                    }
                }
                const pg8::u32x4 tv = *(const pg8::u32x4*)(Tg + (size_t)ci * 4096 + t * 64 + ee * 8), qv = *(const pg8::u32x4*)(QKg + (size_t)ci * 4096 + t * 64 + ee * 8);
#pragma unroll
                for (int j = 0; j < 4; ++j) {
                    Ts[t * 68 + ee * 8 + 2 * j] = __uint_as_float(tv[j] << 16); Ts[t * 68 + ee * 8 + 2 * j + 1] = __uint_as_float(tv[j] & 0xffff0000u);
                    QKs[t * 68 + ee * 8 + 2 * j] = __uint_as_float(qv[j] << 16); QKs[t * 68 + ee * 8 + 2 * j + 1] = __uint_as_float(qv[j] & 0xffff0000u);
                }
                if (tid < 64) { gc[tid] = gb[(size_t)ci * 128 + tid]; bt[tid] = gb[(size_t)ci * 128 + 64 + tid]; }
                vs[t * 8 + ee] = silu(gdn_conv(P, cw, row, row - base, L, 1024 + h * 128 + e0 + ee));
            }
            __syncthreads();
            float acc1 = 0.f, acc2 = 0.f;
            for (int d = 0; d < 128; d += 4) {
                const float4 s4 = *(const float4*)(Ss + ee * 132 + d), k4 = *(const float4*)(ks + t * 132 + d), q4 = *(const float4*)(qs + t * 132 + d);
                acc1 += k4.x * s4.x + k4.y * s4.y + k4.z * s4.z + k4.w * s4.w;
                acc2 += q4.x * s4.x + q4.y * s4.y + q4.z * s4.z + q4.w * s4.w;
            }
            const float gt = gc[t], eg = __expf(gt), gl = gc[63];
            rb[t * 8 + ee] = bt[t] * (vs[t * 8 + ee] - eg * acc1);
            __syncthreads();
            float u = 0.f;
            for (int j = 0; j <= t; ++j) u += Ts[t * 68 + j] * rb[j * 8 + ee];
            ub[t * 8 + ee] = u; u2[t * 8 + ee] = __expf(gl - gt) * u;
            __syncthreads();
            float o = eg * acc2;
            for (int j = 0; j <= t; ++j) o += QKs[t * 68 + j] * ub[j * 8 + ee];
            ob[((size_t)dir * NTOK + row) * 512 + h * 128 + e0 + ee] = f2bf(o);
            {
                const float egl = __expf(gl);
                float a0 = 0.f, a1 = 0.f;
                for (int j = 0; j < 64; ++j) { const float kv = ks[j * 132 + sd]; const float2 uu = *(const float2*)(u2 + j * 8 + sp); a0 += kv * uu.x; a1 += kv * uu.y; }
                S0 = S0 * egl + a0; S1 = S1 * egl + a1;
                Ss[sp * 132 + sd] = S0; Ss[(sp + 1) * 132 + sd] = S1;
            }
        }
    }
}

DEV void phase_combine(const Params& p, const bf16_t* G, int ldg, int gcol, const float* ng, int ocol) {
    const int tid = TID(), lane = tid & 63, wid = tid >> 6;
    const bf16_t* ob = (const bf16_t*)p.out;
    bf16_t* ym = (bf16_t*)(p.ws + OFF_HN);
    const int c0 = lane * 8, d0 = c0 & 127;
    for (int row = blockIdx.x * 8 + wid; row < NTOK; row += gridDim.x * 8) {
        const pg8::u32x4 a = *(const pg8::u32x4*)(ob + (size_t)row * 512 + c0), bq = *(const pg8::u32x4*)(ob + ((size_t)NTOK + row) * 512 + c0);
        const pg8::u32x4 gv = *(const pg8::u32x4*)(G + (size_t)row * ldg + gcol + c0);
        float o[8], gt[8]; float ss = 0.f;
#pragma unroll
        for (int j = 0; j < 4; ++j) {
            o[2 * j] = __uint_as_float(a[j] << 16) + __uint_as_float(bq[j] << 16); o[2 * j + 1] = __uint_as_float(a[j] & 0xffff0000u) + __uint_as_float(bq[j] & 0xffff0000u);
            gt[2 * j] = __uint_as_float(gv[j] << 16); gt[2 * j + 1] = __uint_as_float(gv[j] & 0xffff0000u);
            ss += o[2 * j] * o[2 * j] + o[2 * j + 1] * o[2 * j + 1];
        }
#pragma unroll
        for (int m = 1; m < 16; m <<= 1) ss += __shfl_xor(ss, m, 64);
        const float rstd = rsqrtf(ss * (1.f / 128.f) + 1e-6f);
        pg8::u32x4 wv;
        float y[8];
#pragma unroll
        for (int j = 0; j < 8; ++j) y[j] = o[j] * rstd * ng[d0 + j] * silu(gt[j]);
        wv.x = pack2(y[0], y[1]); wv.y = pack2(y[2], y[3]); wv.z = pack2(y[4], y[5]); wv.w = pack2(y[6], y[7]);
        *(pg8::u32x4*)(ym + (size_t)row * D + ocol + c0) = wv;
    }
}

DEV void phase_conformer(const Params& p, int o, char* smem) {
    const int tid = TID(), lane = tid & 63, w = tid >> 6;
    float* tile = (float*)smem;
    const bf16_t* P = (const bf16_t*)(p.ws + OFF_P);
    bf16_t* ym = (bf16_t*)(p.ws + OFF_HN);
    const float* dw = p.in[I_DWW] + (size_t)o * 31 * 512;
    const int ch = (tid & 255) * 2, tg = tid >> 8;
    float2 wt[31];
#pragma unroll
    for (int j = 0; j < 31; ++j) wt[j] = *(const float2*)(dw + j * 512 + ch);
    const float2 bias = *(const float2*)(p.in[I_DWB] + (size_t)o * 512 + ch);
    for (int it = blockIdx.x; it < 1040; it += gridDim.x) {
        int row0, pos0, len, stride;
        if (it < 1024) {
            const int b = it >> 9, r = (it >> 1) & 255, wh = it & 1;
            row0 = b * SEQ + r * 64 + wh * 32;
            if (ch < 256) { pos0 = wh * 32; len = 64; stride = 1; } else { pos0 = r; len = 256; stride = 64; }
        } else {
            const int ci = it - 1024, b = ci >> 3, t0 = (ci & 7) * 32;
            row0 = NLAT + b * CTXL + t0; pos0 = t0; len = CTXL; stride = 1;
        }
        const bool along = (stride == 1);
        __syncthreads();
        for (int tt = 0; tt < 16; ++tt) {
            const int tok = tg * 16 + tt, row = row0 + tok, pos = along ? pos0 + tok : pos0;
            float a0 = 0.f, a1 = 0.f;
#pragma unroll
            for (int j = 0; j < 31; ++j) {
                const int pp = pos + j - 15;
                if (pp >= 0 && pp < len) {
                    const size_t rr = (size_t)(row + (j - 15) * stride) * CDN;
                    const unsigned av = *(const unsigned*)(P + rr + ch), gv = *(const unsigned*)(P + rr + 512 + ch);
                    const float x0 = __uint_as_float(av << 16) * sigm(__uint_as_float(gv << 16)), x1 = __uint_as_float(av & 0xffff0000u) * sigm(__uint_as_float(gv & 0xffff0000u));
                    a0 += x0 * wt[j].x; a1 += x1 * wt[j].y;
                }
            }
            *(float2*)(tile + tok * 516 + ch) = make_float2(a0 + bias.x, a1 + bias.y);
        }
        __syncthreads();
        const float* lg = p.in[I_LNG] + (size_t)o * 512 + lane * 8; const float* lbb = p.in[I_LNB] + (size_t)o * 512 + lane * 8;
        for (int q = 0; q < 4; ++q) {
            const int tok = w * 4 + q;
            const float4 v0 = *(const float4*)(tile + tok * 516 + lane * 8), v1 = *(const float4*)(tile + tok * 516 + lane * 8 + 4);
            float x[8] = {v0.x, v0.y, v0.z, v0.w, v1.x, v1.y, v1.z, v1.w};
            float s = 0.f;
#pragma unroll
            for (int j = 0; j < 8; ++j) s += x[j];
            const float mean = wave_sum(s) * (1.f / 512.f);
            float vs = 0.f;
#pragma unroll
            for (int j = 0; j < 8; ++j) { x[j] -= mean; vs += x[j] * x[j]; }
            const float rstd = rsqrtf(wave_sum(vs) * (1.f / 512.f) + 1e-6f);
            float y[8];
#pragma unroll
            for (int j = 0; j < 8; ++j) y[j] = silu(x[j] * rstd * lg[j] + lbb[j]);
            pg8::u32x4 wv; wv.x = pack2(y[0], y[1]); wv.y = pack2(y[2], y[3]); wv.z = pack2(y[4], y[5]); wv.w = pack2(y[6], y[7]);
            *(pg8::u32x4*)(ym + (size_t)(row0 + tok) * D + lane * 8) = wv;
        }
    }
}

DEV int hgrn_row(int b, int dir, int bc, int s) {
    if (bc == 0) return NLAT + b * CTXL + (dir ? 255 - s : s);
    const int lc = bc - 1, oc = dir ? 63 - lc : lc; return b * SEQ + oc * 256 + (dir ? 255 - s : s);
}
template <bool OUT> DEV void phase_hgrn_scan(const Params& p, int o, char* smem) {
    const int tid = TID(), e = tid & 127, dg = tid >> 7;
    float* fs = (float*)smem; float* qs = fs + 16 * 128; float* vs = qs + 16 * 128; float* po = vs + 16 * 128;
    const bf16_t* P = (const bf16_t*)(p.ws + OFF_P);
    float* dS = (float*)(p.ws + OFF_SCR + SCR_DS); float* Dd = (float*)(p.ws + OFF_SCR + SCR_DD);
    bf16_t* ob = (bf16_t*)p.out;
    const float* lball = (const float*)(p.ws + OFF_LB) + (size_t)o * 512;
    for (int it = blockIdx.x; it < 16 * NBC; it += gridDim.x) {
        const int chain = it / NBC, bc = it % NBC, dir = chain & 1, h = (chain >> 1) & 3, b = chain >> 3;
        float S[32];
#pragma unroll
        for (int i = 0; i < 32; ++i) S[i] = OUT ? dS[(size_t)it * 16384 + (dg * 32 + i) * 128 + e] : 0.f;
        float Dreg = 1.f;
        for (int sub = 0; sub < 16; ++sub) {
            __syncthreads();
#pragma unroll
            for (int i = 0; i < 4; ++i) {
                const int idx = tid + 512 * i, s = idx >> 7, d = idx & 127;
                const size_t rb = (size_t)hgrn_row(b, dir, bc, sub * 16 + s) * CDN + 1024 + h * 128 + d;
                const float lb = lball[h * 128 + d];
                fs[idx] = lb + (1.f - lb) * sigm(bf2f(P[rb + 512 + dir * 512]));
                if (OUT) qs[idx] = bf2f(P[rb]);
                vs[idx] = bf2f(P[rb + 1536]);
            }
            __syncthreads();
            if (!OUT && tid < 128) {
#pragma unroll
                for (int s = 0; s < 16; ++s) Dreg *= fs[s * 128 + tid];
            }
            for (int s = 0; s < 16; ++s) {
                const float v = vs[s * 128 + e];
                float pacc = 0.f;
#pragma unroll
                for (int i4 = 0; i4 < 8; ++i4) {
                    const float4 f4 = *(const float4*)(fs + s * 128 + dg * 32 + i4 * 4);
                    S[i4 * 4 + 0] = f4.x * S[i4 * 4 + 0] + (1.f - f4.x) * v; S[i4 * 4 + 1] = f4.y * S[i4 * 4 + 1] + (1.f - f4.y) * v;
                    S[i4 * 4 + 2] = f4.z * S[i4 * 4 + 2] + (1.f - f4.z) * v; S[i4 * 4 + 3] = f4.w * S[i4 * 4 + 3] + (1.f - f4.w) * v;
                    if (OUT) {
                        const float4 q4 = *(const float4*)(qs + s * 128 + dg * 32 + i4 * 4);
                        pacc += q4.x * S[i4 * 4 + 0] + q4.y * S[i4 * 4 + 1] + q4.z * S[i4 * 4 + 2] + q4.w * S[i4 * 4 + 3];
                    }
                }
                if (OUT) po[(s * 4 + dg) * 128 + e] = pacc;
            }
            if (OUT) {
                __syncthreads();
#pragma unroll
                for (int i = 0; i < 4; ++i) {
                    const int idx = tid + 512 * i, s = idx >> 7, ee = idx & 127;
                    const float ov = po[(s * 4 + 0) * 128 + ee] + po[(s * 4 + 1) * 128 + ee] + po[(s * 4 + 2) * 128 + ee] + po[(s * 4 + 3) * 128 + ee];
                    ob[((size_t)dir * NTOK + hgrn_row(b, dir, bc, sub * 16 + s)) * 512 + h * 128 + ee] = f2bf(ov);
                }
            }
        }
        if (!OUT) {
#pragma unroll
            for (int i = 0; i < 32; ++i) dS[(size_t)it * 16384 + (dg * 32 + i) * 128 + e] = S[i];
            if (tid < 128) Dd[(size_t)it * 128 + tid] = Dreg;
        }
    }
}
DEV void phase_h2(const Params& p) {
    float* dS = (float*)(p.ws + OFF_SCR + SCR_DS); const float* Dd = (const float*)(p.ws + OFF_SCR + SCR_DD);
    for (int idx = blockIdx.x * 512 + TID(); idx < 16 * 16384; idx += gridDim.x * 512) {
        const int chain = idx >> 14, de = idx & 16383, d = de >> 7;
        float S = 0.f;
        for (int bc = 0; bc < NBC; ++bc) {
            const size_t it = (size_t)chain * NBC + bc;
            const float t = dS[it * 16384 + de];
            dS[it * 16384 + de] = S;
            S = Dd[it * 128 + d] * S + t;
        }
    }
}

constexpr int LDS_BYTES = 155648;

template <class Epi> DEV void run_gemm(char* smem, const bf16_t* A, const bf16_t* Bt, int N, int K, const Epi& E) {
    pg8::Gemm g{A, Bt, NTOK, N, K};
    pg8::StaticOrder S; S.init(NTOK, N, (int)gridDim.x, (int)blockIdx.x);
    pg8::gemm_phase<Epi, pg8::StaticOrder, false>((PG8_LAS unsigned char*)smem, g, S, E, nullptr);
}

DEV void run_step(const Params& p, int st, char* smem) {
    const int type = st & 255, l = (st >> 8) & 255, f = st >> 16, eo = l >> 1;
    char* ws = p.ws;
    const float* mod = (const float*)(ws + OFF_MOD) + (size_t)l * 3 * MODW;
#ifdef ONLY
    if (type != ONLY) return;
#endif
    switch (type) {
    case PH_INIT: phase_init(p, smem); break;
    case PH_NORM: phase_norm(p, l, f); break;
    case PH_UP: { EpiUp E{(bf16_t*)(ws + OFF_P)}; run_gemm(smem, (const bf16_t*)(ws + OFF_HN), (const bf16_t*)(ws + OFF_WUP + (size_t)(l * 2 + f) * SZ_WUP), 2 * FFN, D, E); } break;
    case PH_DOWN: { EpiRes E{(float*)(ws + OFF_H), mod + ((f ? 2 : 0) * 3 + 2) * D, 0.5f}; run_gemm(smem, (const bf16_t*)(ws + OFF_P), (const bf16_t*)(ws + OFF_WDN + (size_t)(l * 2 + f) * SZ_WDN), D, FFN, E); } break;
    case PH_ABIN: { EpiP E{(bf16_t*)(ws + OFF_P), ABN}; run_gemm(smem, (const bf16_t*)(ws + OFF_HN), (const bf16_t*)(ws + OFF_WABIN + (size_t)eo * ABN * D * 2), ABN, D, E); } break;
    case PH_CDIN: { EpiP E{(bf16_t*)(ws + OFF_P), CDN}; run_gemm(smem, (const bf16_t*)(ws + OFF_HN), (const bf16_t*)(ws + OFF_WCDIN + (size_t)eo * CDN * D * 2), CDN, D, E); } break;
    case PH_OUT: { EpiRes E{(float*)(ws + OFF_H), mod + (1 * 3 + 2) * D, 1.0f};
        const bf16_t* W = (const bf16_t*)(ws + ((l & 1) ? OFF_WCDOUT : OFF_WABOUT) + (size_t)eo * D * D * 2);
        run_gemm(smem, (const bf16_t*)(ws + OFF_HN), W, D, D, E); } break;
    case PH_S1: phase_s1(p, eo, smem); break;
    case PH_S2: phase_s2(p, eo); break;
    case PH_S3: phase_s3(p, eo, smem); break;
    case PH_GLU: { EpiGlu E{(const bf16_t*)(ws + OFF_SCR + SCR_YB), p.in[I_GLUB] + (size_t)eo * 512, (bf16_t*)(ws + OFF_HN)};
        run_gemm(smem, (const bf16_t*)(ws + OFF_SCR + SCR_YB), (const bf16_t*)(ws + OFF_WGLU + (size_t)eo * 512 * 512 * 2), 512, 512, E); } break;
    case PH_G1: phase_g1(p, eo, smem); break;
    case PH_G2: phase_g2(p, eo, smem); break;
    case PH_G3: phase_combine(p, (const bf16_t*)(ws + OFF_P), ABN, 1536, p.in[I_GNG] + (size_t)eo * 128, 0); break;
    case PH_CH1: phase_conformer(p, eo, smem); phase_hgrn_scan<false>(p, eo, smem); break;
    case PH_H2: phase_h2(p); break;
    case PH_H3: phase_hgrn_scan<true>(p, eo, smem); break;
    case PH_H4: phase_combine(p, (const bf16_t*)(ws + OFF_P), CDN, 1024 + 2048, p.in[I_HNG] + (size_t)eo * 128, 512); break;
    case PH_FINAL: phase_final(p); break;
    default: break;
    }
}

#ifndef MK_MULTI
__global__ __launch_bounds__(512, 2) void mega_kernel(Params p) {
    extern __shared__ __attribute__((aligned(16))) char smem[];
    cg::grid_group grid = cg::this_grid();
    for (int si = 0; si < p.nsteps; ++si) {
        run_step(p, p.steps[si], smem);
        if (si + 1 < p.nsteps) grid.sync();
    }
}
#else
__global__ __launch_bounds__(512, 2) void step_kernel(Params p, int si) {
    extern __shared__ __attribute__((aligned(16))) char smem[];
    run_step(p, p.steps[si], smem);
}
#endif

extern "C" void kernel_launch(void* const* d_in, const int* in_sizes, int n_in, void* d_out, int out_size, void* d_ws, size_t ws_size, hipStream_t stream) {
    (void)in_sizes; (void)out_size;
    if (n_in < 34 || ws_size < WS_NEED) { fprintf(stderr, "kernel_launch: unexpected inputs (n_in %d, ws %zu < %zu)\n", n_in, ws_size, (size_t)WS_NEED); return; }
    Params p; memset(&p, 0, sizeof(p));
    for (int i = 0; i < 34; ++i) p.in[i] = (const float*)d_in[i];
    p.out = (float*)d_out; p.ws = (char*)d_ws;
    int n = 0;
    auto add = [&](int type, int l, int f) { p.steps[n++] = type | (l << 8) | (f << 16); };
    add(PH_INIT, 0, 0);
    for (int l = 0; l < 4; ++l) {
        add(PH_NORM, l, 0); add(PH_UP, l, 0); add(PH_DOWN, l, 0); add(PH_NORM, l, 1);
        if ((l & 1) == 0) { add(PH_ABIN, l, 0); add(PH_S1, l, 0); add(PH_S2, l, 0); add(PH_S3, l, 0); add(PH_GLU, l, 0); add(PH_G1, l, 0); add(PH_G2, l, 0); add(PH_G3, l, 0); }
        else { add(PH_CDIN, l, 0); add(PH_CH1, l, 0); add(PH_H2, l, 0); add(PH_H3, l, 0); add(PH_H4, l, 0); }
        add(PH_OUT, l, 0); add(PH_NORM, l, 2); add(PH_UP, l, 1); add(PH_DOWN, l, 1);
    }
    add(PH_FINAL, 0, 0);
    p.nsteps = n;
#ifndef MK_MULTI
    static int grid_blocks = 0;
    if (!grid_blocks) {
        int dev = 0, cus = 0, per_cu = 0;
        (void)hipGetDevice(&dev);
        (void)hipDeviceGetAttribute(&cus, hipDeviceAttributeMultiprocessorCount, dev);
        (void)hipFuncSetAttribute((const void*)mega_kernel, hipFuncAttributeMaxDynamicSharedMemorySize, LDS_BYTES);
        (void)hipOccupancyMaxActiveBlocksPerMultiprocessor(&per_cu, mega_kernel, 512, LDS_BYTES);
        if (per_cu < 1) per_cu = 1;
        grid_blocks = cus * per_cu;
    }
    void* args[] = {&p};
    hipError_t e = hipLaunchCooperativeKernel((const void*)mega_kernel, dim3(grid_blocks), dim3(512), args, LDS_BYTES, stream);
    if (e != hipSuccess) fprintf(stderr, "cooperative launch failed: %s (grid %d)\n", hipGetErrorString(e), grid_blocks);
#else
    static int inited = 0;
    if (!inited) { (void)hipFuncSetAttribute((const void*)step_kernel, hipFuncAttributeMaxDynamicSharedMemorySize, LDS_BYTES); inited = 1; }
    for (int si = 0; si < n; ++si) step_kernel<<<256, 512, LDS_BYTES, stream>>>(p, si);
#endif
}
```

```cpp
#include <hip/hip_runtime.h>
#include <hip/hip_cooperative_groups.h>
#include <cstdio>
#include <cstring>
namespace cg = cooperative_groups;

#define DEV __device__ __forceinline__
typedef unsigned short bf16_t;

constexpr int D = 1024, SEQ = 16384, CTXL = 256, NB = 2;
constexpr int NLAT = NB * SEQ;
constexpr int NTOK = NLAT + NB * CTXL;
constexpr int FFN = 2816;
constexpr int ABN = 2816;
constexpr int ABIN = 2576;
constexpr int CDN = 3584;
constexpr int MODW = 9216;
constexpr int NCH = 260;
constexpr int NBC = 65;

constexpr size_t SZ_WUP = (size_t)2 * FFN * D * 2, SZ_WDN = (size_t)D * FFN * 2;
constexpr size_t OFF_WUP = 0;
constexpr size_t OFF_WDN = OFF_WUP + 8 * SZ_WUP;
constexpr size_t OFF_WABIN = OFF_WDN + 8 * SZ_WDN;
constexpr size_t OFF_WCDIN = OFF_WABIN + (size_t)2 * ABN * D * 2;
constexpr size_t OFF_WABOUT = OFF_WCDIN + (size_t)2 * CDN * D * 2;
constexpr size_t OFF_WCDOUT = OFF_WABOUT + (size_t)2 * D * D * 2;
constexpr size_t OFF_WGLU = OFF_WCDOUT + (size_t)2 * D * D * 2;
constexpr size_t OFF_MOD = OFF_WGLU + (size_t)2 * 512 * 512 * 2;
constexpr size_t OFF_LB = OFF_MOD + (size_t)4 * 3 * MODW * 4;
constexpr size_t OFF_DISC = OFF_LB + 8192;
constexpr size_t OFF_H = OFF_DISC + (size_t)8192 * 8 * 4;
constexpr size_t OFF_HN = OFF_H + (size_t)NTOK * D * 4;
constexpr size_t OFF_P = OFF_HN + (size_t)NTOK * D * 2;
constexpr size_t SZ_PAB = (size_t)NTOK * ABN * 2;
constexpr size_t OFF_QN = OFF_P + SZ_PAB;
constexpr size_t OFF_KN = OFF_QN + (size_t)NTOK * 512 * 2;
constexpr size_t SZ_PREG = SZ_PAB + (size_t)2 * NTOK * 512 * 2;
constexpr size_t OFF_SCR = OFF_P + SZ_PREG;
constexpr size_t SCR_T = 0, SCR_QK = (size_t)4160 * 4096 * 2, SCR_GB = 2 * SCR_QK;
constexpr size_t SCR_YB = 0, SCR_CARRY = (size_t)NTOK * 512 * 2;
constexpr size_t SCR_DS = 0, SCR_DD = (size_t)1040 * 16384 * 4;
constexpr size_t SZ_SCR = (size_t)72 * 1024 * 1024;
constexpr size_t OFF_BAR = OFF_SCR + SZ_SCR;
constexpr size_t WS_NEED = OFF_BAR + 16384;
static_assert((size_t)2 * NTOK * 512 * 2 <= (size_t)NLAT * D * 4, "o scratch must fit in d_out");
constexpr size_t OUT_KNT = (size_t)2 * NTOK * 512 * 2;
constexpr size_t OUT_CARRY = OUT_KNT + (size_t)2080 * 8192 * 2;
static_assert(OUT_CARRY + (size_t)128 * 260 * 128 * 4 <= (size_t)NLAT * D * 4, "d_out scratch");
static_assert(SCR_GB + (size_t)4160 * 128 * 4 <= SZ_SCR, "scr");
static_assert(SCR_CARRY + (size_t)128 * 260 * 128 * 4 <= SZ_SCR, "scr");
static_assert(SCR_DD + (size_t)1040 * 128 * 4 <= SZ_SCR, "scr");
static_assert(WS_NEED <= (size_t)737 * 1000 * 1000, "ws");

typedef short s16x8 __attribute__((ext_vector_type(8)));
struct Params { const float* in[34]; float* out; char* ws; int nsteps; int steps[127]; };
enum { I_X = 0, I_C, I_CTX, I_CCTX, I_ADAW, I_ADAB, I_NORMG, I_WUP, I_WDN, I_ABIN, I_ABOUT, I_GCONV, I_GALOG, I_GDT, I_GNG,
       I_LRE, I_LIM, I_LSTEP, I_BRE, I_BIM, I_CRE, I_CIM, I_S5D, I_GLUW, I_GLUB, I_CDIN, I_CDOUT, I_DWW, I_DWB, I_LNG, I_LNB, I_LB, I_HNG, I_FNG };
enum { PH_INIT = 0, PH_NORM, PH_UP, PH_DOWN, PH_ABIN, PH_CDIN, PH_OUT, PH_S1, PH_S2, PH_S3, PH_GLU, PH_G1, PH_G2, PH_G3, PH_CH1, PH_H2, PH_H3, PH_H4, PH_FINAL };

DEV int TID() { int t = threadIdx.x; asm volatile("" : "+v"(t)); return t; }
DEV int PZ() { int z = 0; asm volatile("" : "+s"(z)); return z; }
DEV float bf2f(bf16_t b) { return __uint_as_float(((unsigned)b) << 16); }
typedef float f32x2_ __attribute__((ext_vector_type(2)));
typedef __bf16 bf16x2_ __attribute__((ext_vector_type(2)));
DEV unsigned pack2(float lo, float hi) { const f32x2_ v = {lo, hi}; return __builtin_bit_cast(unsigned, __builtin_convertvector(v, bf16x2_)); }
DEV bf16_t f2bf(float f) { return __builtin_bit_cast(unsigned short, (__bf16)f); }
DEV float sigm(float x) { return __builtin_amdgcn_rcpf(1.f + __expf(-x)); }
DEV float silu(float x) { return x * __builtin_amdgcn_rcpf(1.f + __expf(-x)); }
template <int CTRL> DEV float dpp_f(float v) { return __int_as_float(__builtin_amdgcn_update_dpp(0, __float_as_int(v), CTRL, 0xf, 0xf, true)); }
DEV float sum4(float v) { v += dpp_f<0xB1>(v); v += dpp_f<0x4E>(v); return v; }
DEV float sum8(float v) { v = sum4(v); v += dpp_f<0x141>(v); return v; }
DEV float sum16(float v) { v = sum8(v); v += dpp_f<0x140>(v); return v; }
DEV float wave_sum(float v) {
    v = sum16(v);
    return (__int_as_float(__builtin_amdgcn_readlane(__float_as_int(v), 0)) + __int_as_float(__builtin_amdgcn_readlane(__float_as_int(v), 16))) +
           (__int_as_float(__builtin_amdgcn_readlane(__float_as_int(v), 32)) + __int_as_float(__builtin_amdgcn_readlane(__float_as_int(v), 48)));
}
DEV void lds_barrier() { asm volatile("s_waitcnt lgkmcnt(0)" ::: "memory"); __builtin_amdgcn_s_barrier(); asm volatile("" ::: "memory"); }
DEV int mod_row(int row) { return row < NLAT ? (row >> 14) : 2; }

namespace pg8 {
#define PG8_LAS __attribute__((address_space(3)))
typedef unsigned short bf16_t;
typedef short bf16x8 __attribute__((ext_vector_type(8)));
typedef float f32x4 __attribute__((ext_vector_type(4)));
typedef unsigned u32x4 __attribute__((ext_vector_type(4)));
constexpr int BM = 256, BK = 64, HALF = 128, HTB = HALF * BK * 2  , STAGE_BYTES = 8 * HTB, NXCD = 8, WGM = 4;

__host__ __device__ __forceinline__ int lds_byte(int r, int c) { const int st = (r >> 4) * 2 + (c >> 5), rr = r & 15, cc = c & 31, ob = rr * 64 + cc * 2; return st * 1024 + (ob ^ (((ob >> 9) & 1) << 5)); }
__host__ __device__ __forceinline__ void stage_rc(int b, int& R, int& C) { const int st = b / 1024, sb = b % 1024, swz = sb ^ (((sb >> 9) & 1) << 5); R = (st >> 1) * 16 + swz / 64; C = (st & 1) * 32 + (swz % 64) / 2; }
__host__ __device__ __forceinline__ int perm32(int rho) { const int n = rho >> 4, i = rho & 15; return 8 * (i >> 2) + 4 * n + (i & 3); }

struct Unit { int pm, pn; };
struct Gemm { const bf16_t* A; const bf16_t* Bt; int M, N, K; };
struct StaticOrder {
    int nM, nN, nwg, G, c;
    __host__ __device__ void init(int M, int N, int G_, int c_) { nM = M / BM; nN = N / BM; nwg = nM * nN; G = G_; c = c_; }
    __host__ __device__ bool next(int i, Unit& u) const {
        const long L = (long)i * G + c; if (L >= nwg) return false;
        int wgid = (int)L; { const int q = nwg / NXCD, r = nwg % NXCD, xcd = wgid % NXCD, off = wgid / NXCD; wgid = (xcd < r ? xcd * (q + 1) : r * (q + 1) + (xcd - r) * q) + off; }
        const int nig = WGM * nN, gid = wgid / nig, fm = gid * WGM, gsz = (nM - fm) < WGM ? (nM - fm) : WGM;
        u.pm = fm + ((wgid % nig) % gsz); u.pn = (wgid % nig) / gsz; return true;
    }
    __device__ __forceinline__ void a_ready(const Unit&) const {}
    __device__ __forceinline__ void done(const Unit&) const {}
};
__device__ __forceinline__ unsigned cvt_pk_bf16(float lo, float hi) { unsigned r; asm volatile("v_cvt_pk_bf16_f32 %0, %1, %2" : "=v"(r) : "v"(lo), "v"(hi)); return r; }
template <class Epi, class Sched, bool STAMP = false>
__device__ __forceinline__ void gemm_phase(PG8_LAS unsigned char* lds, const Gemm g, const Sched& S, const Epi& E, unsigned long long* stamps) {
    const int tid = TID(), wid = __builtin_amdgcn_readfirstlane(tid >> 6), lane = tid & 63, wr = wid >> 2, wc = wid & 3, fr = lane & 15, fq = lane >> 4;
    const int K = g.K, nt = K / BK;
    int ts_lo = 0, ts_hi = 0, nts = 0; const unsigned long long rt_entry = STAMP ? (unsigned long long)wall_clock64() : 0ull;
#define PG8_STAMP() do { if (STAMP && wid == 0 && nts < 64) { const unsigned long long _c = (unsigned long long)clock64(); \
        ts_lo = (lane == nts) ? (int)(unsigned)_c : ts_lo; ts_hi = (lane == nts) ? (int)(unsigned)(_c >> 32) : ts_hi; ++nts; } } while (0)
    PG8_STAMP();
    unsigned voffA[2], voffB[2];
#pragma unroll
    for (int i = 0; i < 2; ++i) { int R, C; stage_rc(tid * 16 + i * 8192, R, C); const int Rb = Epi::PERM ? ((R & ~31) + perm32(R & 31)) : R;
        voffA[i] = (unsigned)(R * K + C) * 2u; voffB[i] = (unsigned)(Rb * K + C) * 2u; }
    const size_t kstep = (size_t)(BK * 2);
    const size_t hstep = (size_t)HALF * K * 2;
    const size_t tstep = 2 * hstep;
    const unsigned ldsw = (unsigned)wid * 1024u;
    const int aoff = lds_byte(wr * 64 + fr, fq * 8), boff = lds_byte(wc * 32 + fr, fq * 8);
#define PG8_SA(b, h) (((b) * 2 + (h)) * HTB)
#define PG8_SB(b, h) ((4 + (b) * 2 + (h)) * HTB)
#define PG8_STAGE(bufoff, gbase, voff) do { _Pragma("unroll") for (int _i = 0; _i < 2; ++_i) \
        __builtin_amdgcn_global_load_lds((const unsigned*)((const char*)(gbase) + (voff)[_i]), (PG8_LAS unsigned*)(lds + (bufoff) + ldsw + _i * 8192), 16, 0, 0); } while (0)
#define PG8_LDA(dst, b, h) do { _Pragma("unroll") for (int m = 0; m < 4; ++m) _Pragma("unroll") for (int k = 0; k < 2; ++k) dst[m][k] = *(const PG8_LAS bf16x8*)(lds + PG8_SA(b, h) + aoff + m * 2048 + k * 1024); } while (0)
#define PG8_LDB(dst, b, h) do { _Pragma("unroll") for (int n = 0; n < 2; ++n) _Pragma("unroll") for (int k = 0; k < 2; ++k) dst[n][k] = *(const PG8_LAS bf16x8*)(lds + PG8_SB(b, h) + boff + n * 2048 + k * 1024); } while (0)
#define PG8_MMA(ai, bj, At, Bt) do { __builtin_amdgcn_s_setprio(1); _Pragma("unroll") for (int m = 0; m < 4; ++m) _Pragma("unroll") for (int n = 0; n < 2; ++n) _Pragma("unroll") for (int k = 0; k < 2; ++k) \
        acc[ai][bj][m][n] = __builtin_amdgcn_mfma_f32_16x16x32_bf16(Bt[n][k], At[m][k], acc[ai][bj][m][n], 0, 0, 0); __builtin_amdgcn_s_setprio(0); } while (0)
#define PG8_WAIT_V(n) asm volatile("s_waitcnt vmcnt(" #n ")" ::: "memory")
#define PG8_WAIT_L(n) asm volatile("s_waitcnt lgkmcnt(" #n ")" ::: "memory")
#define PG8_BAR __builtin_amdgcn_s_barrier()
#define PG8_SCHED __builtin_amdgcn_sched_barrier(0)
    Unit cur, nxt; int ui = 0;
    if (!S.next(0, cur)) return;
    f32x4 acc[2][2][4][2];
#pragma unroll
    for (int a = 0; a < 2; ++a)
#pragma unroll
        for (int b = 0; b < 2; ++b)
#pragma unroll
            for (int m = 0; m < 4; ++m)
#pragma unroll
                for (int n = 0; n < 2; ++n) acc[a][b][m][n] = (f32x4){0.f, 0.f, 0.f, 0.f};
    bf16x8 At[4][2], B0[2][2], B1[2][2];
    const char* cA = (const char*)g.A + (size_t)cur.pm * tstep; const char* cB = (const char*)g.Bt + (size_t)cur.pn * tstep;
    S.a_ready(cur);
    PG8_STAGE(PG8_SB(0, 0), cB, voffB); PG8_STAGE(PG8_SA(0, 0), cA, voffA); PG8_STAGE(PG8_SB(0, 1), cB + hstep, voffB); PG8_STAGE(PG8_SA(0, 1), cA + hstep, voffA);
    if (wr == 1) PG8_BAR;
    PG8_WAIT_V(4); PG8_BAR;
    PG8_STAGE(PG8_SB(1, 0), cB + kstep, voffB); PG8_STAGE(PG8_SA(1, 0), cA + kstep, voffA); PG8_STAGE(PG8_SB(1, 1), cB + hstep + kstep, voffB);
    PG8_WAIT_V(6); PG8_BAR;
    PG8_STAMP();
    for (;;) {
        const bool has_next = S.next(ui + 1, nxt);
        const char* nA = has_next ? (const char*)g.A + (size_t)nxt.pm * tstep : cA; const char* nB = has_next ? (const char*)g.Bt + (size_t)nxt.pn * tstep : cB;
        for (int t = 0; t < nt; t += 2) {
            const bool last = (t == nt - 2);
            const char* a1 = cA + (size_t)(t + 1) * kstep;
            const char* a2 = last ? nA : cA + (size_t)(t + 2) * kstep; const char* b2 = last ? nB : cB + (size_t)(t + 2) * kstep;
            const char* a3 = a2 + kstep; const char* b3 = b2 + kstep;
            if (last && has_next) S.a_ready(nxt);
            PG8_LDB(B0, 0, 0); PG8_SCHED; PG8_LDA(At, 0, 0); PG8_STAGE(PG8_SA(1, 1), a1 + hstep, voffA);
            PG8_WAIT_L(8); PG8_BAR; PG8_WAIT_L(0); PG8_MMA(0, 0, At, B0); PG8_BAR; PG8_SCHED;
            PG8_LDB(B1, 0, 1); PG8_STAGE(PG8_SB(0, 0), b2, voffB);
            PG8_BAR; PG8_WAIT_L(0); PG8_MMA(0, 1, At, B1); PG8_BAR;
            PG8_LDA(At, 0, 1); PG8_STAGE(PG8_SA(0, 0), a2, voffA);
            PG8_BAR; PG8_WAIT_L(0); PG8_MMA(1, 0, At, B0); PG8_BAR; PG8_SCHED;
            PG8_STAGE(PG8_SB(0, 1), b2 + hstep, voffB);
            PG8_WAIT_V(6); PG8_BAR; PG8_MMA(1, 1, At, B1); PG8_BAR;
            PG8_LDB(B0, 1, 0); PG8_SCHED; PG8_LDA(At, 1, 0); PG8_STAGE(PG8_SA(0, 1), a2 + hstep, voffA);
            PG8_WAIT_L(8); PG8_BAR; PG8_WAIT_L(0); PG8_MMA(0, 0, At, B0); PG8_BAR; PG8_SCHED;
            PG8_LDB(B1, 1, 1); PG8_STAGE(PG8_SB(1, 0), b3, voffB);
            PG8_BAR; PG8_WAIT_L(0); PG8_MMA(0, 1, At, B1); PG8_BAR;
            PG8_LDA(At, 1, 1); PG8_STAGE(PG8_SA(1, 0), a3, voffA);
            PG8_BAR; PG8_WAIT_L(0); PG8_MMA(1, 0, At, B0); PG8_BAR; PG8_SCHED;
            PG8_STAGE(PG8_SB(1, 1), b3 + hstep, voffB);
            PG8_WAIT_V(6); PG8_BAR; PG8_MMA(1, 1, At, B1); PG8_BAR;
        }
        PG8_STAMP();
        if constexpr (!Epi::AFTER_DRAIN) { E(acc, cur, wr, wc, fr, fq);
#ifdef EPIDUP
            if constexpr (Epi::PERM) { asm volatile("" ::: "memory"); E(acc, cur, wr, wc, fr, fq); }
#endif
            S.done(cur); }
        PG8_STAMP();
        if (!has_next) break;
#pragma unroll
        for (int a = 0; a < 2; ++a)
#pragma unroll
            for (int b = 0; b < 2; ++b)
#pragma unroll
                for (int m = 0; m < 4; ++m)
#pragma unroll
                    for (int n = 0; n < 2; ++n) acc[a][b][m][n] = (f32x4){0.f, 0.f, 0.f, 0.f};
        cur = nxt; cA = nA; cB = nB; ++ui;
    }
    PG8_WAIT_V(0);
    if (wr == 0) PG8_BAR;
    PG8_BAR;
    if constexpr (Epi::AFTER_DRAIN) { E.fused(acc, cur, wr, wc, fr, fq, lds, wid, lane); S.done(cur); }
    PG8_STAMP();
    if (STAMP && wid == 0) { stamps[lane] = lane < nts ? (((unsigned long long)(unsigned)ts_hi << 32) | (unsigned)ts_lo) : 0ull;
        if (lane == 62) stamps[62] = rt_entry; if (lane == 63) stamps[63] = (unsigned long long)wall_clock64(); }
#undef PG8_STAMP
#undef PG8_SA
#undef PG8_SB
#undef PG8_STAGE
#undef PG8_LDA
#undef PG8_LDB
#undef PG8_MMA
#undef PG8_WAIT_V
#undef PG8_WAIT_L
#undef PG8_BAR
#undef PG8_SCHED
}
}

using pg8::f32x4; using pg8::u32x4; using pg8::Unit; using pg8::cvt_pk_bf16;
typedef unsigned u32x2 __attribute__((ext_vector_type(2)));

struct EpiUp {
    static constexpr bool PERM = true, AFTER_DRAIN = false;
    bf16_t* O;
    DEV void operator()(const f32x4 (&acc)[2][2][4][2], const Unit& u, int wr, int wc, int fr, int fq) const {
        const int row0 = u.pm * 256 + wr * 64 + fr, ocol = u.pn * 128 + wc * 32 + 8 * fq;
#pragma unroll
        for (int ai = 0; ai < 2; ++ai)
#pragma unroll
            for (int m = 0; m < 4; ++m) {
                const f32x4 g0 = acc[ai][0][m][0], g1 = acc[ai][0][m][1], v0 = acc[ai][1][m][0], v1 = acc[ai][1][m][1];
                u32x4 w;
                w.x = cvt_pk_bf16(silu(g0[0]) * v0[0], silu(g0[1]) * v0[1]); w.y = cvt_pk_bf16(silu(g0[2]) * v0[2], silu(g0[3]) * v0[3]);
                w.z = cvt_pk_bf16(silu(g1[0]) * v1[0], silu(g1[1]) * v1[1]); w.w = cvt_pk_bf16(silu(g1[2]) * v1[2], silu(g1[3]) * v1[3]);
                *(u32x4*)(O + (size_t)(row0 + ai * 128 + m * 16) * FFN + ocol) = w;
            }
    }
};
struct EpiRes {
    static constexpr bool PERM = false, AFTER_DRAIN = false;
    float* H; const float* gate; float scale;
    DEV void operator()(const f32x4 (&acc)[2][2][4][2], const Unit& u, int wr, int wc, int fr, int fq) const {
        const int row0 = u.pm * 256 + wr * 64 + fr, col0 = u.pn * 256 + wc * 32 + 4 * fq;
        const int r = u.pm < 64 ? 0 : (u.pm < 128 ? 1 : 2);
        f32x4 gv[2][2];
#pragma unroll
        for (int bj = 0; bj < 2; ++bj)
#pragma unroll
            for (int n = 0; n < 2; ++n) gv[bj][n] = *(const f32x4*)(gate + (size_t)r * MODW + col0 + bj * 128 + n * 16) * scale;
#pragma unroll
        for (int ai = 0; ai < 2; ++ai)
#pragma unroll
            for (int m = 0; m < 4; ++m) {
                float* rowp = H + (size_t)(row0 + ai * 128 + m * 16) * D + col0;
#pragma unroll
                for (int bj = 0; bj < 2; ++bj)
#pragma unroll
                    for (int n = 0; n < 2; ++n) { f32x4* q = (f32x4*)(rowp + bj * 128 + n * 16); *q = *q + gv[bj][n] * acc[ai][bj][m][n]; }
            }
    }
};
struct EpiP {
    static constexpr bool PERM = true, AFTER_DRAIN = false;
    bf16_t* O; int ldc;
    DEV void operator()(const f32x4 (&acc)[2][2][4][2], const Unit& u, int wr, int wc, int fr, int fq) const {
        const int row0 = u.pm * 256 + wr * 64 + fr, col0 = u.pn * 256 + wc * 32 + 8 * fq;
#pragma unroll
        for (int ai = 0; ai < 2; ++ai)
#pragma unroll
            for (int m = 0; m < 4; ++m) {
                bf16_t* rowp = O + (size_t)(row0 + ai * 128 + m * 16) * ldc + col0;
#pragma unroll
                for (int bj = 0; bj < 2; ++bj) {
                    const f32x4 v0 = acc[ai][bj][m][0], v1 = acc[ai][bj][m][1];
                    u32x4 w; w.x = cvt_pk_bf16(v0[0], v0[1]); w.y = cvt_pk_bf16(v0[2], v0[3]); w.z = cvt_pk_bf16(v1[0], v1[1]); w.w = cvt_pk_bf16(v1[2], v1[3]);
                    *(u32x4*)(rowp + bj * 128) = w;
                }
            }
    }
};
struct EpiGlu {
    static constexpr bool PERM = true, AFTER_DRAIN = false;
    const bf16_t* Y; const float* bias; bf16_t* O;
    DEV void operator()(const f32x4 (&acc)[2][2][4][2], const Unit& u, int wr, int wc, int fr, int fq) const {
        const int row0 = u.pm * 256 + wr * 64 + fr, col0 = u.pn * 256 + wc * 32 + 8 * fq;
#pragma unroll
        for (int ai = 0; ai < 2; ++ai)
#pragma unroll
            for (int m = 0; m < 4; ++m) {
                const int row = row0 + ai * 128 + m * 16;
#pragma unroll
                for (int bj = 0; bj < 2; ++bj) {
                    const int col = col0 + bj * 128;
                    const u32x4 yv = *(const u32x4*)(Y + (size_t)row * 512 + col);
                    const f32x4 b0 = *(const f32x4*)(bias + col), b1 = *(const f32x4*)(bias + col + 4);
                    const f32x4 v0 = acc[ai][bj][m][0] + b0, v1 = acc[ai][bj][m][1] + b1;
                    float y[8];
#pragma unroll
                    for (int j = 0; j < 4; ++j) { y[2 * j] = __uint_as_float(yv[j] << 16); y[2 * j + 1] = __uint_as_float(yv[j] & 0xffff0000u); }
                    u32x4 w;
                    w.x = cvt_pk_bf16(y[0] * sigm(v0[0]), y[1] * sigm(v0[1])); w.y = cvt_pk_bf16(y[2] * sigm(v0[2]), y[3] * sigm(v0[3]));
                    w.z = cvt_pk_bf16(y[4] * sigm(v1[0]), y[5] * sigm(v1[1])); w.w = cvt_pk_bf16(y[6] * sigm(v1[2]), y[7] * sigm(v1[3]));
                    *(u32x4*)(O + (size_t)row * D + 512 + col) = w;
                }
            }
    }
};

struct EpiPG {
    static constexpr bool PERM = true, AFTER_DRAIN = false;
    bf16_t* O; int ldc;
    DEV void operator()(const f32x4 (&acc)[2][2][4][2], const Unit& u, int wr, int wc, int fr, int fq) const {
        const int row0 = u.pm * 256 + wr * 64 + fr, col0 = u.pn * 256 + wc * 32 + 8 * fq;
        if (u.pn < 4) {
#pragma unroll
            for (int ai = 0; ai < 2; ++ai)
#pragma unroll
                for (int m = 0; m < 4; ++m) {
                    const f32x4 a0 = acc[ai][0][m][0], a1 = acc[ai][0][m][1], g0 = acc[ai][1][m][0], g1 = acc[ai][1][m][1];
                    u32x4 w;
                    w.x = cvt_pk_bf16(a0[0] * sigm(g0[0]), a0[1] * sigm(g0[1])); w.y = cvt_pk_bf16(a0[2] * sigm(g0[2]), a0[3] * sigm(g0[3]));
                    w.z = cvt_pk_bf16(a1[0] * sigm(g1[0]), a1[1] * sigm(g1[1])); w.w = cvt_pk_bf16(a1[2] * sigm(g1[2]), a1[3] * sigm(g1[3]));
                    *(u32x4*)(O + (size_t)(row0 + ai * 128 + m * 16) * ldc + u.pn * 128 + wc * 32 + 8 * fq) = w;
                }
        } else {
#pragma unroll
            for (int ai = 0; ai < 2; ++ai)
#pragma unroll
                for (int m = 0; m < 4; ++m) {
                    bf16_t* rowp = O + (size_t)(row0 + ai * 128 + m * 16) * ldc + col0;
#pragma unroll
                    for (int bj = 0; bj < 2; ++bj) {
                        const f32x4 v0 = acc[ai][bj][m][0], v1 = acc[ai][bj][m][1];
                        u32x4 w; w.x = cvt_pk_bf16(v0[0], v0[1]); w.y = cvt_pk_bf16(v0[2], v0[3]); w.z = cvt_pk_bf16(v1[0], v1[1]); w.w = cvt_pk_bf16(v1[2], v1[3]);
                        *(u32x4*)(rowp + bj * 128) = w;
                    }
                }
        }
    }
};

DEV void convert_job(const float* __restrict__ src, int Nsrc, int K, bf16_t* __restrict__ dst, int Nv, int mode, int& base, float* tile, int bid, int G) {
    const int tid = TID();
    const int tv = Nv / 256, ntiles = (K / 64) * tv;
    const int first = (int)(((long)bid - (long)(base % G) + G) % G);
    for (int t = first; t < ntiles; t += G) {
        const int v0 = (t % tv) * 256, k0 = (t / tv) * 64;
        {
            const int v = tid & 255, kh = (tid >> 8) * 32, vv = v0 + v;
            int sc;
            if (mode == 1) { const int T = vv >> 8, tt = vv & 255; sc = tt < 128 ? 128 * T + tt : FFN + 128 * T + (tt - 128); }
            else if (mode == 2 && vv < 1024) { const int T = vv >> 8, tt = vv & 255; sc = tt < 128 ? 128 * T + tt : 512 + 128 * T + (tt - 128); }
            else sc = vv < Nsrc ? vv : -1;
            float x[32];
#pragma unroll
            for (int i = 0; i < 32; ++i) x[i] = sc >= 0 ? src[(size_t)(k0 + kh + i) * Nsrc + sc] : 0.f;
#pragma unroll
            for (int i = 0; i < 32; ++i) tile[(kh + i) * 257 + v] = x[i];
        }
        __syncthreads();
        {
            const int vo = tid >> 1, kq = (tid & 1) * 32;
#pragma unroll
            for (int q = 0; q < 4; ++q) {
                const int kk = kq + q * 8;
                pg8::u32x4 w;
                w.x = pack2(tile[(kk + 0) * 257 + vo], tile[(kk + 1) * 257 + vo]); w.y = pack2(tile[(kk + 2) * 257 + vo], tile[(kk + 3) * 257 + vo]);
                w.z = pack2(tile[(kk + 4) * 257 + vo], tile[(kk + 5) * 257 + vo]); w.w = pack2(tile[(kk + 6) * 257 + vo], tile[(kk + 7) * 257 + vo]);
                *(pg8::u32x4*)(dst + (size_t)(v0 + vo) * K + k0 + kk) = w;
            }
        }
        __syncthreads();
    }
    base += ntiles;
}

DEV void convert_layer(const Params& p, int l, float* tile, int bid, int G) {
    char* ws = p.ws; int base = 0; const int eo = l >> 1;
    for (int f = 0; f < 2; ++f) {
        const int i = l * 2 + f;
        convert_job(p.in[PZ() + I_WUP] + (size_t)i * D * 2 * FFN, 2 * FFN, D, (bf16_t*)(ws + OFF_WUP + i * SZ_WUP), 2 * FFN, 1, base, tile, bid, G);
        convert_job(p.in[PZ() + I_WDN] + (size_t)i * FFN * D, D, FFN, (bf16_t*)(ws + OFF_WDN + i * SZ_WDN), D, 0, base, tile, bid, G);
    }
    if ((l & 1) == 0) {
        convert_job(p.in[PZ() + I_ABIN] + (size_t)eo * D * ABIN, ABIN, D, (bf16_t*)(ws + OFF_WABIN + (size_t)eo * ABN * D * 2), ABN, 0, base, tile, bid, G);
        convert_job(p.in[PZ() + I_ABOUT] + (size_t)eo * D * D, D, D, (bf16_t*)(ws + OFF_WABOUT + (size_t)eo * D * D * 2), D, 0, base, tile, bid, G);
        convert_job(p.in[PZ() + I_GLUW] + (size_t)eo * 512 * 512, 512, 512, (bf16_t*)(ws + OFF_WGLU + (size_t)eo * 512 * 512 * 2), 512, 0, base, tile, bid, G);
    } else {
        convert_job(p.in[PZ() + I_CDIN] + (size_t)eo * D * CDN, CDN, D, (bf16_t*)(ws + OFF_WCDIN + (size_t)eo * CDN * D * 2), CDN, 2, base, tile, bid, G);
        convert_job(p.in[PZ() + I_CDOUT] + (size_t)eo * D * D, D, D, (bf16_t*)(ws + OFF_WCDOUT + (size_t)eo * D * D * 2), D, 0, base, tile, bid, G);
    }
}

DEV void phase_init(const Params& p, char* smem) {
    const int tid = TID(), G = gridDim.x, bid = blockIdx.x;
    char* ws = p.ws;
    float* tile = (float*)smem;
    convert_layer(p, 0, tile, bid, G);
    {
        float* sc = (float*)smem;
        float* red = sc + 3 * 1024;
        __syncthreads();
        for (int i = tid; i < 3 * 1024; i += 512) { const float v = i < 2048 ? p.in[PZ() + I_C][i] : p.in[PZ() + I_CCTX][i - 2048]; sc[i] = silu(v); }
        __syncthreads();
        float* mod = (float*)(ws + OFF_MOD);
        const int col = tid & 63, ks = tid >> 6;
        for (int u = bid; u < 4 * 144; u += G) {
            const int l = u / 144, cg0 = (u % 144) * 64;
            const float* w = p.in[PZ() + I_ADAW] + ((size_t)l * D + ks * 128) * MODW + cg0 + col;
            float a0 = 0.f, a1 = 0.f, a2 = 0.f;
#pragma unroll 8
            for (int k = 0; k < 128; ++k) { const float wv = w[(size_t)k * MODW]; const int kk = ks * 128 + k; a0 += sc[kk] * wv; a1 += sc[1024 + kk] * wv; a2 += sc[2048 + kk] * wv; }
            red[(ks * 3 + 0) * 64 + col] = a0; red[(ks * 3 + 1) * 64 + col] = a1; red[(ks * 3 + 2) * 64 + col] = a2;
            __syncthreads();
            if (tid < 192) {
                const int r = tid >> 6, cc = tid & 63; float s = p.in[PZ() + I_ADAB][(size_t)l * MODW + cg0 + cc];
#pragma unroll
                for (int k = 0; k < 8; ++k) s += red[(k * 3 + r) * 64 + cc];
                mod[((size_t)l * 3 + r) * MODW + cg0 + cc] = s;
            }
            __syncthreads();
        }
    }
    if (bid == G - 1) {
        float* lb = (float*)(ws + OFF_LB);
        const float a = p.in[PZ() + I_LB][tid], b = p.in[PZ() + I_LB][512 + tid], c = p.in[PZ() + I_LB][1024 + tid];
        const float mx = fmaxf(a, fmaxf(b, c)); const float ea = expf(a - mx), eb = expf(b - mx), ec = expf(c - mx); const float inv = 1.f / (ea + eb + ec);
        lb[tid] = ea * inv; lb[512 + tid] = (ea + eb) * inv; lb[1024 + tid] = 1.f;
    }
    for (int i = (bid + PZ()) * 512 + tid; i < 8192; i += G * 512) {
        const int gidx = i >> 6;
        const double lr = (double)p.in[PZ() + I_LRE][i], li = (double)p.in[PZ() + I_LIM][i], step = exp((double)p.in[PZ() + I_LSTEP][gidx]);
        const double mag = exp(lr * step), ar = mag * cos(li * step), ai = mag * sin(li * step);
        const double den = lr * lr + li * li, nr = ar - 1.0, ni = ai;
        double pr = ar, pi = ai;
#pragma unroll
        for (int q = 0; q < 6; ++q) { const double tr = pr * pr - pi * pi, ti = 2.0 * pr * pi; pr = tr; pi = ti; }
        float* dt = (float*)(ws + OFF_DISC) + (size_t)i * 8;
        dt[0] = (float)ar; dt[1] = (float)ai; dt[2] = (float)((nr * lr + ni * li) / den); dt[3] = (float)((ni * lr - nr * li) / den);
        dt[4] = (float)pr; dt[5] = (float)pi; dt[6] = 0.f; dt[7] = 0.f;
    }
}

DEV void phase_norm(const Params& p, int l, int j) {
    const int tid = TID(), lane = tid & 63, wid = tid >> 6;
    const float* h = (const float*)(p.ws + OFF_H);
    bf16_t* hn = (bf16_t*)(p.ws + OFF_HN);
    const float* g = p.in[PZ() + I_NORMG] + (size_t)(l * 3 + j) * D;
    const float* mod = (const float*)(p.ws + OFF_MOD) + (size_t)l * 3 * MODW;
    const bool first = (l == 0 && j == 0);
    for (int row = blockIdx.x * 8 + wid; row < NTOK; row += gridDim.x * 8) {
        const float* hr = first ? (row < NLAT ? p.in[PZ() + I_X] + (size_t)row * D : p.in[PZ() + I_CTX] + (size_t)(row - NLAT) * D) : h + (size_t)row * D;
        float4 v[4]; float ss = 0.f;
#pragma unroll
        for (int i = 0; i < 4; ++i) { v[i] = *(const float4*)(hr + i * 256 + lane * 4); ss += v[i].x * v[i].x + v[i].y * v[i].y + v[i].z * v[i].z + v[i].w * v[i].w; }
        if (first) {
#pragma unroll
            for (int i = 0; i < 4; ++i) *(float4*)((float*)(p.ws + OFF_H) + (size_t)row * D + i * 256 + lane * 4) = v[i];
        }
        ss = wave_sum(ss);
        const float rstd = rsqrtf(ss * (1.f / D) + 1e-6f);
        const float* m = mod + (size_t)mod_row(row) * MODW + (j * 3) * D;
#pragma unroll
        for (int i = 0; i < 4; ++i) {
            const int c = i * 256 + lane * 4;
            const float4 gg = *(const float4*)(g + c), sh = *(const float4*)(m + c), sc = *(const float4*)(m + D + c);
            u32x2 w;
            w.x = pack2(v[i].x * rstd * gg.x * (1.f + sc.x) + sh.x, v[i].y * rstd * gg.y * (1.f + sc.y) + sh.y);
            w.y = pack2(v[i].z * rstd * gg.z * (1.f + sc.z) + sh.z, v[i].w * rstd * gg.w * (1.f + sc.w) + sh.w);
            *(u32x2*)(hn + (size_t)row * D + c) = w;
        }
    }
}

DEV void phase_final(const Params& p) {
    const int tid = TID(), lane = tid & 63, wid = tid >> 6;
    const float* h = (const float*)(p.ws + OFF_H);
    const float* g = p.in[PZ() + I_FNG];
    for (int row = blockIdx.x * 8 + wid; row < NLAT; row += gridDim.x * 8) {
        const float* hr = h + (size_t)row * D;
        float4 v[4]; float ss = 0.f;
#pragma unroll
        for (int i = 0; i < 4; ++i) { v[i] = *(const float4*)(hr + i * 256 + lane * 4); ss += v[i].x * v[i].x + v[i].y * v[i].y + v[i].z * v[i].z + v[i].w * v[i].w; }
        ss = wave_sum(ss);
        const float rstd = rsqrtf(ss * (1.f / D) + 1e-6f);
#pragma unroll
        for (int i = 0; i < 4; ++i) {
            const int c = i * 256 + lane * 4;
            const float4 gg = *(const float4*)(g + c);
            float4 o; o.x = v[i].x * rstd * gg.x; o.y = v[i].y * rstd * gg.y; o.z = v[i].z * rstd * gg.z; o.w = v[i].w * rstd * gg.w;
            __builtin_nontemporal_store(o.x, p.out + (size_t)row * D + c); __builtin_nontemporal_store(o.y, p.out + (size_t)row * D + c + 1);
            __builtin_nontemporal_store(o.z, p.out + (size_t)row * D + c + 2); __builtin_nontemporal_store(o.w, p.out + (size_t)row * D + c + 3);
        }
    }
}

DEV int stream_row64(int b, int dir, int sc, int s) {
    if (sc < 4) { const int oc = dir ? 3 - sc : sc; return NLAT + b * CTXL + oc * 64 + (dir ? 63 - s : s); }
    const int lc = sc - 4, oc = dir ? 255 - lc : lc; return b * SEQ + oc * 64 + (dir ? 63 - s : s);
}

DEV const float* s5_dt(const Params& p, int e, int dir, int g, int pp) { return (const float*)(p.ws + OFF_DISC) + ((size_t)((e * 2 + dir) * 32 + g) * 64 + pp) * 8; }
DEV void s5_bfrag(const Params& p, int e, int dir, int g, int l15, int lq, s16x8 (&bf)[8]) {
#pragma unroll
    for (int q = 0; q < 4; ++q) {
        const int pp = 16 * q + l15;
        const float* dt = s5_dt(p, e, dir, g, pp); const float cr = dt[2], ci = dt[3];
        const float* br = p.in[PZ() + I_BRE] + ((size_t)(e * 32 + g) * 64 + pp) * 16 + 8 * (lq & 1); const float* bi = p.in[PZ() + I_BIM] + ((size_t)(e * 32 + g) * 64 + pp) * 16 + 8 * (lq & 1);
        const float4 r0 = *(const float4*)br, r1 = *(const float4*)(br + 4), q0 = *(const float4*)bi, q1 = *(const float4*)(bi + 4);
        const float rr[8] = {r0.x, r0.y, r0.z, r0.w, r1.x, r1.y, r1.z, r1.w}, qq[8] = {q0.x, q0.y, q0.z, q0.w, q1.x, q1.y, q1.z, q1.w};
#pragma unroll
        for (int i = 0; i < 8; ++i) {
            const float wre = cr * rr[i] - ci * qq[i], wim = cr * qq[i] + ci * rr[i];
            const bf16_t hre = f2bf(wre), him = f2bf(wim);
            bf[q][i] = (short)(lq < 2 ? hre : f2bf(wre - bf2f(hre)));
            bf[q + 4][i] = (short)(lq < 2 ? him : f2bf(wim - bf2f(him)));
        }
    }
}
template <class RowF> DEV void s5_load_u(const Params& p, bf16_t* us, int gq, RowF rowf) {
    const int tid = TID(), s = tid >> 3, part = tid & 7;
    const bf16_t* P = (const bf16_t*)(p.ws + OFF_P);
    const pg8::u32x4* src = (const pg8::u32x4*)(P + (size_t)rowf(s) * ABN + 2064 + gq * 128 + part * 16);
    pg8::u32x4* dst = (pg8::u32x4*)(us + s * 128 + part * 16);
    dst[0] = src[0]; dst[1] = src[1];
}
DEV void wave_sync() { __builtin_amdgcn_fence(__ATOMIC_RELEASE, "wavefront"); __builtin_amdgcn_wave_barrier(); __builtin_amdgcn_fence(__ATOMIC_ACQUIRE, "wavefront"); }
DEV void s5_bu(const bf16_t* us, int r0, int w, int l15, int lq, const s16x8 (&bf)[8], float* bub) {
    const s16x8 a = *(const s16x8*)(us + (r0 + l15) * 128 + w * 16 + (lq & 1) * 8);
#pragma unroll
    for (int nt = 0; nt < 8; ++nt) {
        f32x4 acc = {0.f, 0.f, 0.f, 0.f};
        acc = __builtin_amdgcn_mfma_f32_16x16x32_bf16(a, bf[nt], acc, 0, 0, 0);
#pragma unroll
        for (int j = 0; j < 4; ++j) bub[(4 * lq + j) * 132 + 16 * nt + l15] = acc[j];
    }
}

DEV void s5_disc(const Params& p, int e, int dir, int g, int pp, float& abr, float& abi, float& cr, float& ci) {
    const int i = ((e * 2 + dir) * 32 + g) * 64 + pp;
    const double lr = (double)p.in[PZ() + I_LRE][i], li = (double)p.in[PZ() + I_LIM][i], step = exp((double)p.in[PZ() + I_LSTEP][(e * 2 + dir) * 32 + g]);
    const double mag = exp(lr * step), ar = mag * cos(li * step), ai = mag * sin(li * step);
    const double den = lr * lr + li * li, nr = ar - 1.0, ni = ai;
    abr = (float)ar; abi = (float)ai; cr = (float)((nr * lr + ni * li) / den); ci = (float)((ni * lr - nr * li) / den);
}
DEV void s5_bbar(const Params& p, int e, int g, int pp, float cr, float ci, float (&bbr)[16], float (&bbi)[16]) {
    const float* br = p.in[PZ() + I_BRE] + ((size_t)(e * 32 + g) * 64 + pp) * 16; const float* bi = p.in[PZ() + I_BIM] + ((size_t)(e * 32 + g) * 64 + pp) * 16;
#pragma unroll
    for (int c4 = 0; c4 < 4; ++c4) {
        const float4 r = *(const float4*)(br + c4 * 4), q = *(const float4*)(bi + c4 * 4);
        bbr[c4 * 4 + 0] = cr * r.x - ci * q.x; bbi[c4 * 4 + 0] = cr * q.x + ci * r.x;
        bbr[c4 * 4 + 1] = cr * r.y - ci * q.y; bbi[c4 * 4 + 1] = cr * q.y + ci * r.y;
        bbr[c4 * 4 + 2] = cr * r.z - ci * q.z; bbi[c4 * 4 + 2] = cr * q.z + ci * r.z;
        bbr[c4 * 4 + 3] = cr * r.w - ci * q.w; bbi[c4 * 4 + 3] = cr * q.w + ci * r.w;
    }
}
DEV void s5_step(const bf16_t* urow, const float (&bbr)[16], const float (&bbi)[16], float abr, float abi, float& hr, float& hi) {
    float bur = 0.f, bui = 0.f;
#pragma unroll
    for (int c8 = 0; c8 < 2; ++c8) {
        const pg8::u32x4 uv = *(const pg8::u32x4*)(urow + c8 * 8);
#pragma unroll
        for (int j = 0; j < 4; ++j) {
            const float u0 = __uint_as_float(uv[j] << 16), u1 = __uint_as_float(uv[j] & 0xffff0000u);
            bur += bbr[c8 * 8 + 2 * j] * u0 + bbr[c8 * 8 + 2 * j + 1] * u1; bui += bbi[c8 * 8 + 2 * j] * u0 + bbi[c8 * 8 + 2 * j + 1] * u1;
        }
    }
    const float nr = abr * hr - abi * hi + bur, ni = abr * hi + abi * hr + bui;
    hr = nr; hi = ni;
}

DEV void phase_s1(const Params& p, int e, char* smem, int first, int stride) {
    const int tid = TID(), lane = tid & 63, w = tid >> 6;
    bf16_t* us = (bf16_t*)smem;
    float2* carry = (float2*)((char*)p.out + OUT_CARRY);
    for (int ib = first; ib < 4 * NCH * 4; ib += stride) {
        const int gq = ib & 3, rest = ib >> 2, sc = rest % NCH, bd = rest / NCH, dir = bd & 1, b = bd >> 1, g = gq * 8 + w;
        __syncthreads();
        s5_load_u(p, us, gq, [&](int s) { return stream_row64(b, dir, sc, s); });
        float abr, abi, cr, ci; s5_disc(p, e, dir, g, lane, abr, abi, cr, ci);
        float bbr[16], bbi[16]; s5_bbar(p, e, g, lane, cr, ci, bbr, bbi);
        __syncthreads();
        float hr = 0.f, hi = 0.f;
        for (int s = 0; s < 64; ++s) s5_step(us + s * 128 + w * 16, bbr, bbi, abr, abi, hr, hi);
        carry[((size_t)((b * 2 + dir) * 32 + g) * NCH + sc) * 64 + lane] = make_float2(hr, hi);
    }
}

DEV void phase_s2(const Params& p, int e, int bid) {
    const int gid = (bid + PZ()) * 512 + TID();
    if (gid < 128 * 64) {
    const int pp = gid & 63, chain = gid >> 6, dir = (chain >> 5) & 1, g = chain & 31;
    const float* dt = s5_dt(p, e, dir, g, pp); const float ar = dt[4], ai = dt[5];
    float2* E = (float2*)((char*)p.out + OUT_CARRY) + (size_t)chain * NCH * 64 + pp;
    float hr = 0.f, hi = 0.f;
    for (int sc = 0; sc < NCH; ++sc) {
        const float2 t = E[(size_t)sc * 64];
        E[(size_t)sc * 64] = make_float2(hr, hi);
        const float nr = ar * hr - ai * hi + t.x, ni = ar * hi + ai * hr + t.y;
        hr = nr; hi = ni;
    }
    }
}

DEV float gelu_tanh(float x) {
    const float z = 0.7978845608028654f * (x + 0.044715f * x * x * x);
    const float t = 1.f - 2.f * __builtin_amdgcn_rcpf(__expf(2.f * z) + 1.f);
    return 0.5f * x * (1.f + t);
}

DEV void phase_s3(const Params& p, int e, char* smem) {
    const int tid = TID(), lane = tid & 63, w = tid >> 6, l15 = lane & 15, lq = lane >> 4;
    bf16_t* us = (bf16_t*)smem;
    float* bub = (float*)(smem + 16384) + (size_t)w * 3200;
    bf16_t* hb = (bf16_t*)(bub + 16 * 132);
    const float2* carry = (const float2*)((char*)p.out + OUT_CARRY);
    bf16_t* ybuf = (bf16_t*)(p.ws + OFF_SCR + SCR_YB);
    for (int ib = blockIdx.x; ib < NB * NCH * 4; ib += gridDim.x) {
        const int gq = ib & 3, rest = ib >> 2, qc = rest % NCH, b = rest / NCH, g = gq * 8 + w;
        const int row0 = qc < 4 ? NLAT + b * CTXL + qc * 64 : b * SEQ + (qc - 4) * 64;
        __syncthreads();
        s5_load_u(p, us, gq, [&](int s) { return row0 + s; });
        s16x8 cm[4];
        {
            const float* cre = p.in[PZ() + I_CRE] + ((size_t)(e * 32 + g) * 16 + l15) * 64; const float* cim = p.in[PZ() + I_CIM] + ((size_t)(e * 32 + g) * 16 + l15) * 64;
#pragma unroll
            for (int ks = 0; ks < 4; ++ks) {
                const float* src = (ks < 2 ? cre : cim) + (32 * ks + 8 * lq) % 64; const float sg = ks < 2 ? 1.f : -1.f;
                const float4 c0 = *(const float4*)src, c1 = *(const float4*)(src + 4);
                cm[ks][0] = (short)f2bf(sg * c0.x); cm[ks][1] = (short)f2bf(sg * c0.y); cm[ks][2] = (short)f2bf(sg * c0.z); cm[ks][3] = (short)f2bf(sg * c0.w);
                cm[ks][4] = (short)f2bf(sg * c1.x); cm[ks][5] = (short)f2bf(sg * c1.y); cm[ks][6] = (short)f2bf(sg * c1.z); cm[ks][7] = (short)f2bf(sg * c1.w);
            }
        }
        f32x4 yacc[4];
#pragma unroll
        for (int i = 0; i < 4; ++i) yacc[i] = (f32x4){0.f, 0.f, 0.f, 0.f};
        __syncthreads();
#pragma unroll
        for (int dir = 0; dir < 2; ++dir) {
            s16x8 bf[8]; s5_bfrag(p, e, dir, g, l15, lq, bf);
            const float* dt = s5_dt(p, e, dir, g, lane); const float abr = dt[0], abi = dt[1];
            const int sc = dir ? (qc < 4 ? 3 - qc : 4 + (255 - (qc - 4))) : qc;
            const float2 h0 = carry[((size_t)((b * 2 + dir) * 32 + g) * NCH + sc) * 64 + lane];
            float hr = h0.x, hi = h0.y;
#pragma unroll
            for (int bi = 0; bi < 4; ++bi) {
                const int blk = dir ? 3 - bi : bi;
                s5_bu(us, blk * 16, w, l15, lq, bf, bub);
                wave_sync();
#pragma unroll
                for (int tt = 0; tt < 16; ++tt) {
                    const int t = dir ? 15 - tt : tt;
                    const float bur = bub[t * 132 + lane], bui = bub[t * 132 + 64 + lane];
                    const float nr = abr * hr - abi * hi + bur, ni = abr * hi + abi * hr + bui; hr = nr; hi = ni;
                    hb[t * 136 + lane] = f2bf(hr); hb[t * 136 + 64 + lane] = f2bf(hi);
                }
                wave_sync();
#pragma unroll
                for (int ks = 0; ks < 4; ++ks) {
                    const s16x8 a = *(const s16x8*)(hb + l15 * 136 + 32 * ks + 8 * lq);
                    yacc[blk] = __builtin_amdgcn_mfma_f32_16x16x32_bf16(a, cm[ks], yacc[blk], 0, 0, 0);
                }
                wave_sync();
            }
        }
        {
            const float dsk = p.in[PZ() + I_S5D][(size_t)e * 512 + g * 16 + l15];
#pragma unroll
            for (int blk = 0; blk < 4; ++blk)
#pragma unroll
                for (int j = 0; j < 4; ++j) {
                    const int t = 16 * blk + 4 * lq + j;
                    const float y = yacc[blk][j] + dsk * bf2f(us[t * 128 + w * 16 + l15]);
                    ybuf[(size_t)(row0 + t) * 512 + g * 16 + l15] = f2bf(gelu_tanh(y));
                }
        }
    }
}

DEV float gdn_conv(const bf16_t* P, const float* cw, int row, int t, int L, int col) {
    float acc = 0.f;
#pragma unroll
    for (int j = 0; j < 5; ++j) { const int tt = t + j - 2; if (tt >= 0 && tt < L) acc += bf2f(P[(size_t)(row + j - 2) * ABN + col]) * cw[j * 1536 + col]; }
    return acc;
}

static_assert(OUT_KNT + (size_t)2080 * 8192 * 2 <= (size_t)NLAT * D * 4, "knT must fit in d_out");

DEV void phase_g1(const Params& p, int e, char* smem) {
    const int tid = TID(), lane = tid & 63, w = tid >> 6;
    float* qs = (float*)smem; float* ks = qs + 64 * 132; float* KKr = ks + 64 * 132; float* QKr = KKr + 64 * 68; float* gcA = QKr + 64 * 68; float* btA = gcA + 128;
    float* As = qs; float* Xs = qs + 64 * 68;
    const bf16_t* P = (const bf16_t*)(p.ws + OFF_P);
    bf16_t* qn = (bf16_t*)(p.ws + OFF_QN); bf16_t* kn = (bf16_t*)(p.ws + OFF_KN); bf16_t* vc = (bf16_t*)(p.ws + OFF_HN);
    bf16_t* knT = (bf16_t*)((char*)p.out + OUT_KNT);
    bf16_t* Tg = (bf16_t*)(p.ws + OFF_SCR + SCR_T); bf16_t* QKg = (bf16_t*)(p.ws + OFF_SCR + SCR_QK); float* gb = (float*)(p.ws + OFF_SCR + SCR_GB);
    const float* cw = p.in[PZ() + I_GCONV] + (size_t)e * 5 * 1536;
    for (int item = blockIdx.x; item < 2080; item += gridDim.x) {
        const int qc = item % NCH, bh = item / NCH, h = bh & 3, b = bh >> 2;
        const int oc = qc < 4 ? qc : qc - 4;
        const int base = qc < 4 ? NLAT + b * CTXL : b * SEQ, L = qc < 4 ? CTXL : SEQ;
        const int sc1 = qc < 4 ? 3 - qc : 4 + (255 - oc);
        lds_barrier();
        {
            for (int ps = 0; ps < 2; ++ps) {
                if (ps == 1 && tid >= 256) break;
                const int pair = ps == 0 ? (tid & 127) : (tid & 63), tg = ps == 0 ? (tid >> 7) : (tid >> 6);
                const int cidx = 2 * pair;
                const int col = ps == 1 ? 1024 + h * 128 + cidx : (cidx < 128 ? h * 128 + cidx : 512 + h * 128 + (cidx - 128));
                float2 wv[5];
#pragma unroll
                for (int j = 0; j < 5; ++j) wv[j] = *(const float2*)(cw + j * 1536 + col);
                auto ld = [&](int n) -> float2 {
                    const int t = oc * 64 + n;
                    if (t < 0 || t >= L) return make_float2(0.f, 0.f);
                    const unsigned raw = *(const unsigned*)(P + (size_t)(base + t) * ABN + col);
                    return make_float2(__uint_as_float(raw << 16), __uint_as_float(raw & 0xffff0000u));
                };
                const int n0 = tg * 16;
                float2 xm2 = ld(n0 - 2), xm1 = ld(n0 - 1), x0 = ld(n0), xp1 = ld(n0 + 1);
#pragma unroll
                for (int i = 0; i < 16; ++i) {
                    const float2 xp2 = ld(n0 + i + 2);
                    const float a0 = xm2.x * wv[0].x + xm1.x * wv[1].x + x0.x * wv[2].x + xp1.x * wv[3].x + xp2.x * wv[4].x;
                    const float a1 = xm2.y * wv[0].y + xm1.y * wv[1].y + x0.y * wv[2].y + xp1.y * wv[3].y + xp2.y * wv[4].y;
                    const int n = n0 + i;
                    if (ps == 0) *(float2*)((cidx < 128 ? qs : ks) + n * 132 + (cidx & 127)) = make_float2(silu(a0), silu(a1));
                    else *(unsigned*)(vc + (size_t)(base + oc * 64 + n) * D + h * 128 + cidx) = pack2(silu(a0), silu(a1));
                    xm2 = xm1; xm1 = x0; x0 = xp1; xp1 = xp2;
                }
            }
        }
        lds_barrier();
        {
            const int vec = tid >> 2, isk = vec >> 6, s = vec & 63, qt = tid & 3;
            float* x = (isk ? ks : qs) + s * 132 + qt * 32;
            float4 v4[8]; float ss = 0.f;
#pragma unroll
            for (int i = 0; i < 8; ++i) { v4[i] = *(const float4*)(x + 4 * i); ss += v4[i].x * v4[i].x + v4[i].y * v4[i].y + v4[i].z * v4[i].z + v4[i].w * v4[i].w; }
            ss = sum4(ss);
            const float scl = rsqrtf(ss + 1e-6f) * (isk ? 1.f : 0.08838834764831845f);
            pg8::u32x4* o = (pg8::u32x4*)((isk ? kn : qn) + (size_t)(base + oc * 64 + s) * 512 + h * 128 + qt * 32);
#pragma unroll
            for (int i = 0; i < 4; ++i) {
                float4 a = v4[2 * i], c = v4[2 * i + 1];
                a.x *= scl; a.y *= scl; a.z *= scl; a.w *= scl; c.x *= scl; c.y *= scl; c.z *= scl; c.w *= scl;
                *(float4*)(x + 8 * i) = a; *(float4*)(x + 8 * i + 4) = c;
                pg8::u32x4 wv; wv.x = pack2(a.x, a.y); wv.y = pack2(a.z, a.w); wv.z = pack2(c.x, c.y); wv.w = pack2(c.z, c.w);
                o[i] = wv;
            }
        }
        if (tid < 128) {
            const int dir = tid >> 6, s = tid & 63, n = dir ? 63 - s : s, row = base + oc * 64 + n;
            const int ci = ((b * 4 + h) * 2 + dir) * NCH + (dir ? sc1 : qc);
            const float a = bf2f(P[(size_t)row * ABN + 2048 + dir * 4 + h]), bb = bf2f(P[(size_t)row * ABN + 2056 + dir * 4 + h]);
            const float x = a + p.in[PZ() + I_GDT][(e * 2 + dir) * 4 + h];
            const float sp = x > 20.f ? x : __logf(1.f + __expf(x));
            float la = -__expf(p.in[PZ() + I_GALOG][(e * 2 + dir) * 4 + h]) * sp;
#pragma unroll
            for (int o = 1; o < 64; o <<= 1) { const float t = __shfl_up(la, o, 64); if (lane >= o) la += t; }
            const float be = sigm(bb);
            gcA[dir * 64 + s] = la; btA[dir * 64 + s] = be; gb[(size_t)ci * 128 + s] = la; gb[(size_t)ci * 128 + 64 + s] = be;
        }
        lds_barrier();
        {
            const int d = tid >> 2, tq = (tid & 3) * 16;
            unsigned o[8];
#pragma unroll
            for (int i = 0; i < 8; ++i) o[i] = pack2(ks[(tq + 2 * i) * 132 + d], ks[(tq + 2 * i + 1) * 132 + d]);
            pg8::u32x4* dst = (pg8::u32x4*)(knT + ((size_t)(bh * NCH + qc) * 128 + d) * 64 + tq);
            pg8::u32x4 w0, w1; w0.x = o[0]; w0.y = o[1]; w0.z = o[2]; w0.w = o[3]; w1.x = o[4]; w1.y = o[5]; w1.z = o[6]; w1.w = o[7];
            dst[0] = w0; dst[1] = w1;
        }
        {
            const int l15 = lane & 15, lq = lane >> 4;
            for (int job = w; job < 26; job += 8) {
                int mi, ni; const bool isq = job >= 10;
                if (isq) { mi = (job - 10) >> 2; ni = (job - 10) & 3; }
                else { mi = job >= 6 ? 3 : (job >= 3 ? 2 : (job >= 1 ? 1 : 0)); ni = job - (mi * (mi + 1)) / 2; }
                const float* X = isq ? qs : ks;
                f32x4 acc = {0.f, 0.f, 0.f, 0.f};
#pragma unroll
                for (int dd = 0; dd < 8; ++dd) {
                    const float4 a4 = *(const float4*)(X + (16 * mi + l15) * 132 + 16 * dd + 4 * lq), b4 = *(const float4*)(ks + (16 * ni + l15) * 132 + 16 * dd + 4 * lq);
                    acc = __builtin_amdgcn_mfma_f32_16x16x4f32(a4.x, b4.x, acc, 0, 0, 0); acc = __builtin_amdgcn_mfma_f32_16x16x4f32(a4.y, b4.y, acc, 0, 0, 0);
                    acc = __builtin_amdgcn_mfma_f32_16x16x4f32(a4.z, b4.z, acc, 0, 0, 0); acc = __builtin_amdgcn_mfma_f32_16x16x4f32(a4.w, b4.w, acc, 0, 0, 0);
                }
                const int jc = 16 * ni + l15;
#pragma unroll
                for (int j = 0; j < 4; ++j) {
                    const int i = 16 * mi + 4 * lq + j;
                    if (isq) QKr[i * 68 + jc] = acc[j];
                    else { KKr[i * 68 + jc] = acc[j]; if (mi != ni) KKr[jc * 68 + i] = acc[j]; }
                }
            }
        }
        lds_barrier();
        for (int dir = 0; dir < 2; ++dir) {
            const int ci = ((b * 4 + h) * 2 + dir) * NCH + (dir ? sc1 : qc);
            const float* gc = gcA + dir * 64; const float* bt = btA + dir * 64;
            {
                const int si = tid >> 3, jg = tid & 7, ni_ = dir ? 63 - si : si;
                const float gi = gc[si], bi = bt[si];
                unsigned o[4];
#pragma unroll
                for (int j2 = 0; j2 < 4; ++j2) {
                    float q2[2];
#pragma unroll
                    for (int jj = 0; jj < 2; ++jj) {
                        const int sj = jg * 8 + j2 * 2 + jj, nj = dir ? 63 - sj : sj;
                        const float dec = sj <= si ? __expf(gi - gc[sj]) : 0.f;
                        As[si * 68 + (sj & 7) * 8 + (sj >> 3)] = sj < si ? KKr[ni_ * 68 + nj] * dec * bi : 0.f;
                        q2[jj] = QKr[ni_ * 68 + nj] * dec;
                    }
                    o[j2] = pack2(q2[0], q2[1]);
                }
                pg8::u32x4 wv; wv.x = o[0]; wv.y = o[1]; wv.z = o[2]; wv.w = o[3];
                *(pg8::u32x4*)(QKg + (size_t)ci * 4096 + si * 64 + jg * 8) = wv;
            }
            lds_barrier();
            {
                const int c = 8 * w + (lane >> 3), part = lane & 7;
                float X[8];
#pragma unroll
                for (int m = 0; m < 8; ++m) X[m] = 0.f;
#pragma unroll
                for (int i = 0; i < 64; ++i) {
                    const float4 a0 = *(const float4*)(As + i * 68 + part * 8), a1 = *(const float4*)(As + i * 68 + part * 8 + 4);
                    float acc = a0.x * X[0] + a0.y * X[1] + a0.z * X[2] + a0.w * X[3] + a1.x * X[4] + a1.y * X[5] + a1.z * X[6] + a1.w * X[7];
                    acc = sum8(acc);
                    const float x = (i == c ? 1.f : 0.f) - acc;
                    if (part == (i & 7)) X[i >> 3] = x;
                }
#pragma unroll
                for (int m = 0; m < 8; ++m) Xs[(part + 8 * m) * 65 + c] = X[m];
            }
            lds_barrier();
            {
                const int i = tid >> 3, jg = tid & 7;
                pg8::u32x4 wv;
                wv.x = pack2(Xs[i * 65 + jg * 8 + 0], Xs[i * 65 + jg * 8 + 1]); wv.y = pack2(Xs[i * 65 + jg * 8 + 2], Xs[i * 65 + jg * 8 + 3]);
                wv.z = pack2(Xs[i * 65 + jg * 8 + 4], Xs[i * 65 + jg * 8 + 5]); wv.w = pack2(Xs[i * 65 + jg * 8 + 6], Xs[i * 65 + jg * 8 + 7]);
                *(pg8::u32x4*)(Tg + (size_t)ci * 4096 + i * 64 + jg * 8) = wv;
            }
            lds_barrier();
        }
    }
}

DEV void phase_g2(const Params& p, int e, char* smem) {
    (void)e;
    const int tid = TID(), lane = tid & 63, w = tid >> 6, l15 = lane & 15, lq = lane >> 4;
    bf16_t* Kc = (bf16_t*)smem; bf16_t* Qc = Kc + 64 * 136; bf16_t* KT = Qc + 64 * 136; bf16_t* Tc = KT + 128 * 72; bf16_t* QKc = Tc + 64 * 72;
    bf16_t* ST = QKc + 64 * 72; bf16_t* rT = ST + 16 * 136; bf16_t* uT = rT + 16 * 72; bf16_t* u2T = uT + 16 * 72;
    float* vS = (float*)(u2T + 16 * 72); float* gc = vS + 64 * 17; float* bt = gc + 64; bf16_t* oS = (bf16_t*)(bt + 64);
    const bf16_t* qn = (const bf16_t*)(p.ws + OFF_QN); const bf16_t* kn = (const bf16_t*)(p.ws + OFF_KN); const bf16_t* vc = (const bf16_t*)(p.ws + OFF_HN);
    const bf16_t* knT = (const bf16_t*)((const char*)p.out + OUT_KNT);
    const bf16_t* Tg = (const bf16_t*)(p.ws + OFF_SCR + SCR_T); const bf16_t* QKg = (const bf16_t*)(p.ws + OFF_SCR + SCR_QK); const float* gb = (const float*)(p.ws + OFF_SCR + SCR_GB);
    bf16_t* ob = (bf16_t*)p.out;
    for (int item = blockIdx.x; item < 128; item += gridDim.x) {
        const int chain = (item & 7) * 2 + ((item >> 3) & 1), e0 = (item >> 4) * 16, dir = chain & 1, h = (chain >> 1) & 3, b = chain >> 3, bh = chain >> 1;
        struct Pf { pg8::u32x4 rk[2], rq[2], rkt[2], rt, rqk; unsigned rv; float rg; };
        Pf R0, R1;
        const int ls = tid >> 3, lp = tid & 7;
        const int kd = tid >> 2, ktq = (tid & 3) * 16;
        auto fetch = [&](Pf& R, int sc) {
            const int ci = chain * NCH + sc, row = stream_row64(b, dir, sc, ls);
            const int oc = sc < 4 ? (dir ? 3 - sc : sc) : (dir ? 255 - (sc - 4) : sc - 4), qc = sc < 4 ? oc : 4 + oc;
            const pg8::u32x4* sk = (const pg8::u32x4*)(kn + (size_t)row * 512 + h * 128 + lp * 16); R.rk[0] = sk[0]; R.rk[1] = sk[1];
            const pg8::u32x4* sq = (const pg8::u32x4*)(qn + (size_t)row * 512 + h * 128 + lp * 16); R.rq[0] = sq[0]; R.rq[1] = sq[1];
            const pg8::u32x4* st = (const pg8::u32x4*)(knT + ((size_t)(bh * NCH + qc) * 128 + kd) * 64 + ktq); R.rkt[0] = st[0]; R.rkt[1] = st[1];
            R.rt = *(const pg8::u32x4*)(Tg + (size_t)ci * 4096 + ls * 64 + lp * 8); R.rqk = *(const pg8::u32x4*)(QKg + (size_t)ci * 4096 + ls * 64 + lp * 8);
            R.rv = *(const unsigned*)(vc + (size_t)row * D + h * 128 + e0 + 2 * lp);
            R.rg = gb[(size_t)ci * 128 + (tid & 127)];
        };
        auto stash = [&](const Pf& R) {
            pg8::u32x4* dk = (pg8::u32x4*)(Kc + ls * 136 + lp * 16); dk[0] = R.rk[0]; dk[1] = R.rk[1];
            pg8::u32x4* dq = (pg8::u32x4*)(Qc + ls * 136 + lp * 16); dq[0] = R.rq[0]; dq[1] = R.rq[1];
            pg8::u32x4* dt = (pg8::u32x4*)(KT + kd * 72 + ktq); dt[0] = R.rkt[0]; dt[1] = R.rkt[1];
            *(pg8::u32x4*)(Tc + ls * 72 + lp * 8) = R.rt; *(pg8::u32x4*)(QKc + ls * 72 + lp * 8) = R.rqk;
            vS[ls * 17 + 2 * lp] = __uint_as_float(R.rv << 16); vS[ls * 17 + 2 * lp + 1] = __uint_as_float(R.rv & 0xffff0000u);
            if (tid < 64) gc[tid] = R.rg; else if (tid < 128) bt[tid - 64] = R.rg;
        };
        f32x4 Sreg = {0.f, 0.f, 0.f, 0.f};
        lds_barrier();
        for (int i = tid; i < 16 * 136 / 2; i += 512) ((unsigned*)ST)[i] = 0u;
        fetch(R0, 0); stash(R0); fetch(R0, 1);
        lds_barrier();
        auto step = [&](int sc) {
            const int sel = w >> 2, mt = w & 3;
            const bf16_t* Xc = sel ? Qc : Kc;
            f32x4 acc = {0.f, 0.f, 0.f, 0.f};
#pragma unroll
            for (int kq = 0; kq < 4; ++kq) {
                const s16x8 a = *(const s16x8*)(Xc + (16 * mt + l15) * 136 + 32 * kq + 8 * lq), bb = *(const s16x8*)(ST + l15 * 136 + 32 * kq + 8 * lq);
                acc = __builtin_amdgcn_mfma_f32_16x16x32_bf16(a, bb, acc, 0, 0, 0);
            }
            const int t0 = 16 * mt + 4 * lq;
            float eg[4];
#pragma unroll
            for (int j = 0; j < 4; ++j) eg[j] = __expf(gc[t0 + j]);
            const float gl = gc[63];
            if (sel == 0) {
                float r[4];
#pragma unroll
                for (int j = 0; j < 4; ++j) r[j] = bt[t0 + j] * (vS[(t0 + j) * 17 + l15] - eg[j] * acc[j]);
                u32x2 wv; wv.x = pack2(r[0], r[1]); wv.y = pack2(r[2], r[3]);
                *(u32x2*)(rT + l15 * 72 + t0) = wv;
            } else {
#pragma unroll
                for (int j = 0; j < 4; ++j) acc[j] *= eg[j];
            }
            lds_barrier();
            if (sel == 0) {
                f32x4 ua = {0.f, 0.f, 0.f, 0.f};
#pragma unroll
                for (int kq = 0; kq < 2; ++kq) {
                    const s16x8 a = *(const s16x8*)(Tc + (16 * mt + l15) * 72 + 32 * kq + 8 * lq), bb = *(const s16x8*)(rT + l15 * 72 + 32 * kq + 8 * lq);
                    ua = __builtin_amdgcn_mfma_f32_16x16x32_bf16(a, bb, ua, 0, 0, 0);
                }
                u32x2 wv; wv.x = pack2(ua[0], ua[1]); wv.y = pack2(ua[2], ua[3]);
                *(u32x2*)(uT + l15 * 72 + t0) = wv;
                float u2[4];
#pragma unroll
                for (int j = 0; j < 4; ++j) u2[j] = __expf(gl - gc[t0 + j]) * ua[j];
                if (dir == 0) { wv.x = pack2(u2[0], u2[1]); wv.y = pack2(u2[2], u2[3]); *(u32x2*)(u2T + l15 * 72 + t0) = wv; }
                else { wv.x = pack2(u2[3], u2[2]); wv.y = pack2(u2[1], u2[0]); *(u32x2*)(u2T + l15 * 72 + (60 - t0)) = wv; }
            }
            lds_barrier();
            if (sel == 1) {
#pragma unroll
                for (int kq = 0; kq < 2; ++kq) {
                    const s16x8 a = *(const s16x8*)(QKc + (16 * mt + l15) * 72 + 32 * kq + 8 * lq), bb = *(const s16x8*)(uT + l15 * 72 + 32 * kq + 8 * lq);
                    acc = __builtin_amdgcn_mfma_f32_16x16x32_bf16(a, bb, acc, 0, 0, 0);
                }
#pragma unroll
                for (int j = 0; j < 4; ++j) oS[(t0 + j) * 16 + l15] = f2bf(acc[j]);
            }
            {
                const float egl = __expf(gl);
#pragma unroll
                for (int j = 0; j < 4; ++j) Sreg[j] *= egl;
#pragma unroll
                for (int kq = 0; kq < 2; ++kq) {
                    const s16x8 a = *(const s16x8*)(u2T + l15 * 72 + 32 * kq + 8 * lq), bb = *(const s16x8*)(KT + (16 * w + l15) * 72 + 32 * kq + 8 * lq);
                    Sreg = __builtin_amdgcn_mfma_f32_16x16x32_bf16(a, bb, Sreg, 0, 0, 0);
                }
#pragma unroll
                for (int j = 0; j < 4; ++j) ST[(4 * lq + j) * 136 + 16 * w + l15] = f2bf(Sreg[j]);
            }
            lds_barrier();
            *(unsigned*)(ob + ((size_t)dir * NTOK + stream_row64(b, dir, sc, ls)) * 512 + h * 128 + e0 + 2 * lp) = *(const unsigned*)(oS + ls * 16 + 2 * lp);
        };
        for (int sc = 0; sc < NCH; sc += 2) {
            fetch(R1, sc + 2 < NCH ? sc + 2 : NCH - 1);
            step(sc);
            stash(R0); lds_barrier();
            fetch(R0, sc + 3 < NCH ? sc + 3 : NCH - 1);
            step(sc + 1);
            stash(R1);
            lds_barrier();
        }
    }
}

DEV void phase_combine(const Params& p, const bf16_t* G, int ldg, int gcol, const float* ng, int ocol, int bfirst, int nblk) {
    const int tid = TID(), lane = tid & 63, wid = tid >> 6;
    const bf16_t* ob = (const bf16_t*)p.out;
    bf16_t* ym = (bf16_t*)(p.ws + OFF_HN);
    const int c0 = lane * 8, d0 = c0 & 127;
    for (int row = bfirst * 8 + wid; row < NTOK; row += nblk * 8) {
        const pg8::u32x4 a = *(const pg8::u32x4*)(ob + (size_t)row * 512 + c0), bq = *(const pg8::u32x4*)(ob + ((size_t)NTOK + row) * 512 + c0);
        const pg8::u32x4 gv = *(const pg8::u32x4*)(G + (size_t)row * ldg + gcol + c0);
        float o[8], gt[8]; float ss = 0.f;
#pragma unroll
        for (int j = 0; j < 4; ++j) {
            o[2 * j] = __uint_as_float(a[j] << 16) + __uint_as_float(bq[j] << 16); o[2 * j + 1] = __uint_as_float(a[j] & 0xffff0000u) + __uint_as_float(bq[j] & 0xffff0000u);
            gt[2 * j] = __uint_as_float(gv[j] << 16); gt[2 * j + 1] = __uint_as_float(gv[j] & 0xffff0000u);
            ss += o[2 * j] * o[2 * j] + o[2 * j + 1] * o[2 * j + 1];
        }
        ss = sum16(ss);
        const float rstd = rsqrtf(ss * (1.f / 128.f) + 1e-6f);
        pg8::u32x4 wv;
        float y[8];
#pragma unroll
        for (int j = 0; j < 8; ++j) y[j] = o[j] * rstd * ng[d0 + j] * silu(gt[j]);
        wv.x = pack2(y[0], y[1]); wv.y = pack2(y[2], y[3]); wv.z = pack2(y[4], y[5]); wv.w = pack2(y[6], y[7]);
        *(pg8::u32x4*)(ym + (size_t)row * D + ocol + c0) = wv;
    }
}

DEV float2 cf_ld(const bf16_t* P, int row, int ch) { const unsigned v = *(const unsigned*)(P + (size_t)row * CDN + ch); return make_float2(__uint_as_float(v << 16), __uint_as_float(v & 0xffff0000u)); }
template <int NOUT, int STRIDE> DEV void cf_task(const bf16_t* P, const float* wl, float2 bias, int rowbase, int pos0, int len, int ch, float* tile, int tok0, int tokstep) {
    float2 x[NOUT + 30];
#pragma unroll
    for (int i = 0; i < NOUT + 30; ++i) {
        const int pp = pos0 - 15 + i;
        const bool ok = pp >= 0 && pp < len;
        x[i] = cf_ld(P, rowbase + (ok ? pp : pos0) * STRIDE, ch);
        x[i].x = ok ? x[i].x : 0.f; x[i].y = ok ? x[i].y : 0.f;
    }
    float2 acc[NOUT];
#pragma unroll
    for (int o = 0; o < NOUT; ++o) acc[o] = make_float2(0.f, 0.f);
#pragma unroll
    for (int j = 0; j < 31; ++j) {
        const float2 wv = *(const float2*)(wl + j * 512 + ch);
#pragma unroll
        for (int o = 0; o < NOUT; ++o) { acc[o].x += x[o + j].x * wv.x; acc[o].y += x[o + j].y * wv.y; }
    }
#pragma unroll
    for (int o = 0; o < NOUT; ++o) *(float2*)(tile + (tok0 + o * tokstep) * 516 + ch) = make_float2(acc[o].x + bias.x, acc[o].y + bias.y);
}
DEV void phase_conformer(const Params& p, int o, char* smem) {
    const int tid = TID(), lane = tid & 63, w = tid >> 6;
    float* tile = (float*)smem;
    const bf16_t* P = (const bf16_t*)(p.ws + OFF_P);
    bf16_t* ym = (bf16_t*)(p.ws + OFF_HN);
    const float* dw = p.in[PZ() + I_DWW] + (size_t)o * 31 * 512;
    const int pair = tid & 127, sub = tid >> 7, chW = 2 * pair, chV = 256 + 2 * pair;
    float* wl = tile + 32 * 516;
    __syncthreads();
    for (int i = tid; i < 31 * 512; i += 512) wl[i] = dw[i];
    const float2 bW = *(const float2*)(p.in[PZ() + I_DWB] + (size_t)o * 512 + chW), bV = *(const float2*)(p.in[PZ() + I_DWB] + (size_t)o * 512 + chV);
    for (int it = blockIdx.x; it < 1040; it += gridDim.x) {
        __syncthreads();
        int rowtok0, rowstep_r;
        if (it < 1024) {
            const int b = it >> 9, r0 = ((it >> 3) & 63) * 4, w0 = (it & 7) * 8;
            cf_task<8, 1>(P, wl, bW, b * SEQ + (r0 + sub) * 64, w0, 64, chW, tile, sub * 8, 1);
#pragma unroll
            for (int k = 0; k < 2; ++k) { const int ww = 2 * sub + k; cf_task<4, 64>(P, wl, bV, b * SEQ + w0 + ww, r0, 256, chV, tile, ww, 8); }
            rowtok0 = b * SEQ + r0 * 64 + w0; rowstep_r = 64;
        } else {
            const int ci = it - 1024, b = ci >> 3, t0 = (ci & 7) * 32;
            cf_task<8, 1>(P, wl, bW, NLAT + b * CTXL, t0 + sub * 8, CTXL, chW, tile, sub * 8, 1);
            cf_task<8, 1>(P, wl, bV, NLAT + b * CTXL, t0 + sub * 8, CTXL, chV, tile, sub * 8, 1);
            rowtok0 = NLAT + b * CTXL + t0; rowstep_r = 8;
        }
        __syncthreads();
        const float* lg = p.in[PZ() + I_LNG] + (size_t)o * 512 + lane * 8; const float* lbb = p.in[PZ() + I_LNB] + (size_t)o * 512 + lane * 8;
        for (int q = 0; q < 4; ++q) {
            const int tok = w * 4 + q, orow = rowtok0 + (tok >> 3) * rowstep_r + (tok & 7);
            const float4 v0 = *(const float4*)(tile + tok * 516 + lane * 8), v1 = *(const float4*)(tile + tok * 516 + lane * 8 + 4);
            float x[8] = {v0.x, v0.y, v0.z, v0.w, v1.x, v1.y, v1.z, v1.w};
            float s = 0.f;
#pragma unroll
            for (int j = 0; j < 8; ++j) s += x[j];
            const float mean = wave_sum(s) * (1.f / 512.f);
            float vs = 0.f;
#pragma unroll
            for (int j = 0; j < 8; ++j) { x[j] -= mean; vs += x[j] * x[j]; }
            const float rstd = rsqrtf(wave_sum(vs) * (1.f / 512.f) + 1e-6f);
            float y[8];
#pragma unroll
            for (int j = 0; j < 8; ++j) y[j] = silu(x[j] * rstd * lg[j] + lbb[j]);
            pg8::u32x4 wv; wv.x = pack2(y[0], y[1]); wv.y = pack2(y[2], y[3]); wv.z = pack2(y[4], y[5]); wv.w = pack2(y[6], y[7]);
            *(pg8::u32x4*)(ym + (size_t)orow * D + lane * 8) = wv;
        }
    }
}

DEV int hgrn_row(int b, int dir, int bc, int s) {
    if (bc == 0) return NLAT + b * CTXL + (dir ? 255 - s : s);
    const int lc = bc - 1, oc = dir ? 63 - lc : lc; return b * SEQ + oc * 256 + (dir ? 255 - s : s);
}
DEV void phase_h1(const Params& p, int o, char* smem, int skew) {
    const int tid = TID(), lane = tid & 63, w = tid >> 6, l15 = lane & 15, lq = lane >> 4;
    bf16_t* kT = (bf16_t*)smem; bf16_t* vT = kT + 128 * 264; float* seg = (float*)(vT + 128 * 264);
    const bf16_t* P = (const bf16_t*)(p.ws + OFF_P);
    float* dS = (float*)(p.ws + OFF_SCR + SCR_DS); float* Dd = (float*)(p.ws + OFF_SCR + SCR_DD);
    const float* lball = (const float*)(p.ws + OFF_LB) + (size_t)o * 512;
    const int d = tid & 127, tq = tid >> 7;
    for (int it = (int)((blockIdx.x + gridDim.x - skew % gridDim.x) % gridDim.x); it < 16 * NBC; it += gridDim.x) {
        const int chain = it / NBC, bc = it % NBC, dir = chain & 1, h = (chain >> 1) & 3, b = chain >> 3;
        const float lb = lball[h * 128 + d];
        const size_t cf = (size_t)1024 + 512 + dir * 512 + h * 128 + d, cv = (size_t)1024 + 1536 + h * 128 + d;
        lds_barrier();
        float sum = 0.f;
        for (int i8 = 0; i8 < 8; ++i8) {
            unsigned o8[4];
#pragma unroll
            for (int j2 = 0; j2 < 4; ++j2) {
                const size_t r0 = (size_t)hgrn_row(b, dir, bc, tq * 64 + i8 * 8 + 2 * j2) * CDN, r1 = (size_t)hgrn_row(b, dir, bc, tq * 64 + i8 * 8 + 2 * j2 + 1) * CDN;
                const float f0 = lb + (1.f - lb) * sigm(bf2f(P[r0 + cf])), f1 = lb + (1.f - lb) * sigm(bf2f(P[r1 + cf]));
                sum += __logf(f0) + __logf(f1);
                o8[j2] = (unsigned)P[r0 + cv] | ((unsigned)P[r1 + cv] << 16);
            }
            pg8::u32x4 wv; wv.x = o8[0]; wv.y = o8[1]; wv.z = o8[2]; wv.w = o8[3];
            *(pg8::u32x4*)(vT + d * 264 + tq * 64 + i8 * 8) = wv;
        }
        seg[tq * 128 + d] = sum;
        lds_barrier();
        float r = 0.f;
        for (int q = tq + 1; q < 4; ++q) r += seg[q * 128 + d];
        for (int i8 = 7; i8 >= 0; --i8) {
            float ko[8];
#pragma unroll
            for (int j = 7; j >= 0; --j) {
                const size_t r0 = (size_t)hgrn_row(b, dir, bc, tq * 64 + i8 * 8 + j) * CDN;
                const float f = lb + (1.f - lb) * sigm(bf2f(P[r0 + cf]));
                ko[j] = (1.f - f) * __expf(r); r += __logf(f);
            }
            pg8::u32x4 wv; wv.x = pack2(ko[0], ko[1]); wv.y = pack2(ko[2], ko[3]); wv.z = pack2(ko[4], ko[5]); wv.w = pack2(ko[6], ko[7]);
            *(pg8::u32x4*)(kT + d * 264 + tq * 64 + i8 * 8) = wv;
        }
        if (tq == 0) Dd[(size_t)it * 128 + d] = __expf(seg[d] + seg[128 + d] + seg[256 + d] + seg[384 + d]);
        lds_barrier();
        s16x8 af[8];
#pragma unroll
        for (int kq = 0; kq < 8; ++kq) af[kq] = *(const s16x8*)(vT + (16 * w + l15) * 264 + 32 * kq + 8 * lq);
        for (int ni = 0; ni < 8; ++ni) {
            f32x4 acc = {0.f, 0.f, 0.f, 0.f};
#pragma unroll
            for (int kq = 0; kq < 8; ++kq) { const s16x8 bb = *(const s16x8*)(kT + (16 * ni + l15) * 264 + 32 * kq + 8 * lq); acc = __builtin_amdgcn_mfma_f32_16x16x32_bf16(af[kq], bb, acc, 0, 0, 0); }
#pragma unroll
            for (int j = 0; j < 4; ++j) dS[(size_t)it * 16384 + (16 * w + 4 * lq + j) * 128 + 16 * ni + l15] = acc[j];
        }
    }
}
DEV void phase_h2(const Params& p) {
    float* dS = (float*)(p.ws + OFF_SCR + SCR_DS); const float* Dd = (const float*)(p.ws + OFF_SCR + SCR_DD);
    for (int idx = ((int)blockIdx.x + PZ()) * 512 + TID(); idx < 16 * 16384; idx += gridDim.x * 512) {
        const int chain = idx >> 14, de = idx & 16383, d = de & 127;
        float S = 0.f;
        for (int bc = 0; bc < NBC; ++bc) {
            const size_t it = (size_t)chain * NBC + bc;
            const float t = dS[it * 16384 + de];
            dS[it * 16384 + de] = S;
            S = Dd[it * 128 + d] * S + t;
        }
    }
}
DEV void phase_h3(const Params& p, int o, char* smem, bool skipctx) {
    const int tid = TID(), lane = tid & 63, w = tid >> 6, l15 = lane & 15, lq = lane >> 4;
    bf16_t* STb = (bf16_t*)smem; bf16_t* qin = STb + 128 * 136; bf16_t* kin = qin + 32 * 136; bf16_t* koT = kin + 32 * 136; bf16_t* vT = koT + 128 * 40; bf16_t* att = vT + 128 * 40;
    float* seg = (float*)(att + 32 * 40); float* cdv = seg + 512;
    const bf16_t* P = (const bf16_t*)(p.ws + OFF_P);
    const float* dS = (const float*)(p.ws + OFF_SCR + SCR_DS);
    bf16_t* ob = (bf16_t*)p.out;
    const float* lball = (const float*)(p.ws + OFF_LB) + (size_t)o * 512;
    const int d = tid & 127, tq = tid >> 7;
    const int nitems = skipctx ? 16 * (NBC - 1) : 16 * NBC;
    for (int it0 = blockIdx.x; it0 < nitems; it0 += gridDim.x) {
        const int chain = skipctx ? it0 / (NBC - 1) : it0 / NBC, bc = skipctx ? 1 + it0 % (NBC - 1) : it0 % NBC, it = chain * NBC + bc;
        const int dir = chain & 1, h = (chain >> 1) & 3, b = chain >> 3;
        const float lb = lball[h * 128 + d];
        f32x4 Sacc[8];
#pragma unroll
        for (int ni = 0; ni < 8; ++ni)
#pragma unroll
            for (int j = 0; j < 4; ++j) Sacc[ni][j] = dS[(size_t)it * 16384 + (16 * w + 4 * lq + j) * 128 + 16 * ni + l15];
        lds_barrier();
#pragma unroll
        for (int ni = 0; ni < 8; ++ni)
#pragma unroll
            for (int j = 0; j < 4; ++j) STb[(16 * w + 4 * lq + j) * 136 + 16 * ni + l15] = f2bf(Sacc[ni][j]);
        unsigned rf[8], rq[8], rv[8];
        auto fetch = [&](int sub) {
#pragma unroll
            for (int i = 0; i < 8; ++i) {
                const size_t rb = (size_t)hgrn_row(b, dir, bc, sub * 32 + tq * 8 + i) * CDN + 1024 + h * 128 + d;
                rf[i] = P[rb + 512 + dir * 512]; rq[i] = P[rb]; rv[i] = P[rb + 1536];
            }
        };
        fetch(0);
        for (int sub = 0; sub < 8; ++sub) {
            float f[8], c[8]; float run = 0.f;
#pragma unroll
            for (int i = 0; i < 8; ++i) { f[i] = lb + (1.f - lb) * sigm(__uint_as_float(rf[i] << 16)); run += __logf(f[i]); c[i] = run; }
            seg[tq * 128 + d] = run;
            { pg8::u32x4 wv; wv.x = rv[0] | (rv[1] << 16); wv.y = rv[2] | (rv[3] << 16); wv.z = rv[4] | (rv[5] << 16); wv.w = rv[6] | (rv[7] << 16); *(pg8::u32x4*)(vT + d * 40 + tq * 8) = wv; }
            lds_barrier();
            float pre = 0.f, tot = 0.f;
#pragma unroll
            for (int q = 0; q < 4; ++q) { const float sv = seg[q * 128 + d]; tot += sv; if (q < tq) pre += sv; }
            float ko[8];
#pragma unroll
            for (int i = 0; i < 8; ++i) {
                const float bcv = pre + c[i], eb = __expf(bcv), ieb = __expf(-bcv), k1 = 1.f - f[i];
                qin[(tq * 8 + i) * 136 + d] = f2bf(__uint_as_float(rq[i] << 16) * eb);
                kin[(tq * 8 + i) * 136 + d] = f2bf(k1 * ieb);
                ko[i] = k1 * __expf(tot - bcv);
            }
            { pg8::u32x4 wv; wv.x = pack2(ko[0], ko[1]); wv.y = pack2(ko[2], ko[3]); wv.z = pack2(ko[4], ko[5]); wv.w = pack2(ko[6], ko[7]); *(pg8::u32x4*)(koT + d * 40 + tq * 8) = wv; }
            if (tq == 0) cdv[d] = __expf(tot);
            fetch(sub + 1 < 8 ? sub + 1 : 7);
            lds_barrier();
            f32x4 oacc[2] = {{0.f, 0.f, 0.f, 0.f}, {0.f, 0.f, 0.f, 0.f}};
#pragma unroll
            for (int kq = 0; kq < 4; ++kq) {
                const s16x8 bb = *(const s16x8*)(STb + (16 * w + l15) * 136 + 32 * kq + 8 * lq);
#pragma unroll
                for (int mi = 0; mi < 2; ++mi) { const s16x8 a = *(const s16x8*)(qin + (16 * mi + l15) * 136 + 32 * kq + 8 * lq); oacc[mi] = __builtin_amdgcn_mfma_f32_16x16x32_bf16(a, bb, oacc[mi], 0, 0, 0); }
            }
            if (w < 4) {
                const int mi = w >> 1, nj = w & 1;
                f32x4 at = {0.f, 0.f, 0.f, 0.f};
                if (!(mi == 0 && nj == 1)) {
#pragma unroll
                    for (int kq = 0; kq < 4; ++kq) {
                        const s16x8 a = *(const s16x8*)(qin + (16 * mi + l15) * 136 + 32 * kq + 8 * lq), bb = *(const s16x8*)(kin + (16 * nj + l15) * 136 + 32 * kq + 8 * lq);
                        at = __builtin_amdgcn_mfma_f32_16x16x32_bf16(a, bb, at, 0, 0, 0);
                    }
                }
#pragma unroll
                for (int jj = 0; jj < 4; ++jj) { const int t = 16 * mi + 4 * lq + jj, j = 16 * nj + l15; att[t * 40 + j] = f2bf(j <= t ? at[jj] : 0.f); }
            }
            lds_barrier();
            const s16x8 vb = *(const s16x8*)(vT + (16 * w + l15) * 40 + 8 * lq);
#pragma unroll
            for (int mi = 0; mi < 2; ++mi) {
                const s16x8 a = *(const s16x8*)(att + (16 * mi + l15) * 40 + 8 * lq);
                oacc[mi] = __builtin_amdgcn_mfma_f32_16x16x32_bf16(a, vb, oacc[mi], 0, 0, 0);
#pragma unroll
                for (int jj = 0; jj < 4; ++jj)
                    ob[((size_t)dir * NTOK + hgrn_row(b, dir, bc, sub * 32 + 16 * mi + 4 * lq + jj)) * 512 + h * 128 + 16 * w + l15] = f2bf(oacc[mi][jj]);
            }
#pragma unroll
            for (int ni = 0; ni < 8; ++ni) {
                const float cd = cdv[16 * ni + l15];
#pragma unroll
                for (int j = 0; j < 4; ++j) Sacc[ni][j] *= cd;
                const s16x8 bb = *(const s16x8*)(koT + (16 * ni + l15) * 40 + 8 * lq);
                Sacc[ni] = __builtin_amdgcn_mfma_f32_16x16x32_bf16(vb, bb, Sacc[ni], 0, 0, 0);
#pragma unroll
                for (int j = 0; j < 4; ++j) STb[(16 * w + 4 * lq + j) * 136 + 16 * ni + l15] = f2bf(Sacc[ni][j]);
            }
            lds_barrier();
        }
    }
}

#define XB_TMO      128
#define XB_XCNT(j)  (256  + 64 * (j))
#define XB_XSUB(j)  (1280 + 64 * (j))
#define XB_XGEN(j)  (2304 + 64 * (j))
#define XB_TOP      3328
#define XB_TOPGEN   3392
#define XCD_BAR_WORDS 3456
#define XB_SPIN_CAP (1u << 18)
#define XLAS __attribute__((address_space(3)))
__device__ __forceinline__ unsigned xb_ld(unsigned* p)              { return __hip_atomic_load(p, __ATOMIC_RELAXED, __HIP_MEMORY_SCOPE_AGENT); }
__device__ __forceinline__ unsigned xb_add(unsigned* p, unsigned v) { return __hip_atomic_fetch_add(p, v, __ATOMIC_RELAXED, __HIP_MEMORY_SCOPE_AGENT); }
__device__ __forceinline__ unsigned xb_xcc_id() { return (unsigned)__builtin_amdgcn_s_getreg((3 << 11) | 20) & 0xFu; }
#define XB_SPIN(cond, bar) do { unsigned _sp = 0; while (cond) { __builtin_amdgcn_s_sleep(1); \
    if ((++_sp & 255u) == 0u) { if (xb_ld(&(bar)[XB_TMO])) break; if (_sp > XB_SPIN_CAP) { atomicAdd(&(bar)[XB_TMO], 1u); break; } } } } while (0)

struct XcdBarrier {
    unsigned* bar; unsigned x;
    volatile XLAS unsigned* st;
};

__device__ __forceinline__ XcdBarrier xcd_barrier_post(unsigned* bar, volatile XLAS unsigned* st) {
    XcdBarrier b; b.bar = bar; b.x = xb_xcc_id(); b.st = st;
    if (threadIdx.x == 0) (void)xb_add(&bar[XB_XCNT(b.x)], 1u);
    return b;
}
__device__ __forceinline__ void xcd_barrier_complete(unsigned* bar, unsigned x, unsigned& nloc, unsigned& nx) {
    const unsigned G = gridDim.x * gridDim.y * gridDim.z;
    unsigned sum, cnt, mine, sp = 0u;
    for (;;) {
        sum = 0u; cnt = 0u; mine = 0u;
#pragma unroll
        for (unsigned j = 0; j < 16; ++j) { const unsigned c = xb_ld(&bar[XB_XCNT(j)]); sum += c; cnt += (c > 0u) ? 1u : 0u; mine = (j == x) ? c : mine; }
        if (sum == G) break;
        __builtin_amdgcn_s_sleep(1);
        if ((++sp & 255u) == 0u) { if (xb_ld(&bar[XB_TMO])) break; if (sp > XB_SPIN_CAP) { atomicAdd(&bar[XB_TMO], 1u); break; } }
    }
    nloc = mine > 0u ? mine : 1u; nx = cnt > 0u ? cnt : 1u;
}

__device__ __forceinline__ void xcd_barrier(const XcdBarrier& b) {
    asm volatile("s_waitcnt vmcnt(0)" ::: "memory");
    __syncthreads();
    if (threadIdx.x == 0) {
        unsigned* bar = b.bar;
        __builtin_amdgcn_s_waitcnt(0);
        unsigned nloc = b.st[0], nx = b.st[1];
        if (nloc == 0u) { xcd_barrier_complete(bar, b.x, nloc, nx); b.st[0] = nloc; b.st[1] = nx; }
        const unsigned old = xb_add(&bar[XB_XSUB(b.x)], 1u);
        const unsigned gen = old / nloc;
        if (old + 1u == (gen + 1u) * nloc) {
            __builtin_amdgcn_fence(__ATOMIC_RELEASE, "agent");
            asm volatile("s_waitcnt vmcnt(0)" ::: "memory");
            const unsigned og = xb_add(&bar[XB_TOP], 1u);
            const unsigned tg = og / nx;
            if (og + 1u == (tg + 1u) * nx) xb_add(&bar[XB_TOPGEN], 1u);
            else XB_SPIN(xb_ld(&bar[XB_TOPGEN]) == tg, bar);
            __builtin_amdgcn_fence(__ATOMIC_ACQUIRE, "agent");
            xb_add(&bar[XB_XGEN(b.x)], 1u);
            asm volatile("s_waitcnt vmcnt(0)" ::: "memory");
        } else {
            XB_SPIN(xb_ld(&bar[XB_XGEN(b.x)]) == gen, bar);
            __builtin_amdgcn_fence(__ATOMIC_ACQUIRE, "agent");
            asm volatile("s_waitcnt vmcnt(0)" ::: "memory");
        }
    }
    __syncthreads();
}


__device__ __forceinline__ void sub_arrive_wait(unsigned* cnt, unsigned target, bool wait) {
    asm volatile("s_waitcnt vmcnt(0)" ::: "memory");
    __syncthreads();
    if (threadIdx.x == 0) {
        __builtin_amdgcn_fence(__ATOMIC_RELEASE, "agent");
        asm volatile("s_waitcnt vmcnt(0)" ::: "memory");
        (void)xb_add(cnt, 1u);
        if (wait) {
            unsigned sp = 0u;
            while (xb_ld(cnt) < target) { __builtin_amdgcn_s_sleep(2); if (++sp > (1u << 22)) break; }
            __builtin_amdgcn_fence(__ATOMIC_ACQUIRE, "agent");
            asm volatile("s_waitcnt vmcnt(0)" ::: "memory");
        }
    }
    __syncthreads();
}

constexpr int LDS_BYTES = 155648;

template <class Epi> DEV void run_gemm(char* smem, const bf16_t* A, const bf16_t* Bt, int N, int K, const Epi& E, int M = NTOK) {
    pg8::Gemm g{A, Bt, M, N, K};
    pg8::StaticOrder S; S.init(M, N, (int)gridDim.x, (int)blockIdx.x);
    pg8::gemm_phase<Epi, pg8::StaticOrder, false>((PG8_LAS unsigned char*)smem, g, S, E, nullptr);
}


DEV void ctx_res_gemm(const Params& p, const bf16_t* A, const bf16_t* Wt, int K, const float* gate, float scale) {
    const int tid = TID(), lane = tid & 63, w = tid >> 6, l15 = lane & 15, lq = lane >> 4;
    const int rt = blockIdx.x >> 4, ct = blockIdx.x & 15;
    const int row0 = NLAT + rt * 32 + (w >> 2) * 16, col0 = ct * 64 + (w & 3) * 16;
    const bf16_t* ap = A + (size_t)(row0 + l15) * K + 8 * lq;
    const bf16_t* bp = Wt + (size_t)(col0 + l15) * K + 8 * lq;
    f32x4 acc0 = {0.f, 0.f, 0.f, 0.f}, acc1 = {0.f, 0.f, 0.f, 0.f};
    for (int k0 = 0; k0 < K; k0 += 256) {
        s16x8 a[8], bq[8];
#pragma unroll
        for (int q = 0; q < 8; ++q) { a[q] = *(const s16x8*)(ap + k0 + 32 * q); bq[q] = *(const s16x8*)(bp + k0 + 32 * q); }
#pragma unroll
        for (int q = 0; q < 8; q += 2) {
            acc0 = __builtin_amdgcn_mfma_f32_16x16x32_bf16(a[q], bq[q], acc0, 0, 0, 0);
            acc1 = __builtin_amdgcn_mfma_f32_16x16x32_bf16(a[q + 1], bq[q + 1], acc1, 0, 0, 0);
        }
    }
    float* H = (float*)(p.ws + OFF_H);
    const float gv = gate[(size_t)2 * MODW + col0 + l15] * scale;
#pragma unroll
    for (int j = 0; j < 4; ++j) { float* q = H + (size_t)(row0 + 4 * lq + j) * D + col0 + l15; *q = *q + gv * (acc0[j] + acc1[j]); }
}


DEV void run_step(const Params& p, int st, char* smem) {
    const int type = st & 255, l = (st >> 8) & 255, f = st >> 16, eo = l >> 1;
    char* ws = p.ws;
    const float* mod = (const float*)(ws + OFF_MOD) + (size_t)l * 3 * MODW;
#ifdef ONLY
    if (type != ONLY) return;
#endif
    switch (type) {
    case PH_INIT: phase_init(p, smem); break;
    case PH_NORM: phase_norm(p, l, f); break;
    case PH_UP: { EpiUp E{(bf16_t*)(ws + OFF_P)}; run_gemm(smem, (const bf16_t*)(ws + OFF_HN), (const bf16_t*)(ws + OFF_WUP + (size_t)(l * 2 + f) * SZ_WUP), 2 * FFN, D, E, (l == 3 && f == 1) ? NLAT : NTOK); } break;
    case PH_DOWN: { EpiRes E{(float*)(ws + OFF_H), mod + ((f ? 2 : 0) * 3 + 2) * D, 0.5f}; run_gemm(smem, (const bf16_t*)(ws + OFF_P), (const bf16_t*)(ws + OFF_WDN + (size_t)(l * 2 + f) * SZ_WDN), D, FFN, E, ((l == 3 && f == 1) || gridDim.x == 256) ? NLAT : NTOK);
        if (gridDim.x == 256 && !(l == 3 && f == 1)) ctx_res_gemm(p, (const bf16_t*)(ws + OFF_P), (const bf16_t*)(ws + OFF_WDN + (size_t)(l * 2 + f) * SZ_WDN), FFN, mod + ((f ? 2 : 0) * 3 + 2) * D, 0.5f);
        if (f == 1 && l < 3) { __syncthreads(); convert_layer(p, l + 1, (float*)smem, (int)blockIdx.x, (int)gridDim.x); }
    } break;
    case PH_ABIN: { EpiP E{(bf16_t*)(ws + OFF_P), ABN}; run_gemm(smem, (const bf16_t*)(ws + OFF_HN), (const bf16_t*)(ws + OFF_WABIN + (size_t)eo * ABN * D * 2), ABN, D, E); } break;
    case PH_CDIN: { EpiPG E{(bf16_t*)(ws + OFF_P), CDN}; run_gemm(smem, (const bf16_t*)(ws + OFF_HN), (const bf16_t*)(ws + OFF_WCDIN + (size_t)eo * CDN * D * 2), CDN, D, E); } break;
    case PH_OUT: { EpiRes E{(float*)(ws + OFF_H), mod + (1 * 3 + 2) * D, 1.0f};
        const bf16_t* W = (const bf16_t*)(ws + ((l & 1) ? OFF_WCDOUT : OFF_WABOUT) + (size_t)eo * D * D * 2);
        run_gemm(smem, (const bf16_t*)(ws + OFF_HN), W, D, D, E, (l == 3 || gridDim.x == 256) ? NLAT : NTOK);
        if (gridDim.x == 256 && l != 3) ctx_res_gemm(p, (const bf16_t*)(ws + OFF_HN), W, D, mod + (1 * 3 + 2) * D, 1.0f); } break;
    case PH_S2: phase_s2(p, eo, (int)blockIdx.x); break;
    case PH_S3: phase_s3(p, eo, smem); break;
    case PH_GLU: { EpiGlu E{(const bf16_t*)(ws + OFF_SCR + SCR_YB), p.in[PZ() + I_GLUB] + (size_t)eo * 512, (bf16_t*)(ws + OFF_HN)};
        run_gemm(smem, (const bf16_t*)(ws + OFF_SCR + SCR_YB), (const bf16_t*)(ws + OFF_WGLU + (size_t)eo * 512 * 512 * 2), 512, 512, E); }
        [[fallthrough]];
    case PH_G3: phase_combine(p, (const bf16_t*)(ws + OFF_P), ABN, 1536, p.in[PZ() + I_GNG] + (size_t)eo * 128, 0, (int)blockIdx.x, (int)gridDim.x); break;
    case PH_G1: phase_g1(p, eo, smem); break;
    case PH_G2:
        if (gridDim.x >= 256) {
            if (blockIdx.x < 128) phase_g2(p, eo, smem);
            else {
                phase_s1(p, eo, smem, (int)blockIdx.x - 128, (int)gridDim.x - 128);
                const bool scan = blockIdx.x - 128 < 16;
                sub_arrive_wait((unsigned*)(ws + OFF_BAR) + 3520 + 64 * eo, gridDim.x - 128, scan);
                if (scan) phase_s2(p, eo, (int)blockIdx.x - 128);
            }
        }
        else { phase_g2(p, eo, smem); phase_s1(p, eo, smem, (int)blockIdx.x, (int)gridDim.x); }
        break;
    case PH_CH1: phase_conformer(p, eo, smem); phase_h1(p, eo, smem, 1040); break;
    case PH_H2: phase_h2(p); break;
    case PH_H3: phase_h3(p, eo, smem, l == 3); break;
    case PH_H4: phase_combine(p, (const bf16_t*)(ws + OFF_P), CDN, 1024 + 2048, p.in[PZ() + I_HNG] + (size_t)eo * 128, 512, (int)blockIdx.x, (int)gridDim.x); break;
    case PH_FINAL: phase_final(p); break;
    default: break;
    }
}

#ifndef MK_MULTI
__global__ __launch_bounds__(512, 2) void mega_kernel(Params p) {
    extern __shared__ __attribute__((aligned(16))) char smem[];
    cg::grid_group grid = cg::this_grid();
    volatile XLAS unsigned* st = (volatile XLAS unsigned*)(smem + LDS_BYTES - 16);
    if (threadIdx.x < 2) st[threadIdx.x] = 0u;
    __syncthreads();
    const XcdBarrier xb = xcd_barrier_post((unsigned*)(p.ws + OFF_BAR), st);
    for (int si = 0; si < p.nsteps; ++si) {
        run_step(p, p.steps[si], smem);
        if (si + 1 < p.nsteps) { if (p.nsteps < 0) grid.sync(); else xcd_barrier(xb); }
    }
}
#else
__global__ __launch_bounds__(512, 2) void step_kernel(Params p, int si) {
    extern __shared__ __attribute__((aligned(16))) char smem[];
    run_step(p, p.steps[si], smem);
}
#endif

extern "C" void kernel_launch(void* const* d_in, const int* in_sizes, int n_in, void* d_out, int out_size, void* d_ws, size_t ws_size, hipStream_t stream) {
    (void)in_sizes; (void)out_size;
    if (n_in < 34 || ws_size < WS_NEED) { fprintf(stderr, "kernel_launch: unexpected inputs (n_in %d, ws %zu < %zu)\n", n_in, ws_size, (size_t)WS_NEED); return; }
    Params p; memset(&p, 0, sizeof(p));
    for (int i = 0; i < 34; ++i) p.in[i] = (const float*)d_in[i];
    p.out = (float*)d_out; p.ws = (char*)d_ws;
#ifndef MK_MULTI
    static int grid_blocks = 0;
    if (!grid_blocks) {
        int dev = 0, cus = 0, per_cu = 0;
        (void)hipGetDevice(&dev);
        (void)hipDeviceGetAttribute(&cus, hipDeviceAttributeMultiprocessorCount, dev);
        (void)hipFuncSetAttribute((const void*)mega_kernel, hipFuncAttributeMaxDynamicSharedMemorySize, LDS_BYTES);
        (void)hipOccupancyMaxActiveBlocksPerMultiprocessor(&per_cu, mega_kernel, 512, LDS_BYTES);
        if (per_cu < 1) per_cu = 1;
        grid_blocks = cus * per_cu;
    }
    int n = 0;
#ifndef DUPMASK
#define DUPMASK 0u
#endif
    auto add = [&](int type, int l, int f) { p.steps[n++] = type | (l << 8) | (f << 16); if ((DUPMASK >> type) & 1u) p.steps[n++] = type | (l << 8) | (f << 16); };
    add(PH_INIT, 0, 0);
    for (int l = 0; l < 4; ++l) {
        add(PH_NORM, l, 0); add(PH_UP, l, 0); add(PH_DOWN, l, 0); add(PH_NORM, l, 1);
        if ((l & 1) == 0) { add(PH_ABIN, l, 0); add(PH_G1, l, 0); add(PH_G2, l, 0); if (grid_blocks < 256) add(PH_S2, l, 0); add(PH_S3, l, 0); add(PH_GLU, l, 0); }
        else { add(PH_CDIN, l, 0); add(PH_CH1, l, 0); add(PH_H2, l, 0); add(PH_H3, l, 0); add(PH_H4, l, 0); }
        add(PH_OUT, l, 0); add(PH_NORM, l, 2); add(PH_UP, l, 1); add(PH_DOWN, l, 1);
    }
    add(PH_FINAL, 0, 0);
    p.nsteps = n;
    (void)hipMemsetAsync((char*)d_ws + OFF_BAR, 0, 16384, stream);
    void* args[] = {&p};
    hipError_t e = hipLaunchCooperativeKernel((const void*)mega_kernel, dim3(grid_blocks), dim3(512), args, LDS_BYTES, stream);
    if (e != hipSuccess) fprintf(stderr, "cooperative launch failed: %s (grid %d)\n", hipGetErrorString(e), grid_blocks);
#else
    const int grid_blocks = 0;
    int n = 0;
#ifndef DUPMASK
#define DUPMASK 0u
#endif
    auto add = [&](int type, int l, int f) { p.steps[n++] = type | (l << 8) | (f << 16); if ((DUPMASK >> type) & 1u) p.steps[n++] = type | (l << 8) | (f << 16); };
    add(PH_INIT, 0, 0);
    for (int l = 0; l < 4; ++l) {
        add(PH_NORM, l, 0); add(PH_UP, l, 0); add(PH_DOWN, l, 0); add(PH_NORM, l, 1);
        if ((l & 1) == 0) { add(PH_ABIN, l, 0); add(PH_G1, l, 0); add(PH_G2, l, 0); if (grid_blocks < 256) add(PH_S2, l, 0); add(PH_S3, l, 0); add(PH_GLU, l, 0); }
        else { add(PH_CDIN, l, 0); add(PH_CH1, l, 0); add(PH_H2, l, 0); add(PH_H3, l, 0); add(PH_H4, l, 0); }
        add(PH_OUT, l, 0); add(PH_NORM, l, 2); add(PH_UP, l, 1); add(PH_DOWN, l, 1);
    }
    add(PH_FINAL, 0, 0);
    p.nsteps = n;
    static int inited = 0;
    if (!inited) { (void)hipFuncSetAttribute((const void*)step_kernel, hipFuncAttributeMaxDynamicSharedMemorySize, LDS_BYTES); inited = 1; }
    for (int si = 0; si < n; ++si) step_kernel<<<256, 512, LDS_BYTES, stream>>>(p, si);
#endif
}
```

```cpp
#include <hip/hip_runtime.h>
#include <hip/hip_cooperative_groups.h>
#include <cstdio>
#include <cstring>
namespace cg = cooperative_groups;

#define DEV __device__ __forceinline__
typedef unsigned short bf16_t;

constexpr int D = 1024, SEQ = 16384, CTXL = 256, NB = 2;
constexpr int NLAT = NB * SEQ;
constexpr int NTOK = NLAT + NB * CTXL;
constexpr int FFN = 2816;
constexpr int ABN = 2816;
constexpr int ABIN = 2576;
constexpr int CDN = 3584;
constexpr int MODW = 9216;
constexpr int NCH = 260;
constexpr int NBC = 65;

constexpr size_t SZ_WUP = (size_t)2 * FFN * D * 2, SZ_WDN = (size_t)D * FFN * 2;
constexpr size_t OFF_WUP = 0;
constexpr size_t OFF_WDN = OFF_WUP + 8 * SZ_WUP;
constexpr size_t OFF_WABIN = OFF_WDN + 8 * SZ_WDN;
constexpr size_t OFF_WCDIN = OFF_WABIN + (size_t)2 * ABN * D * 2;
constexpr size_t OFF_WABOUT = OFF_WCDIN + (size_t)2 * CDN * D * 2;
constexpr size_t OFF_WCDOUT = OFF_WABOUT + (size_t)2 * D * D * 2;
constexpr size_t OFF_WGLU = OFF_WCDOUT + (size_t)2 * D * D * 2;
constexpr size_t OFF_MOD = OFF_WGLU + (size_t)2 * 512 * 512 * 2;
constexpr size_t OFF_LB = OFF_MOD + (size_t)4 * 3 * MODW * 4;
constexpr size_t OFF_DISC = OFF_LB + 8192;
constexpr size_t OFF_H = OFF_DISC + (size_t)8192 * 8 * 4;
constexpr size_t OFF_HN = OFF_H + (size_t)NTOK * D * 4;
constexpr size_t OFF_P = OFF_HN + (size_t)NTOK * D * 2;
constexpr size_t SZ_PAB = (size_t)NTOK * ABN * 2;
constexpr size_t OFF_QN = OFF_P + SZ_PAB;
constexpr size_t OFF_KN = OFF_QN + (size_t)NTOK * 512 * 2;
constexpr size_t SZ_PREG = SZ_PAB + (size_t)2 * NTOK * 512 * 2;
constexpr size_t OFF_SCR = OFF_P + SZ_PREG;
constexpr size_t SCR_T = 0, SCR_QK = (size_t)4160 * 4096 * 2, SCR_GB = 2 * SCR_QK;
constexpr size_t SCR_YB = 0, SCR_CARRY = (size_t)NTOK * 512 * 2;
constexpr size_t SCR_DS = 0, SCR_DD = (size_t)1040 * 16384 * 4;
constexpr size_t SZ_SCR = (size_t)72 * 1024 * 1024;
constexpr size_t OFF_BAR = OFF_SCR + SZ_SCR;
constexpr size_t WS_NEED = OFF_BAR + 16384;
static_assert((size_t)2 * NTOK * 512 * 2 <= (size_t)NLAT * D * 4, "o scratch must fit in d_out");
constexpr size_t OUT_KNT = (size_t)2 * NTOK * 512 * 2;
constexpr size_t OUT_CARRY = OUT_KNT + (size_t)2080 * 8192 * 2;
static_assert(OUT_CARRY + (size_t)128 * 260 * 128 * 4 <= (size_t)NLAT * D * 4, "d_out scratch");
static_assert(SCR_GB + (size_t)4160 * 128 * 4 <= SZ_SCR, "scr");
static_assert(SCR_CARRY + (size_t)128 * 260 * 128 * 4 <= SZ_SCR, "scr");
static_assert(SCR_DD + (size_t)1040 * 128 * 4 <= SZ_SCR, "scr");
static_assert(WS_NEED <= (size_t)737 * 1000 * 1000, "ws");

typedef short s16x8 __attribute__((ext_vector_type(8)));
struct Params { const float* in[34]; float* out; char* ws; int nsteps; int steps[127]; };
enum { I_X = 0, I_C, I_CTX, I_CCTX, I_ADAW, I_ADAB, I_NORMG, I_WUP, I_WDN, I_ABIN, I_ABOUT, I_GCONV, I_GALOG, I_GDT, I_GNG,
       I_LRE, I_LIM, I_LSTEP, I_BRE, I_BIM, I_CRE, I_CIM, I_S5D, I_GLUW, I_GLUB, I_CDIN, I_CDOUT, I_DWW, I_DWB, I_LNG, I_LNB, I_LB, I_HNG, I_FNG };
enum { PH_INIT = 0, PH_NORM, PH_UP, PH_DOWN, PH_ABIN, PH_CDIN, PH_OUT, PH_S1, PH_S2, PH_S3, PH_GLU, PH_G1, PH_G2, PH_G3, PH_CH1, PH_H2, PH_H3, PH_H4, PH_FINAL };

DEV int TID() { int t = threadIdx.x; asm volatile("" : "+v"(t)); return t; }
DEV int PZ() { int z = 0; asm volatile("" : "+s"(z)); return z; }
DEV float bf2f(bf16_t b) { return __uint_as_float(((unsigned)b) << 16); }
typedef float f32x2_ __attribute__((ext_vector_type(2)));
typedef __bf16 bf16x2_ __attribute__((ext_vector_type(2)));
DEV unsigned pack2(float lo, float hi) { const f32x2_ v = {lo, hi}; return __builtin_bit_cast(unsigned, __builtin_convertvector(v, bf16x2_)); }
DEV bf16_t f2bf(float f) { return __builtin_bit_cast(unsigned short, (__bf16)f); }
DEV float sigm(float x) { return __builtin_amdgcn_rcpf(1.f + __expf(-x)); }
DEV float silu(float x) { return x * __builtin_amdgcn_rcpf(1.f + __expf(-x)); }
template <int CTRL> DEV float dpp_f(float v) { return __int_as_float(__builtin_amdgcn_update_dpp(0, __float_as_int(v), CTRL, 0xf, 0xf, true)); }
DEV float sum4(float v) { v += dpp_f<0xB1>(v); v += dpp_f<0x4E>(v); return v; }
DEV float sum8(float v) { v = sum4(v); v += dpp_f<0x141>(v); return v; }
DEV float sum16(float v) { v = sum8(v); v += dpp_f<0x140>(v); return v; }
DEV float wave_sum(float v) {
    v = sum16(v);
    return (__int_as_float(__builtin_amdgcn_readlane(__float_as_int(v), 0)) + __int_as_float(__builtin_amdgcn_readlane(__float_as_int(v), 16))) +
           (__int_as_float(__builtin_amdgcn_readlane(__float_as_int(v), 32)) + __int_as_float(__builtin_amdgcn_readlane(__float_as_int(v), 48)));
}
DEV void lds_barrier() { asm volatile("s_waitcnt lgkmcnt(0)" ::: "memory"); __builtin_amdgcn_s_barrier(); asm volatile("" ::: "memory"); }
DEV int mod_row(int row) { return row < NLAT ? (row >> 14) : 2; }

namespace pg8 {
#define PG8_LAS __attribute__((address_space(3)))
typedef unsigned short bf16_t;
typedef short bf16x8 __attribute__((ext_vector_type(8)));
typedef float f32x4 __attribute__((ext_vector_type(4)));
typedef unsigned u32x4 __attribute__((ext_vector_type(4)));
constexpr int BM = 256, BK = 64, HALF = 128, HTB = HALF * BK * 2  , STAGE_BYTES = 8 * HTB, NXCD = 8, WGM = 4;

__host__ __device__ __forceinline__ int lds_byte(int r, int c) { const int st = (r >> 4) * 2 + (c >> 5), rr = r & 15, cc = c & 31, ob = rr * 64 + cc * 2; return st * 1024 + (ob ^ (((ob >> 9) & 1) << 5)); }
__host__ __device__ __forceinline__ void stage_rc(int b, int& R, int& C) { const int st = b / 1024, sb = b % 1024, swz = sb ^ (((sb >> 9) & 1) << 5); R = (st >> 1) * 16 + swz / 64; C = (st & 1) * 32 + (swz % 64) / 2; }
__host__ __device__ __forceinline__ int perm32(int rho) { const int n = rho >> 4, i = rho & 15; return 8 * (i >> 2) + 4 * n + (i & 3); }

struct Unit { int pm, pn; };
struct Gemm { const bf16_t* A; const bf16_t* Bt; int M, N, K; };
struct StaticOrder {
    int nM, nN, nwg, G, c;
    __host__ __device__ void init(int M, int N, int G_, int c_) { nM = M / BM; nN = N / BM; nwg = nM * nN; G = G_; c = c_; }
    __host__ __device__ bool next(int i, Unit& u) const {
        const long L = (long)i * G + c; if (L >= nwg) return false;
        int wgid = (int)L; { const int q = nwg / NXCD, r = nwg % NXCD, xcd = wgid % NXCD, off = wgid / NXCD; wgid = (xcd < r ? xcd * (q + 1) : r * (q + 1) + (xcd - r) * q) + off; }
        const int nig = WGM * nN, gid = wgid / nig, fm = gid * WGM, gsz = (nM - fm) < WGM ? (nM - fm) : WGM;
        u.pm = fm + ((wgid % nig) % gsz); u.pn = (wgid % nig) / gsz; return true;
    }
    __device__ __forceinline__ void a_ready(const Unit&) const {}
    __device__ __forceinline__ void done(const Unit&) const {}
};
__device__ __forceinline__ unsigned cvt_pk_bf16(float lo, float hi) { unsigned r; asm volatile("v_cvt_pk_bf16_f32 %0, %1, %2" : "=v"(r) : "v"(lo), "v"(hi)); return r; }
template <class Epi, class Sched, bool STAMP = false>
__device__ __forceinline__ void gemm_phase(PG8_LAS unsigned char* lds, const Gemm g, const Sched& S, const Epi& E, unsigned long long* stamps) {
    const int tid = TID(), wid = __builtin_amdgcn_readfirstlane(tid >> 6), lane = tid & 63, wr = wid >> 2, wc = wid & 3, fr = lane & 15, fq = lane >> 4;
    const int K = g.K, nt = K / BK;
    int ts_lo = 0, ts_hi = 0, nts = 0; const unsigned long long rt_entry = STAMP ? (unsigned long long)wall_clock64() : 0ull;
#define PG8_STAMP() do { if (STAMP && wid == 0 && nts < 64) { const unsigned long long _c = (unsigned long long)clock64(); \
        ts_lo = (lane == nts) ? (int)(unsigned)_c : ts_lo; ts_hi = (lane == nts) ? (int)(unsigned)(_c >> 32) : ts_hi; ++nts; } } while (0)
    PG8_STAMP();
    unsigned voffA[2], voffB[2];
#pragma unroll
    for (int i = 0; i < 2; ++i) { int R, C; stage_rc(tid * 16 + i * 8192, R, C); const int Rb = Epi::PERM ? ((R & ~31) + perm32(R & 31)) : R;
        voffA[i] = (unsigned)(R * K + C) * 2u; voffB[i] = (unsigned)(Rb * K + C) * 2u; }
    const size_t kstep = (size_t)(BK * 2);
    const size_t hstep = (size_t)HALF * K * 2;
    const size_t tstep = 2 * hstep;
    const unsigned ldsw = (unsigned)wid * 1024u;
    const int aoff = lds_byte(wr * 64 + fr, fq * 8), boff = lds_byte(wc * 32 + fr, fq * 8);
#define PG8_SA(b, h) (((b) * 2 + (h)) * HTB)
#define PG8_SB(b, h) ((4 + (b) * 2 + (h)) * HTB)
#define PG8_STAGE(bufoff, gbase, voff) do { _Pragma("unroll") for (int _i = 0; _i < 2; ++_i) \
        __builtin_amdgcn_global_load_lds((const unsigned*)((const char*)(gbase) + (voff)[_i]), (PG8_LAS unsigned*)(lds + (bufoff) + ldsw + _i * 8192), 16, 0, 0); } while (0)
#define PG8_LDA(dst, b, h) do { _Pragma("unroll") for (int m = 0; m < 4; ++m) _Pragma("unroll") for (int k = 0; k < 2; ++k) dst[m][k] = *(const PG8_LAS bf16x8*)(lds + PG8_SA(b, h) + aoff + m * 2048 + k * 1024); } while (0)
#define PG8_LDB(dst, b, h) do { _Pragma("unroll") for (int n = 0; n < 2; ++n) _Pragma("unroll") for (int k = 0; k < 2; ++k) dst[n][k] = *(const PG8_LAS bf16x8*)(lds + PG8_SB(b, h) + boff + n * 2048 + k * 1024); } while (0)
#define PG8_MMA(ai, bj, At, Bt) do { __builtin_amdgcn_s_setprio(1); _Pragma("unroll") for (int m = 0; m < 4; ++m) _Pragma("unroll") for (int n = 0; n < 2; ++n) _Pragma("unroll") for (int k = 0; k < 2; ++k) \
        acc[ai][bj][m][n] = __builtin_amdgcn_mfma_f32_16x16x32_bf16(Bt[n][k], At[m][k], acc[ai][bj][m][n], 0, 0, 0); __builtin_amdgcn_s_setprio(0); } while (0)
#define PG8_WAIT_V(n) asm volatile("s_waitcnt vmcnt(" #n ")" ::: "memory")
#define PG8_WAIT_L(n) asm volatile("s_waitcnt lgkmcnt(" #n ")" ::: "memory")
#define PG8_BAR __builtin_amdgcn_s_barrier()
#define PG8_SCHED __builtin_amdgcn_sched_barrier(0)
    Unit cur, nxt; int ui = 0;
    if (!S.next(0, cur)) return;
    f32x4 acc[2][2][4][2];
#pragma unroll
    for (int a = 0; a < 2; ++a)
#pragma unroll
        for (int b = 0; b < 2; ++b)
#pragma unroll
            for (int m = 0; m < 4; ++m)
#pragma unroll
                for (int n = 0; n < 2; ++n) acc[a][b][m][n] = (f32x4){0.f, 0.f, 0.f, 0.f};
    bf16x8 At[4][2], B0[2][2], B1[2][2];
    const char* cA = (const char*)g.A + (size_t)cur.pm * tstep; const char* cB = (const char*)g.Bt + (size_t)cur.pn * tstep;
    S.a_ready(cur);
    PG8_STAGE(PG8_SB(0, 0), cB, voffB); PG8_STAGE(PG8_SA(0, 0), cA, voffA); PG8_STAGE(PG8_SB(0, 1), cB + hstep, voffB); PG8_STAGE(PG8_SA(0, 1), cA + hstep, voffA);
    if (wr == 1) PG8_BAR;
    PG8_WAIT_V(4); PG8_BAR;
    PG8_STAGE(PG8_SB(1, 0), cB + kstep, voffB); PG8_STAGE(PG8_SA(1, 0), cA + kstep, voffA); PG8_STAGE(PG8_SB(1, 1), cB + hstep + kstep, voffB);
    PG8_WAIT_V(6); PG8_BAR;
    PG8_STAMP();
    for (;;) {
        const bool has_next = S.next(ui + 1, nxt);
        const char* nA = has_next ? (const char*)g.A + (size_t)nxt.pm * tstep : cA; const char* nB = has_next ? (const char*)g.Bt + (size_t)nxt.pn * tstep : cB;
        for (int t = 0; t < nt; t += 2) {
            const bool last = (t == nt - 2);
            const char* a1 = cA + (size_t)(t + 1) * kstep;
            const char* a2 = last ? nA : cA + (size_t)(t + 2) * kstep; const char* b2 = last ? nB : cB + (size_t)(t + 2) * kstep;
            const char* a3 = a2 + kstep; const char* b3 = b2 + kstep;
            if (last && has_next) S.a_ready(nxt);
            PG8_LDB(B0, 0, 0); PG8_SCHED; PG8_LDA(At, 0, 0); PG8_STAGE(PG8_SA(1, 1), a1 + hstep, voffA);
            PG8_WAIT_L(8); PG8_BAR; PG8_WAIT_L(0); PG8_MMA(0, 0, At, B0); PG8_BAR; PG8_SCHED;
            PG8_LDB(B1, 0, 1); PG8_STAGE(PG8_SB(0, 0), b2, voffB);
            PG8_BAR; PG8_WAIT_L(0); PG8_MMA(0, 1, At, B1); PG8_BAR;
            PG8_LDA(At, 0, 1); PG8_STAGE(PG8_SA(0, 0), a2, voffA);
            PG8_BAR; PG8_WAIT_L(0); PG8_MMA(1, 0, At, B0); PG8_BAR; PG8_SCHED;
            PG8_STAGE(PG8_SB(0, 1), b2 + hstep, voffB);
            PG8_WAIT_V(6); PG8_BAR; PG8_MMA(1, 1, At, B1); PG8_BAR;
            PG8_LDB(B0, 1, 0); PG8_SCHED; PG8_LDA(At, 1, 0); PG8_STAGE(PG8_SA(0, 1), a2 + hstep, voffA);
            PG8_WAIT_L(8); PG8_BAR; PG8_WAIT_L(0); PG8_MMA(0, 0, At, B0); PG8_BAR; PG8_SCHED;
            PG8_LDB(B1, 1, 1); PG8_STAGE(PG8_SB(1, 0), b3, voffB);
            PG8_BAR; PG8_WAIT_L(0); PG8_MMA(0, 1, At, B1); PG8_BAR;
            PG8_LDA(At, 1, 1); PG8_STAGE(PG8_SA(1, 0), a3, voffA);
            PG8_BAR; PG8_WAIT_L(0); PG8_MMA(1, 0, At, B0); PG8_BAR; PG8_SCHED;
            PG8_STAGE(PG8_SB(1, 1), b3 + hstep, voffB);
            PG8_WAIT_V(6); PG8_BAR; PG8_MMA(1, 1, At, B1); PG8_BAR;
        }
        PG8_STAMP();
        if constexpr (!Epi::AFTER_DRAIN) { E(acc, cur, wr, wc, fr, fq);
#ifdef EPIDUP
            if constexpr (Epi::PERM) { asm volatile("" ::: "memory"); E(acc, cur, wr, wc, fr, fq); }
#endif
            S.done(cur); }
        PG8_STAMP();
        if (!has_next) break;
#pragma unroll
        for (int a = 0; a < 2; ++a)
#pragma unroll
            for (int b = 0; b < 2; ++b)
#pragma unroll
                for (int m = 0; m < 4; ++m)
#pragma unroll
                    for (int n = 0; n < 2; ++n) acc[a][b][m][n] = (f32x4){0.f, 0.f, 0.f, 0.f};
        cur = nxt; cA = nA; cB = nB; ++ui;
    }
    PG8_WAIT_V(0);
    if (wr == 0) PG8_BAR;
    PG8_BAR;
    if constexpr (Epi::AFTER_DRAIN) { E.fused(acc, cur, wr, wc, fr, fq, lds, wid, lane); S.done(cur); }
    PG8_STAMP();
    if (STAMP && wid == 0) { stamps[lane] = lane < nts ? (((unsigned long long)(unsigned)ts_hi << 32) | (unsigned)ts_lo) : 0ull;
        if (lane == 62) stamps[62] = rt_entry; if (lane == 63) stamps[63] = (unsigned long long)wall_clock64(); }
#undef PG8_STAMP
#undef PG8_SA
#undef PG8_SB
#undef PG8_STAGE
#undef PG8_LDA
#undef PG8_LDB
#undef PG8_MMA
#undef PG8_WAIT_V
#undef PG8_WAIT_L
#undef PG8_BAR
#undef PG8_SCHED
}
}

using pg8::f32x4; using pg8::u32x4; using pg8::Unit; using pg8::cvt_pk_bf16;
typedef unsigned u32x2 __attribute__((ext_vector_type(2)));

struct EpiUp {
    static constexpr bool PERM = true, AFTER_DRAIN = false;
    bf16_t* O;
    DEV void operator()(const f32x4 (&acc)[2][2][4][2], const Unit& u, int wr, int wc, int fr, int fq) const {
        const int row0 = u.pm * 256 + wr * 64 + fr, ocol = u.pn * 128 + wc * 32 + 8 * fq;
#pragma unroll
        for (int ai = 0; ai < 2; ++ai)
#pragma unroll
            for (int m = 0; m < 4; ++m) {
                const f32x4 g0 = acc[ai][0][m][0], g1 = acc[ai][0][m][1], v0 = acc[ai][1][m][0], v1 = acc[ai][1][m][1];
                u32x4 w;
                w.x = cvt_pk_bf16(silu(g0[0]) * v0[0], silu(g0[1]) * v0[1]); w.y = cvt_pk_bf16(silu(g0[2]) * v0[2], silu(g0[3]) * v0[3]);
                w.z = cvt_pk_bf16(silu(g1[0]) * v1[0], silu(g1[1]) * v1[1]); w.w = cvt_pk_bf16(silu(g1[2]) * v1[2], silu(g1[3]) * v1[3]);
                *(u32x4*)(O + (size_t)(row0 + ai * 128 + m * 16) * FFN + ocol) = w;
            }
    }
};
struct EpiRes {
    static constexpr bool PERM = false, AFTER_DRAIN = false;
    float* H; const float* gate; float scale;
    DEV void operator()(const f32x4 (&acc)[2][2][4][2], const Unit& u, int wr, int wc, int fr, int fq) const {
        const int row0 = u.pm * 256 + wr * 64 + fr, col0 = u.pn * 256 + wc * 32 + 4 * fq;
        const int r = u.pm < 64 ? 0 : (u.pm < 128 ? 1 : 2);
        f32x4 gv[2][2];
#pragma unroll
        for (int bj = 0; bj < 2; ++bj)
#pragma unroll
            for (int n = 0; n < 2; ++n) gv[bj][n] = *(const f32x4*)(gate + (size_t)r * MODW + col0 + bj * 128 + n * 16) * scale;
#pragma unroll
        for (int ai = 0; ai < 2; ++ai)
#pragma unroll
            for (int m = 0; m < 4; ++m) {
                float* rowp = H + (size_t)(row0 + ai * 128 + m * 16) * D + col0;
#pragma unroll
                for (int bj = 0; bj < 2; ++bj)
#pragma unroll
                    for (int n = 0; n < 2; ++n) { f32x4* q = (f32x4*)(rowp + bj * 128 + n * 16); *q = *q + gv[bj][n] * acc[ai][bj][m][n]; }
            }
    }
};
struct EpiP {
    static constexpr bool PERM = true, AFTER_DRAIN = false;
    bf16_t* O; int ldc;
    DEV void operator()(const f32x4 (&acc)[2][2][4][2], const Unit& u, int wr, int wc, int fr, int fq) const {
        const int row0 = u.pm * 256 + wr * 64 + fr, col0 = u.pn * 256 + wc * 32 + 8 * fq;
#pragma unroll
        for (int ai = 0; ai < 2; ++ai)
#pragma unroll
            for (int m = 0; m < 4; ++m) {
                bf16_t* rowp = O + (size_t)(row0 + ai * 128 + m * 16) * ldc + col0;
#pragma unroll
                for (int bj = 0; bj < 2; ++bj) {
                    const f32x4 v0 = acc[ai][bj][m][0], v1 = acc[ai][bj][m][1];
                    u32x4 w; w.x = cvt_pk_bf16(v0[0], v0[1]); w.y = cvt_pk_bf16(v0[2], v0[3]); w.z = cvt_pk_bf16(v1[0], v1[1]); w.w = cvt_pk_bf16(v1[2], v1[3]);
                    *(u32x4*)(rowp + bj * 128) = w;
                }
            }
    }
};
struct EpiGlu {
    static constexpr bool PERM = true, AFTER_DRAIN = false;
    const bf16_t* Y; const float* bias; bf16_t* O;
    DEV void operator()(const f32x4 (&acc)[2][2][4][2], const Unit& u, int wr, int wc, int fr, int fq) const {
        const int row0 = u.pm * 256 + wr * 64 + fr, col0 = u.pn * 256 + wc * 32 + 8 * fq;
#pragma unroll
        for (int ai = 0; ai < 2; ++ai)
#pragma unroll
            for (int m = 0; m < 4; ++m) {
                const int row = row0 + ai * 128 + m * 16;
#pragma unroll
                for (int bj = 0; bj < 2; ++bj) {
                    const int col = col0 + bj * 128;
                    const u32x4 yv = *(const u32x4*)(Y + (size_t)row * 512 + col);
                    const f32x4 b0 = *(const f32x4*)(bias + col), b1 = *(const f32x4*)(bias + col + 4);
                    const f32x4 v0 = acc[ai][bj][m][0] + b0, v1 = acc[ai][bj][m][1] + b1;
                    float y[8];
#pragma unroll
                    for (int j = 0; j < 4; ++j) { y[2 * j] = __uint_as_float(yv[j] << 16); y[2 * j + 1] = __uint_as_float(yv[j] & 0xffff0000u); }
                    u32x4 w;
                    w.x = cvt_pk_bf16(y[0] * sigm(v0[0]), y[1] * sigm(v0[1])); w.y = cvt_pk_bf16(y[2] * sigm(v0[2]), y[3] * sigm(v0[3]));
                    w.z = cvt_pk_bf16(y[4] * sigm(v1[0]), y[5] * sigm(v1[1])); w.w = cvt_pk_bf16(y[6] * sigm(v1[2]), y[7] * sigm(v1[3]));
                    *(u32x4*)(O + (size_t)row * D + 512 + col) = w;
                }
            }
    }
};

struct EpiPG {
    static constexpr bool PERM = true, AFTER_DRAIN = false;
    bf16_t* O; int ldc;
    DEV void operator()(const f32x4 (&acc)[2][2][4][2], const Unit& u, int wr, int wc, int fr, int fq) const {
        const int row0 = u.pm * 256 + wr * 64 + fr, col0 = u.pn * 256 + wc * 32 + 8 * fq;
        if (u.pn < 4) {
#pragma unroll
            for (int ai = 0; ai < 2; ++ai)
#pragma unroll
                for (int m = 0; m < 4; ++m) {
                    const f32x4 a0 = acc[ai][0][m][0], a1 = acc[ai][0][m][1], g0 = acc[ai][1][m][0], g1 = acc[ai][1][m][1];
                    u32x4 w;
                    w.x = cvt_pk_bf16(a0[0] * sigm(g0[0]), a0[1] * sigm(g0[1])); w.y = cvt_pk_bf16(a0[2] * sigm(g0[2]), a0[3] * sigm(g0[3]));
                    w.z = cvt_pk_bf16(a1[0] * sigm(g1[0]), a1[1] * sigm(g1[1])); w.w = cvt_pk_bf16(a1[2] * sigm(g1[2]), a1[3] * sigm(g1[3]));
                    *(u32x4*)(O + (size_t)(row0 + ai * 128 + m * 16) * ldc + u.pn * 128 + wc * 32 + 8 * fq) = w;
                }
        } else {
#pragma unroll
            for (int ai = 0; ai < 2; ++ai)
#pragma unroll
                for (int m = 0; m < 4; ++m) {
                    bf16_t* rowp = O + (size_t)(row0 + ai * 128 + m * 16) * ldc + col0;
#pragma unroll
                    for (int bj = 0; bj < 2; ++bj) {
                        const f32x4 v0 = acc[ai][bj][m][0], v1 = acc[ai][bj][m][1];
                        u32x4 w; w.x = cvt_pk_bf16(v0[0], v0[1]); w.y = cvt_pk_bf16(v0[2], v0[3]); w.z = cvt_pk_bf16(v1[0], v1[1]); w.w = cvt_pk_bf16(v1[2], v1[3]);
                        *(u32x4*)(rowp + bj * 128) = w;
                    }
                }
        }
    }
};

DEV void convert_job(const float* __restrict__ src, int Nsrc, int K, bf16_t* __restrict__ dst, int Nv, int mode, int& base, float* tile, int bid, int G) {
    const int tid = TID();
    const int tv = Nv / 256, ntiles = (K / 64) * tv;
    const int first = (int)(((long)bid - (long)(base % G) + G) % G);
    for (int t = first; t < ntiles; t += G) {
        const int v0 = (t % tv) * 256, k0 = (t / tv) * 64;
        {
            const int v = tid & 255, kh = (tid >> 8) * 32, vv = v0 + v;
            int sc;
            if (mode == 1) { const int T = vv >> 8, tt = vv & 255; sc = tt < 128 ? 128 * T + tt : FFN + 128 * T + (tt - 128); }
            else if (mode == 2 && vv < 1024) { const int T = vv >> 8, tt = vv & 255; sc = tt < 128 ? 128 * T + tt : 512 + 128 * T + (tt - 128); }
            else sc = vv < Nsrc ? vv : -1;
            float x[32];
#pragma unroll
            for (int i = 0; i < 32; ++i) x[i] = sc >= 0 ? src[(size_t)(k0 + kh + i) * Nsrc + sc] : 0.f;
#pragma unroll
            for (int i = 0; i < 32; ++i) tile[(kh + i) * 257 + v] = x[i];
        }
        __syncthreads();
        {
            const int vo = tid >> 1, kq = (tid & 1) * 32;
#pragma unroll
            for (int q = 0; q < 4; ++q) {
                const int kk = kq + q * 8;
                pg8::u32x4 w;
                w.x = pack2(tile[(kk + 0) * 257 + vo], tile[(kk + 1) * 257 + vo]); w.y = pack2(tile[(kk + 2) * 257 + vo], tile[(kk + 3) * 257 + vo]);
                w.z = pack2(tile[(kk + 4) * 257 + vo], tile[(kk + 5) * 257 + vo]); w.w = pack2(tile[(kk + 6) * 257 + vo], tile[(kk + 7) * 257 + vo]);
                *(pg8::u32x4*)(dst + (size_t)(v0 + vo) * K + k0 + kk) = w;
            }
        }
        __syncthreads();
    }
    base += ntiles;
}

DEV void convert_layer(const Params& p, int l, float* tile, int bid, int G) {
    char* ws = p.ws; int base = 0; const int eo = l >> 1;
    for (int f = 0; f < 2; ++f) {
        const int i = l * 2 + f;
        convert_job(p.in[PZ() + I_WUP] + (size_t)i * D * 2 * FFN, 2 * FFN, D, (bf16_t*)(ws + OFF_WUP + i * SZ_WUP), 2 * FFN, 1, base, tile, bid, G);
        convert_job(p.in[PZ() + I_WDN] + (size_t)i * FFN * D, D, FFN, (bf16_t*)(ws + OFF_WDN + i * SZ_WDN), D, 0, base, tile, bid, G);
    }
    if ((l & 1) == 0) {
        convert_job(p.in[PZ() + I_ABIN] + (size_t)eo * D * ABIN, ABIN, D, (bf16_t*)(ws + OFF_WABIN + (size_t)eo * ABN * D * 2), ABN, 0, base, tile, bid, G);
        convert_job(p.in[PZ() + I_ABOUT] + (size_t)eo * D * D, D, D, (bf16_t*)(ws + OFF_WABOUT + (size_t)eo * D * D * 2), D, 0, base, tile, bid, G);
        convert_job(p.in[PZ() + I_GLUW] + (size_t)eo * 512 * 512, 512, 512, (bf16_t*)(ws + OFF_WGLU + (size_t)eo * 512 * 512 * 2), 512, 0, base, tile, bid, G);
    } else {
        convert_job(p.in[PZ() + I_CDIN] + (size_t)eo * D * CDN, CDN, D, (bf16_t*)(ws + OFF_WCDIN + (size_t)eo * CDN * D * 2), CDN, 2, base, tile, bid, G);
        convert_job(p.in[PZ() + I_CDOUT] + (size_t)eo * D * D, D, D, (bf16_t*)(ws + OFF_WCDOUT + (size_t)eo * D * D * 2), D, 0, base, tile, bid, G);
    }
}

DEV void phase_init(const Params& p, char* smem) {
    const int tid = TID(), G = gridDim.x, bid = blockIdx.x;
    char* ws = p.ws;
    float* tile = (float*)smem;
    convert_layer(p, 0, tile, bid, G);
    {
        float* sc = (float*)smem;
        float* red = sc + 3 * 1024;
        __syncthreads();
        for (int i = tid; i < 3 * 1024; i += 512) { const float v = i < 2048 ? p.in[PZ() + I_C][i] : p.in[PZ() + I_CCTX][i - 2048]; sc[i] = silu(v); }
        __syncthreads();
        float* mod = (float*)(ws + OFF_MOD);
        const int col = tid & 63, ks = tid >> 6;
        for (int u = bid; u < 4 * 144; u += G) {
            const int l = u / 144, cg0 = (u % 144) * 64;
            const float* w = p.in[PZ() + I_ADAW] + ((size_t)l * D + ks * 128) * MODW + cg0 + col;
            float a0 = 0.f, a1 = 0.f, a2 = 0.f;
#pragma unroll 8
            for (int k = 0; k < 128; ++k) { const float wv = w[(size_t)k * MODW]; const int kk = ks * 128 + k; a0 += sc[kk] * wv; a1 += sc[1024 + kk] * wv; a2 += sc[2048 + kk] * wv; }
            red[(ks * 3 + 0) * 64 + col] = a0; red[(ks * 3 + 1) * 64 + col] = a1; red[(ks * 3 + 2) * 64 + col] = a2;
            __syncthreads();
            if (tid < 192) {
                const int r = tid >> 6, cc = tid & 63; float s = p.in[PZ() + I_ADAB][(size_t)l * MODW + cg0 + cc];
#pragma unroll
                for (int k = 0; k < 8; ++k) s += red[(k * 3 + r) * 64 + cc];
                mod[((size_t)l * 3 + r) * MODW + cg0 + cc] = s;
            }
            __syncthreads();
        }
    }
    if (bid == G - 1) {
        float* lb = (float*)(ws + OFF_LB);
        const float a = p.in[PZ() + I_LB][tid], b = p.in[PZ() + I_LB][512 + tid], c = p.in[PZ() + I_LB][1024 + tid];
        const float mx = fmaxf(a, fmaxf(b, c)); const float ea = expf(a - mx), eb = expf(b - mx), ec = expf(c - mx); const float inv = 1.f / (ea + eb + ec);
        lb[tid] = ea * inv; lb[512 + tid] = (ea + eb) * inv; lb[1024 + tid] = 1.f;
    }
    for (int i = (bid + PZ()) * 512 + tid; i < 8192; i += G * 512) {
        const int gidx = i >> 6;
        const double lr = (double)p.in[PZ() + I_LRE][i], li = (double)p.in[PZ() + I_LIM][i], step = exp((double)p.in[PZ() + I_LSTEP][gidx]);
        const double mag = exp(lr * step), ar = mag * cos(li * step), ai = mag * sin(li * step);
        const double den = lr * lr + li * li, nr = ar - 1.0, ni = ai;
        double pr = ar, pi = ai;
#pragma unroll
        for (int q = 0; q < 6; ++q) { const double tr = pr * pr - pi * pi, ti = 2.0 * pr * pi; pr = tr; pi = ti; }
        float* dt = (float*)(ws + OFF_DISC) + (size_t)i * 8;
        dt[0] = (float)ar; dt[1] = (float)ai; dt[2] = (float)((nr * lr + ni * li) / den); dt[3] = (float)((ni * lr - nr * li) / den);
        dt[4] = (float)pr; dt[5] = (float)pi; dt[6] = 0.f; dt[7] = 0.f;
    }
}

DEV void phase_norm(const Params& p, int l, int j) {
    const int tid = TID(), lane = tid & 63, wid = tid >> 6;
    const float* h = (const float*)(p.ws + OFF_H);
    bf16_t* hn = (bf16_t*)(p.ws + OFF_HN);
    const float* g = p.in[PZ() + I_NORMG] + (size_t)(l * 3 + j) * D;
    const float* mod = (const float*)(p.ws + OFF_MOD) + (size_t)l * 3 * MODW;
    const bool first = (l == 0 && j == 0);
    for (int row = blockIdx.x * 8 + wid; row < NTOK; row += gridDim.x * 8) {
        const float* hr = first ? (row < NLAT ? p.in[PZ() + I_X] + (size_t)row * D : p.in[PZ() + I_CTX] + (size_t)(row - NLAT) * D) : h + (size_t)row * D;
        float4 v[4]; float ss = 0.f;
#pragma unroll
        for (int i = 0; i < 4; ++i) { v[i] = *(const float4*)(hr + i * 256 + lane * 4); ss += v[i].x * v[i].x + v[i].y * v[i].y + v[i].z * v[i].z + v[i].w * v[i].w; }
        if (first) {
#pragma unroll
            for (int i = 0; i < 4; ++i) *(float4*)((float*)(p.ws + OFF_H) + (size_t)row * D + i * 256 + lane * 4) = v[i];
        }
        ss = wave_sum(ss);
        const float rstd = rsqrtf(ss * (1.f / D) + 1e-6f);
        const float* m = mod + (size_t)mod_row(row) * MODW + (j * 3) * D;
#pragma unroll
        for (int i = 0; i < 4; ++i) {
            const int c = i * 256 + lane * 4;
            const float4 gg = *(const float4*)(g + c), sh = *(const float4*)(m + c), sc = *(const float4*)(m + D + c);
            u32x2 w;
            w.x = pack2(v[i].x * rstd * gg.x * (1.f + sc.x) + sh.x, v[i].y * rstd * gg.y * (1.f + sc.y) + sh.y);
            w.y = pack2(v[i].z * rstd * gg.z * (1.f + sc.z) + sh.z, v[i].w * rstd * gg.w * (1.f + sc.w) + sh.w);
            *(u32x2*)(hn + (size_t)row * D + c) = w;
        }
    }
}

DEV void phase_final(const Params& p) {
    const int tid = TID(), lane = tid & 63, wid = tid >> 6;
    const float* h = (const float*)(p.ws + OFF_H);
    const float* g = p.in[PZ() + I_FNG];
    for (int row = blockIdx.x * 8 + wid; row < NLAT; row += gridDim.x * 8) {
        const float* hr = h + (size_t)row * D;
        float4 v[4]; float ss = 0.f;
#pragma unroll
        for (int i = 0; i < 4; ++i) { v[i] = *(const float4*)(hr + i * 256 + lane * 4); ss += v[i].x * v[i].x + v[i].y * v[i].y + v[i].z * v[i].z + v[i].w * v[i].w; }
        ss = wave_sum(ss);
        const float rstd = rsqrtf(ss * (1.f / D) + 1e-6f);
#pragma unroll
        for (int i = 0; i < 4; ++i) {
            const int c = i * 256 + lane * 4;
            const float4 gg = *(const float4*)(g + c);
            float4 o; o.x = v[i].x * rstd * gg.x; o.y = v[i].y * rstd * gg.y; o.z = v[i].z * rstd * gg.z; o.w = v[i].w * rstd * gg.w;
            *(float4*)(p.out + (size_t)row * D + c) = o;
        }
    }
}

DEV int stream_row64(int b, int dir, int sc, int s) {
    if (sc < 4) { const int oc = dir ? 3 - sc : sc; return NLAT + b * CTXL + oc * 64 + (dir ? 63 - s : s); }
    const int lc = sc - 4, oc = dir ? 255 - lc : lc; return b * SEQ + oc * 64 + (dir ? 63 - s : s);
}

DEV const float* s5_dt(const Params& p, int e, int dir, int g, int pp) { return (const float*)(p.ws + OFF_DISC) + ((size_t)((e * 2 + dir) * 32 + g) * 64 + pp) * 8; }
DEV void s5_bfrag(const Params& p, int e, int dir, int g, int l15, int lq, s16x8 (&bf)[8]) {
#pragma unroll
    for (int q = 0; q < 4; ++q) {
        const int pp = 16 * q + l15;
        const float* dt = s5_dt(p, e, dir, g, pp); const float cr = dt[2], ci = dt[3];
        const float* br = p.in[PZ() + I_BRE] + ((size_t)(e * 32 + g) * 64 + pp) * 16 + 8 * (lq & 1); const float* bi = p.in[PZ() + I_BIM] + ((size_t)(e * 32 + g) * 64 + pp) * 16 + 8 * (lq & 1);
        const float4 r0 = *(const float4*)br, r1 = *(const float4*)(br + 4), q0 = *(const float4*)bi, q1 = *(const float4*)(bi + 4);
        const float rr[8] = {r0.x, r0.y, r0.z, r0.w, r1.x, r1.y, r1.z, r1.w}, qq[8] = {q0.x, q0.y, q0.z, q0.w, q1.x, q1.y, q1.z, q1.w};
#pragma unroll
        for (int i = 0; i < 8; ++i) {
            const float wre = cr * rr[i] - ci * qq[i], wim = cr * qq[i] + ci * rr[i];
            const bf16_t hre = f2bf(wre), him = f2bf(wim);
            bf[q][i] = (short)(lq < 2 ? hre : f2bf(wre - bf2f(hre)));
            bf[q + 4][i] = (short)(lq < 2 ? him : f2bf(wim - bf2f(him)));
        }
    }
}
template <class RowF> DEV void s5_load_u(const Params& p, bf16_t* us, int gq, RowF rowf) {
    const int tid = TID(), s = tid >> 3, part = tid & 7;
    const bf16_t* P = (const bf16_t*)(p.ws + OFF_P);
    const pg8::u32x4* src = (const pg8::u32x4*)(P + (size_t)rowf(s) * ABN + 2064 + gq * 128 + part * 16);
    pg8::u32x4* dst = (pg8::u32x4*)(us + s * 128 + part * 16);
    dst[0] = src[0]; dst[1] = src[1];
}
DEV void wave_sync() { __builtin_amdgcn_fence(__ATOMIC_RELEASE, "wavefront"); __builtin_amdgcn_wave_barrier(); __builtin_amdgcn_fence(__ATOMIC_ACQUIRE, "wavefront"); }
DEV void s5_bu(const bf16_t* us, int r0, int w, int l15, int lq, const s16x8 (&bf)[8], float* bub) {
    const s16x8 a = *(const s16x8*)(us + (r0 + l15) * 128 + w * 16 + (lq & 1) * 8);
#pragma unroll
    for (int nt = 0; nt < 8; ++nt) {
        f32x4 acc = {0.f, 0.f, 0.f, 0.f};
        acc = __builtin_amdgcn_mfma_f32_16x16x32_bf16(a, bf[nt], acc, 0, 0, 0);
#pragma unroll
        for (int j = 0; j < 4; ++j) bub[(4 * lq + j) * 132 + 16 * nt + l15] = acc[j];
    }
}

DEV void s5_disc(const Params& p, int e, int dir, int g, int pp, float& abr, float& abi, float& cr, float& ci) {
    const int i = ((e * 2 + dir) * 32 + g) * 64 + pp;
    const double lr = (double)p.in[PZ() + I_LRE][i], li = (double)p.in[PZ() + I_LIM][i], step = exp((double)p.in[PZ() + I_LSTEP][(e * 2 + dir) * 32 + g]);
    const double mag = exp(lr * step), ar = mag * cos(li * step), ai = mag * sin(li * step);
    const double den = lr * lr + li * li, nr = ar - 1.0, ni = ai;
    abr = (float)ar; abi = (float)ai; cr = (float)((nr * lr + ni * li) / den); ci = (float)((ni * lr - nr * li) / den);
}
DEV void s5_bbar(const Params& p, int e, int g, int pp, float cr, float ci, float (&bbr)[16], float (&bbi)[16]) {
    const float* br = p.in[PZ() + I_BRE] + ((size_t)(e * 32 + g) * 64 + pp) * 16; const float* bi = p.in[PZ() + I_BIM] + ((size_t)(e * 32 + g) * 64 + pp) * 16;
#pragma unroll
    for (int c4 = 0; c4 < 4; ++c4) {
        const float4 r = *(const float4*)(br + c4 * 4), q = *(const float4*)(bi + c4 * 4);
        bbr[c4 * 4 + 0] = cr * r.x - ci * q.x; bbi[c4 * 4 + 0] = cr * q.x + ci * r.x;
        bbr[c4 * 4 + 1] = cr * r.y - ci * q.y; bbi[c4 * 4 + 1] = cr * q.y + ci * r.y;
        bbr[c4 * 4 + 2] = cr * r.z - ci * q.z; bbi[c4 * 4 + 2] = cr * q.z + ci * r.z;
        bbr[c4 * 4 + 3] = cr * r.w - ci * q.w; bbi[c4 * 4 + 3] = cr * q.w + ci * r.w;
    }
}
DEV void s5_step(const bf16_t* urow, const float (&bbr)[16], const float (&bbi)[16], float abr, float abi, float& hr, float& hi) {
    float bur = 0.f, bui = 0.f;
#pragma unroll
    for (int c8 = 0; c8 < 2; ++c8) {
        const pg8::u32x4 uv = *(const pg8::u32x4*)(urow + c8 * 8);
#pragma unroll
        for (int j = 0; j < 4; ++j) {
            const float u0 = __uint_as_float(uv[j] << 16), u1 = __uint_as_float(uv[j] & 0xffff0000u);
            bur += bbr[c8 * 8 + 2 * j] * u0 + bbr[c8 * 8 + 2 * j + 1] * u1; bui += bbi[c8 * 8 + 2 * j] * u0 + bbi[c8 * 8 + 2 * j + 1] * u1;
        }
    }
    const float nr = abr * hr - abi * hi + bur, ni = abr * hi + abi * hr + bui;
    hr = nr; hi = ni;
}

DEV void phase_s1(const Params& p, int e, char* smem, int first, int stride) {
    const int tid = TID(), lane = tid & 63, w = tid >> 6;
    bf16_t* us = (bf16_t*)smem;
    float2* carry = (float2*)((char*)p.out + OUT_CARRY);
    for (int ib = first; ib < 4 * NCH * 4; ib += stride) {
        const int gq = ib & 3, rest = ib >> 2, sc = rest % NCH, bd = rest / NCH, dir = bd & 1, b = bd >> 1, g = gq * 8 + w;
        __syncthreads();
        s5_load_u(p, us, gq, [&](int s) { return stream_row64(b, dir, sc, s); });
        float abr, abi, cr, ci; s5_disc(p, e, dir, g, lane, abr, abi, cr, ci);
        float bbr[16], bbi[16]; s5_bbar(p, e, g, lane, cr, ci, bbr, bbi);
        __syncthreads();
        float hr = 0.f, hi = 0.f;
        for (int s = 0; s < 64; ++s) s5_step(us + s * 128 + w * 16, bbr, bbi, abr, abi, hr, hi);
        carry[((size_t)((b * 2 + dir) * 32 + g) * NCH + sc) * 64 + lane] = make_float2(hr, hi);
    }
}

DEV void phase_s2(const Params& p, int e, int bid) {
    const int gid = (bid + PZ()) * 512 + TID();
    if (gid < 128 * 64) {
    const int pp = gid & 63, chain = gid >> 6, dir = (chain >> 5) & 1, g = chain & 31;
    const float* dt = s5_dt(p, e, dir, g, pp); const float ar = dt[4], ai = dt[5];
    float2* E = (float2*)((char*)p.out + OUT_CARRY) + (size_t)chain * NCH * 64 + pp;
    float hr = 0.f, hi = 0.f;
    for (int sc = 0; sc < NCH; ++sc) {
        const float2 t = E[(size_t)sc * 64];
        E[(size_t)sc * 64] = make_float2(hr, hi);
        const float nr = ar * hr - ai * hi + t.x, ni = ar * hi + ai * hr + t.y;
        hr = nr; hi = ni;
    }
    }
}

DEV float gelu_tanh(float x) {
    const float z = 0.7978845608028654f * (x + 0.044715f * x * x * x);
    const float t = 1.f - 2.f * __builtin_amdgcn_rcpf(__expf(2.f * z) + 1.f);
    return 0.5f * x * (1.f + t);
}

DEV void phase_s3(const Params& p, int e, char* smem) {
    const int tid = TID(), lane = tid & 63, w = tid >> 6, l15 = lane & 15, lq = lane >> 4;
    bf16_t* us = (bf16_t*)smem;
    float* bub = (float*)(smem + 16384) + (size_t)w * 3200;
    bf16_t* hb = (bf16_t*)(bub + 16 * 132);
    const float2* carry = (const float2*)((char*)p.out + OUT_CARRY);
    bf16_t* ybuf = (bf16_t*)(p.ws + OFF_SCR + SCR_YB);
    for (int ib = blockIdx.x; ib < NB * NCH * 4; ib += gridDim.x) {
        const int gq = ib & 3, rest = ib >> 2, qc = rest % NCH, b = rest / NCH, g = gq * 8 + w;
        const int row0 = qc < 4 ? NLAT + b * CTXL + qc * 64 : b * SEQ + (qc - 4) * 64;
        __syncthreads();
        s5_load_u(p, us, gq, [&](int s) { return row0 + s; });
        s16x8 cm[4];
        {
            const float* cre = p.in[PZ() + I_CRE] + ((size_t)(e * 32 + g) * 16 + l15) * 64; const float* cim = p.in[PZ() + I_CIM] + ((size_t)(e * 32 + g) * 16 + l15) * 64;
#pragma unroll
            for (int ks = 0; ks < 4; ++ks) {
                const float* src = (ks < 2 ? cre : cim) + (32 * ks + 8 * lq) % 64; const float sg = ks < 2 ? 1.f : -1.f;
                const float4 c0 = *(const float4*)src, c1 = *(const float4*)(src + 4);
                cm[ks][0] = (short)f2bf(sg * c0.x); cm[ks][1] = (short)f2bf(sg * c0.y); cm[ks][2] = (short)f2bf(sg * c0.z); cm[ks][3] = (short)f2bf(sg * c0.w);
                cm[ks][4] = (short)f2bf(sg * c1.x); cm[ks][5] = (short)f2bf(sg * c1.y); cm[ks][6] = (short)f2bf(sg * c1.z); cm[ks][7] = (short)f2bf(sg * c1.w);
            }
        }
        f32x4 yacc[4];
#pragma unroll
        for (int i = 0; i < 4; ++i) yacc[i] = (f32x4){0.f, 0.f, 0.f, 0.f};
        __syncthreads();
#pragma unroll
        for (int dir = 0; dir < 2; ++dir) {
            s16x8 bf[8]; s5_bfrag(p, e, dir, g, l15, lq, bf);
            const float* dt = s5_dt(p, e, dir, g, lane); const float abr = dt[0], abi = dt[1];
            const int sc = dir ? (qc < 4 ? 3 - qc : 4 + (255 - (qc - 4))) : qc;
            const float2 h0 = carry[((size_t)((b * 2 + dir) * 32 + g) * NCH + sc) * 64 + lane];
            float hr = h0.x, hi = h0.y;
#pragma unroll
            for (int bi = 0; bi < 4; ++bi) {
                const int blk = dir ? 3 - bi : bi;
                s5_bu(us, blk * 16, w, l15, lq, bf, bub);
                wave_sync();
#pragma unroll
                for (int tt = 0; tt < 16; ++tt) {
                    const int t = dir ? 15 - tt : tt;
                    const float bur = bub[t * 132 + lane], bui = bub[t * 132 + 64 + lane];
                    const float nr = abr * hr - abi * hi + bur, ni = abr * hi + abi * hr + bui; hr = nr; hi = ni;
                    hb[t * 136 + lane] = f2bf(hr); hb[t * 136 + 64 + lane] = f2bf(hi);
                }
                wave_sync();
#pragma unroll
                for (int ks = 0; ks < 4; ++ks) {
                    const s16x8 a = *(const s16x8*)(hb + l15 * 136 + 32 * ks + 8 * lq);
                    yacc[blk] = __builtin_amdgcn_mfma_f32_16x16x32_bf16(a, cm[ks], yacc[blk], 0, 0, 0);
                }
                wave_sync();
            }
        }
        {
            const float dsk = p.in[PZ() + I_S5D][(size_t)e * 512 + g * 16 + l15];
#pragma unroll
            for (int blk = 0; blk < 4; ++blk)
#pragma unroll
                for (int j = 0; j < 4; ++j) {
                    const int t = 16 * blk + 4 * lq + j;
                    const float y = yacc[blk][j] + dsk * bf2f(us[t * 128 + w * 16 + l15]);
                    ybuf[(size_t)(row0 + t) * 512 + g * 16 + l15] = f2bf(gelu_tanh(y));
                }
        }
    }
}

DEV float gdn_conv(const bf16_t* P, const float* cw, int row, int t, int L, int col) {
    float acc = 0.f;
#pragma unroll
    for (int j = 0; j < 5; ++j) { const int tt = t + j - 2; if (tt >= 0 && tt < L) acc += bf2f(P[(size_t)(row + j - 2) * ABN + col]) * cw[j * 1536 + col]; }
    return acc;
}

static_assert(OUT_KNT + (size_t)2080 * 8192 * 2 <= (size_t)NLAT * D * 4, "knT must fit in d_out");

DEV void phase_g1(const Params& p, int e, char* smem) {
    const int tid = TID(), lane = tid & 63, w = tid >> 6;
    float* qs = (float*)smem; float* ks = qs + 64 * 132; float* KKr = ks + 64 * 132; float* QKr = KKr + 64 * 68; float* gcA = QKr + 64 * 68; float* btA = gcA + 128;
    float* As = qs; float* Xs = qs + 64 * 68;
    const bf16_t* P = (const bf16_t*)(p.ws + OFF_P);
    bf16_t* qn = (bf16_t*)(p.ws + OFF_QN); bf16_t* kn = (bf16_t*)(p.ws + OFF_KN); bf16_t* vc = (bf16_t*)(p.ws + OFF_HN);
    bf16_t* knT = (bf16_t*)((char*)p.out + OUT_KNT);
    bf16_t* Tg = (bf16_t*)(p.ws + OFF_SCR + SCR_T); bf16_t* QKg = (bf16_t*)(p.ws + OFF_SCR + SCR_QK); float* gb = (float*)(p.ws + OFF_SCR + SCR_GB);
    const float* cw = p.in[PZ() + I_GCONV] + (size_t)e * 5 * 1536;
    for (int item = blockIdx.x; item < 2080; item += gridDim.x) {
        const int qc = item % NCH, bh = item / NCH, h = bh & 3, b = bh >> 2;
        const int oc = qc < 4 ? qc : qc - 4;
        const int base = qc < 4 ? NLAT + b * CTXL : b * SEQ, L = qc < 4 ? CTXL : SEQ;
        const int sc1 = qc < 4 ? 3 - qc : 4 + (255 - oc);
        lds_barrier();
        {
            for (int ps = 0; ps < 2; ++ps) {
                if (ps == 1 && tid >= 256) break;
                const int pair = ps == 0 ? (tid & 127) : (tid & 63), tg = ps == 0 ? (tid >> 7) : (tid >> 6);
                const int cidx = 2 * pair;
                const int col = ps == 1 ? 1024 + h * 128 + cidx : (cidx < 128 ? h * 128 + cidx : 512 + h * 128 + (cidx - 128));
                float2 wv[5];
#pragma unroll
                for (int j = 0; j < 5; ++j) wv[j] = *(const float2*)(cw + j * 1536 + col);
                auto ld = [&](int n) -> float2 {
                    const int t = oc * 64 + n;
                    if (t < 0 || t >= L) return make_float2(0.f, 0.f);
                    const unsigned raw = *(const unsigned*)(P + (size_t)(base + t) * ABN + col);
                    return make_float2(__uint_as_float(raw << 16), __uint_as_float(raw & 0xffff0000u));
                };
                const int n0 = tg * 16;
                float2 xm2 = ld(n0 - 2), xm1 = ld(n0 - 1), x0 = ld(n0), xp1 = ld(n0 + 1);
#pragma unroll
                for (int i = 0; i < 16; ++i) {
                    const float2 xp2 = ld(n0 + i + 2);
                    const float a0 = xm2.x * wv[0].x + xm1.x * wv[1].x + x0.x * wv[2].x + xp1.x * wv[3].x + xp2.x * wv[4].x;
                    const float a1 = xm2.y * wv[0].y + xm1.y * wv[1].y + x0.y * wv[2].y + xp1.y * wv[3].y + xp2.y * wv[4].y;
                    const int n = n0 + i;
                    if (ps == 0) *(float2*)((cidx < 128 ? qs : ks) + n * 132 + (cidx & 127)) = make_float2(silu(a0), silu(a1));
                    else *(unsigned*)(vc + (size_t)(base + oc * 64 + n) * D + h * 128 + cidx) = pack2(silu(a0), silu(a1));
                    xm2 = xm1; xm1 = x0; x0 = xp1; xp1 = xp2;
                }
            }
        }
        lds_barrier();
        {
            const int vec = tid >> 2, isk = vec >> 6, s = vec & 63, qt = tid & 3;
            float* x = (isk ? ks : qs) + s * 132 + qt * 32;
            float4 v4[8]; float ss = 0.f;
#pragma unroll
            for (int i = 0; i < 8; ++i) { v4[i] = *(const float4*)(x + 4 * i); ss += v4[i].x * v4[i].x + v4[i].y * v4[i].y + v4[i].z * v4[i].z + v4[i].w * v4[i].w; }
            ss = sum4(ss);
            const float scl = rsqrtf(ss + 1e-6f) * (isk ? 1.f : 0.08838834764831845f);
            pg8::u32x4* o = (pg8::u32x4*)((isk ? kn : qn) + (size_t)(base + oc * 64 + s) * 512 + h * 128 + qt * 32);
#pragma unroll
            for (int i = 0; i < 4; ++i) {
                float4 a = v4[2 * i], c = v4[2 * i + 1];
                a.x *= scl; a.y *= scl; a.z *= scl; a.w *= scl; c.x *= scl; c.y *= scl; c.z *= scl; c.w *= scl;
                *(float4*)(x + 8 * i) = a; *(float4*)(x + 8 * i + 4) = c;
                pg8::u32x4 wv; wv.x = pack2(a.x, a.y); wv.y = pack2(a.z, a.w); wv.z = pack2(c.x, c.y); wv.w = pack2(c.z, c.w);
                o[i] = wv;
            }
        }
        if (tid < 128) {
            const int dir = tid >> 6, s = tid & 63, n = dir ? 63 - s : s, row = base + oc * 64 + n;
            const int ci = ((b * 4 + h) * 2 + dir) * NCH + (dir ? sc1 : qc);
            const float a = bf2f(P[(size_t)row * ABN + 2048 + dir * 4 + h]), bb = bf2f(P[(size_t)row * ABN + 2056 + dir * 4 + h]);
            const float x = a + p.in[PZ() + I_GDT][(e * 2 + dir) * 4 + h];
            const float sp = x > 20.f ? x : __logf(1.f + __expf(x));
            float la = -__expf(p.in[PZ() + I_GALOG][(e * 2 + dir) * 4 + h]) * sp;
#pragma unroll
            for (int o = 1; o < 64; o <<= 1) { const float t = __shfl_up(la, o, 64); if (lane >= o) la += t; }
            const float be = sigm(bb);
            gcA[dir * 64 + s] = la; btA[dir * 64 + s] = be; gb[(size_t)ci * 128 + s] = la; gb[(size_t)ci * 128 + 64 + s] = be;
        }
        lds_barrier();
        {
            const int d = tid >> 2, tq = (tid & 3) * 16;
            unsigned o[8];
#pragma unroll
            for (int i = 0; i < 8; ++i) o[i] = pack2(ks[(tq + 2 * i) * 132 + d], ks[(tq + 2 * i + 1) * 132 + d]);
            pg8::u32x4* dst = (pg8::u32x4*)(knT + ((size_t)(bh * NCH + qc) * 128 + d) * 64 + tq);
            pg8::u32x4 w0, w1; w0.x = o[0]; w0.y = o[1]; w0.z = o[2]; w0.w = o[3]; w1.x = o[4]; w1.y = o[5]; w1.z = o[6]; w1.w = o[7];
            dst[0] = w0; dst[1] = w1;
        }
        {
            const int l15 = lane & 15, lq = lane >> 4;
            for (int job = w; job < 26; job += 8) {
                int mi, ni; const bool isq = job >= 10;
                if (isq) { mi = (job - 10) >> 2; ni = (job - 10) & 3; }
                else { mi = job >= 6 ? 3 : (job >= 3 ? 2 : (job >= 1 ? 1 : 0)); ni = job - (mi * (mi + 1)) / 2; }
                const float* X = isq ? qs : ks;
                f32x4 acc = {0.f, 0.f, 0.f, 0.f};
#pragma unroll
                for (int dd = 0; dd < 8; ++dd) {
                    const float4 a4 = *(const float4*)(X + (16 * mi + l15) * 132 + 16 * dd + 4 * lq), b4 = *(const float4*)(ks + (16 * ni + l15) * 132 + 16 * dd + 4 * lq);
                    acc = __builtin_amdgcn_mfma_f32_16x16x4f32(a4.x, b4.x, acc, 0, 0, 0); acc = __builtin_amdgcn_mfma_f32_16x16x4f32(a4.y, b4.y, acc, 0, 0, 0);
                    acc = __builtin_amdgcn_mfma_f32_16x16x4f32(a4.z, b4.z, acc, 0, 0, 0); acc = __builtin_amdgcn_mfma_f32_16x16x4f32(a4.w, b4.w, acc, 0, 0, 0);
                }
                const int jc = 16 * ni + l15;
#pragma unroll
                for (int j = 0; j < 4; ++j) {
                    const int i = 16 * mi + 4 * lq + j;
                    if (isq) QKr[i * 68 + jc] = acc[j];
                    else { KKr[i * 68 + jc] = acc[j]; if (mi != ni) KKr[jc * 68 + i] = acc[j]; }
                }
            }
        }
        lds_barrier();
        for (int dir = 0; dir < 2; ++dir) {
            const int ci = ((b * 4 + h) * 2 + dir) * NCH + (dir ? sc1 : qc);
            const float* gc = gcA + dir * 64; const float* bt = btA + dir * 64;
            {
                const int si = tid >> 3, jg = tid & 7, ni_ = dir ? 63 - si : si;
                const float gi = gc[si], bi = bt[si];
                unsigned o[4];
#pragma unroll
                for (int j2 = 0; j2 < 4; ++j2) {
                    float q2[2];
#pragma unroll
                    for (int jj = 0; jj < 2; ++jj) {
                        const int sj = jg * 8 + j2 * 2 + jj, nj = dir ? 63 - sj : sj;
                        const float dec = sj <= si ? __expf(gi - gc[sj]) : 0.f;
                        As[si * 68 + (sj & 7) * 8 + (sj >> 3)] = sj < si ? KKr[ni_ * 68 + nj] * dec * bi : 0.f;
                        q2[jj] = QKr[ni_ * 68 + nj] * dec;
                    }
                    o[j2] = pack2(q2[0], q2[1]);
                }
                pg8::u32x4 wv; wv.x = o[0]; wv.y = o[1]; wv.z = o[2]; wv.w = o[3];
                *(pg8::u32x4*)(QKg + (size_t)ci * 4096 + si * 64 + jg * 8) = wv;
            }
            lds_barrier();
            {
                const int c = 8 * w + (lane >> 3), part = lane & 7;
                float X[8];
#pragma unroll
                for (int m = 0; m < 8; ++m) X[m] = 0.f;
#pragma unroll
                for (int i = 0; i < 64; ++i) {
                    const float4 a0 = *(const float4*)(As + i * 68 + part * 8), a1 = *(const float4*)(As + i * 68 + part * 8 + 4);
                    float acc = a0.x * X[0] + a0.y * X[1] + a0.z * X[2] + a0.w * X[3] + a1.x * X[4] + a1.y * X[5] + a1.z * X[6] + a1.w * X[7];
                    acc = sum8(acc);
                    const float x = (i == c ? 1.f : 0.f) - acc;
                    if (part == (i & 7)) X[i >> 3] = x;
                }
#pragma unroll
                for (int m = 0; m < 8; ++m) Xs[(part + 8 * m) * 65 + c] = X[m];
            }
            lds_barrier();
            {
                const int i = tid >> 3, jg = tid & 7;
                pg8::u32x4 wv;
                wv.x = pack2(Xs[i * 65 + jg * 8 + 0], Xs[i * 65 + jg * 8 + 1]); wv.y = pack2(Xs[i * 65 + jg * 8 + 2], Xs[i * 65 + jg * 8 + 3]);
                wv.z = pack2(Xs[i * 65 + jg * 8 + 4], Xs[i * 65 + jg * 8 + 5]); wv.w = pack2(Xs[i * 65 + jg * 8 + 6], Xs[i * 65 + jg * 8 + 7]);
                *(pg8::u32x4*)(Tg + (size_t)ci * 4096 + i * 64 + jg * 8) = wv;
            }
            lds_barrier();
        }
    }
}

DEV void phase_g2(const Params& p, int e, char* smem) {
    (void)e;
    const int tid = TID(), lane = tid & 63, w = tid >> 6, l15 = lane & 15, lq = lane >> 4;
    bf16_t* Kc = (bf16_t*)smem; bf16_t* Qc = Kc + 64 * 136; bf16_t* KT = Qc + 64 * 136; bf16_t* Tc = KT + 128 * 72; bf16_t* QKc = Tc + 64 * 72;
    bf16_t* ST = QKc + 64 * 72; bf16_t* rT = ST + 16 * 136; bf16_t* uT = rT + 16 * 72; bf16_t* u2T = uT + 16 * 72;
    float* vS = (float*)(u2T + 16 * 72); float* gc = vS + 64 * 17; float* bt = gc + 64; bf16_t* oS = (bf16_t*)(bt + 64);
    const bf16_t* qn = (const bf16_t*)(p.ws + OFF_QN); const bf16_t* kn = (const bf16_t*)(p.ws + OFF_KN); const bf16_t* vc = (const bf16_t*)(p.ws + OFF_HN);
    const bf16_t* knT = (const bf16_t*)((const char*)p.out + OUT_KNT);
    const bf16_t* Tg = (const bf16_t*)(p.ws + OFF_SCR + SCR_T); const bf16_t* QKg = (const bf16_t*)(p.ws + OFF_SCR + SCR_QK); const float* gb = (const float*)(p.ws + OFF_SCR + SCR_GB);
    bf16_t* ob = (bf16_t*)p.out;
    for (int item = blockIdx.x; item < 128; item += gridDim.x) {
        const int chain = (item & 7) * 2 + ((item >> 3) & 1), e0 = (item >> 4) * 16, dir = chain & 1, h = (chain >> 1) & 3, b = chain >> 3, bh = chain >> 1;
        struct Pf { pg8::u32x4 rk[2], rq[2], rkt[2], rt, rqk; unsigned rv; float rg; };
        Pf R0, R1;
        const int ls = tid >> 3, lp = tid & 7;
        const int kd = tid >> 2, ktq = (tid & 3) * 16;
        auto fetch = [&](Pf& R, int sc) {
            const int ci = chain * NCH + sc, row = stream_row64(b, dir, sc, ls);
            const int oc = sc < 4 ? (dir ? 3 - sc : sc) : (dir ? 255 - (sc - 4) : sc - 4), qc = sc < 4 ? oc : 4 + oc;
            const pg8::u32x4* sk = (const pg8::u32x4*)(kn + (size_t)row * 512 + h * 128 + lp * 16); R.rk[0] = sk[0]; R.rk[1] = sk[1];
            const pg8::u32x4* sq = (const pg8::u32x4*)(qn + (size_t)row * 512 + h * 128 + lp * 16); R.rq[0] = sq[0]; R.rq[1] = sq[1];
            const pg8::u32x4* st = (const pg8::u32x4*)(knT + ((size_t)(bh * NCH + qc) * 128 + kd) * 64 + ktq); R.rkt[0] = st[0]; R.rkt[1] = st[1];
            R.rt = *(const pg8::u32x4*)(Tg + (size_t)ci * 4096 + ls * 64 + lp * 8); R.rqk = *(const pg8::u32x4*)(QKg + (size_t)ci * 4096 + ls * 64 + lp * 8);
            R.rv = *(const unsigned*)(vc + (size_t)row * D + h * 128 + e0 + 2 * lp);
            R.rg = gb[(size_t)ci * 128 + (tid & 127)];
        };
        auto stash = [&](const Pf& R) {
            pg8::u32x4* dk = (pg8::u32x4*)(Kc + ls * 136 + lp * 16); dk[0] = R.rk[0]; dk[1] = R.rk[1];
            pg8::u32x4* dq = (pg8::u32x4*)(Qc + ls * 136 + lp * 16); dq[0] = R.rq[0]; dq[1] = R.rq[1];
            pg8::u32x4* dt = (pg8::u32x4*)(KT + kd * 72 + ktq); dt[0] = R.rkt[0]; dt[1] = R.rkt[1];
            *(pg8::u32x4*)(Tc + ls * 72 + lp * 8) = R.rt; *(pg8::u32x4*)(QKc + ls * 72 + lp * 8) = R.rqk;
            vS[ls * 17 + 2 * lp] = __uint_as_float(R.rv << 16); vS[ls * 17 + 2 * lp + 1] = __uint_as_float(R.rv & 0xffff0000u);
            if (tid < 64) gc[tid] = R.rg; else if (tid < 128) bt[tid - 64] = R.rg;
        };
        f32x4 Sreg = {0.f, 0.f, 0.f, 0.f};
        lds_barrier();
        for (int i = tid; i < 16 * 136 / 2; i += 512) ((unsigned*)ST)[i] = 0u;
        fetch(R0, 0); stash(R0); fetch(R0, 1);
        lds_barrier();
        auto step = [&](int sc) {
            const int sel = w >> 2, mt = w & 3;
            const bf16_t* Xc = sel ? Qc : Kc;
            f32x4 acc = {0.f, 0.f, 0.f, 0.f};
#pragma unroll
            for (int kq = 0; kq < 4; ++kq) {
                const s16x8 a = *(const s16x8*)(Xc + (16 * mt + l15) * 136 + 32 * kq + 8 * lq), bb = *(const s16x8*)(ST + l15 * 136 + 32 * kq + 8 * lq);
                acc = __builtin_amdgcn_mfma_f32_16x16x32_bf16(a, bb, acc, 0, 0, 0);
            }
            const int t0 = 16 * mt + 4 * lq;
            float eg[4];
#pragma unroll
            for (int j = 0; j < 4; ++j) eg[j] = __expf(gc[t0 + j]);
            const float gl = gc[63];
            if (sel == 0) {
                float r[4];
#pragma unroll
                for (int j = 0; j < 4; ++j) r[j] = bt[t0 + j] * (vS[(t0 + j) * 17 + l15] - eg[j] * acc[j]);
                u32x2 wv; wv.x = pack2(r[0], r[1]); wv.y = pack2(r[2], r[3]);
                *(u32x2*)(rT + l15 * 72 + t0) = wv;
            } else {
#pragma unroll
                for (int j = 0; j < 4; ++j) acc[j] *= eg[j];
            }
            lds_barrier();
            if (sel == 0) {
                f32x4 ua = {0.f, 0.f, 0.f, 0.f};
#pragma unroll
                for (int kq = 0; kq < 2; ++kq) {
                    const s16x8 a = *(const s16x8*)(Tc + (16 * mt + l15) * 72 + 32 * kq + 8 * lq), bb = *(const s16x8*)(rT + l15 * 72 + 32 * kq + 8 * lq);
                    ua = __builtin_amdgcn_mfma_f32_16x16x32_bf16(a, bb, ua, 0, 0, 0);
                }
                u32x2 wv; wv.x = pack2(ua[0], ua[1]); wv.y = pack2(ua[2], ua[3]);
                *(u32x2*)(uT + l15 * 72 + t0) = wv;
                float u2[4];
#pragma unroll
                for (int j = 0; j < 4; ++j) u2[j] = __expf(gl - gc[t0 + j]) * ua[j];
                if (dir == 0) { wv.x = pack2(u2[0], u2[1]); wv.y = pack2(u2[2], u2[3]); *(u32x2*)(u2T + l15 * 72 + t0) = wv; }
                else { wv.x = pack2(u2[3], u2[2]); wv.y = pack2(u2[1], u2[0]); *(u32x2*)(u2T + l15 * 72 + (60 - t0)) = wv; }
            }
            lds_barrier();
            if (sel == 1) {
#pragma unroll
                for (int kq = 0; kq < 2; ++kq) {
                    const s16x8 a = *(const s16x8*)(QKc + (16 * mt + l15) * 72 + 32 * kq + 8 * lq), bb = *(const s16x8*)(uT + l15 * 72 + 32 * kq + 8 * lq);
                    acc = __builtin_amdgcn_mfma_f32_16x16x32_bf16(a, bb, acc, 0, 0, 0);
                }
#pragma unroll
                for (int j = 0; j < 4; ++j) oS[(t0 + j) * 16 + l15] = f2bf(acc[j]);
            }
            {
                const float egl = __expf(gl);
#pragma unroll
                for (int j = 0; j < 4; ++j) Sreg[j] *= egl;
#pragma unroll
                for (int kq = 0; kq < 2; ++kq) {
                    const s16x8 a = *(const s16x8*)(u2T + l15 * 72 + 32 * kq + 8 * lq), bb = *(const s16x8*)(KT + (16 * w + l15) * 72 + 32 * kq + 8 * lq);
                    Sreg = __builtin_amdgcn_mfma_f32_16x16x32_bf16(a, bb, Sreg, 0, 0, 0);
                }
#pragma unroll
                for (int j = 0; j < 4; ++j) ST[(4 * lq + j) * 136 + 16 * w + l15] = f2bf(Sreg[j]);
            }
            lds_barrier();
            *(unsigned*)(ob + ((size_t)dir * NTOK + stream_row64(b, dir, sc, ls)) * 512 + h * 128 + e0 + 2 * lp) = *(const unsigned*)(oS + ls * 16 + 2 * lp);
        };
        for (int sc = 0; sc < NCH; sc += 2) {
            fetch(R1, sc + 2 < NCH ? sc + 2 : NCH - 1);
            step(sc);
            stash(R0); lds_barrier();
            fetch(R0, sc + 3 < NCH ? sc + 3 : NCH - 1);
            step(sc + 1);
            stash(R1);
            lds_barrier();
        }
    }
}

DEV void phase_combine(const Params& p, const bf16_t* G, int ldg, int gcol, const float* ng, int ocol, int bfirst, int nblk) {
    const int tid = TID(), lane = tid & 63, wid = tid >> 6;
    const bf16_t* ob = (const bf16_t*)p.out;
    bf16_t* ym = (bf16_t*)(p.ws + OFF_HN);
    const int c0 = lane * 8, d0 = c0 & 127;
    for (int row = bfirst * 8 + wid; row < NTOK; row += nblk * 8) {
        const pg8::u32x4 a = *(const pg8::u32x4*)(ob + (size_t)row * 512 + c0), bq = *(const pg8::u32x4*)(ob + ((size_t)NTOK + row) * 512 + c0);
        const pg8::u32x4 gv = *(const pg8::u32x4*)(G + (size_t)row * ldg + gcol + c0);
        float o[8], gt[8]; float ss = 0.f;
#pragma unroll
        for (int j = 0; j < 4; ++j) {
            o[2 * j] = __uint_as_float(a[j] << 16) + __uint_as_float(bq[j] << 16); o[2 * j + 1] = __uint_as_float(a[j] & 0xffff0000u) + __uint_as_float(bq[j] & 0xffff0000u);
            gt[2 * j] = __uint_as_float(gv[j] << 16); gt[2 * j + 1] = __uint_as_float(gv[j] & 0xffff0000u);
            ss += o[2 * j] * o[2 * j] + o[2 * j + 1] * o[2 * j + 1];
        }
        ss = sum16(ss);
        const float rstd = rsqrtf(ss * (1.f / 128.f) + 1e-6f);
        pg8::u32x4 wv;
        float y[8];
#pragma unroll
        for (int j = 0; j < 8; ++j) y[j] = o[j] * rstd * ng[d0 + j] * silu(gt[j]);
        wv.x = pack2(y[0], y[1]); wv.y = pack2(y[2], y[3]); wv.z = pack2(y[4], y[5]); wv.w = pack2(y[6], y[7]);
        *(pg8::u32x4*)(ym + (size_t)row * D + ocol + c0) = wv;
    }
}

DEV float2 cf_ld(const bf16_t* P, int row, int ch) { const unsigned v = *(const unsigned*)(P + (size_t)row * CDN + ch); return make_float2(__uint_as_float(v << 16), __uint_as_float(v & 0xffff0000u)); }
template <int NOUT, int STRIDE> DEV void cf_task(const bf16_t* P, const float* wl, float2 bias, int rowbase, int pos0, int len, int ch, float* tile, int tok0, int tokstep) {
    float2 x[NOUT + 30];
#pragma unroll
    for (int i = 0; i < NOUT + 30; ++i) {
        const int pp = pos0 - 15 + i;
        const bool ok = pp >= 0 && pp < len;
        x[i] = cf_ld(P, rowbase + (ok ? pp : pos0) * STRIDE, ch);
        x[i].x = ok ? x[i].x : 0.f; x[i].y = ok ? x[i].y : 0.f;
    }
    float2 acc[NOUT];
#pragma unroll
    for (int o = 0; o < NOUT; ++o) acc[o] = make_float2(0.f, 0.f);
#pragma unroll
    for (int j = 0; j < 31; ++j) {
        const float2 wv = *(const float2*)(wl + j * 512 + ch);
#pragma unroll
        for (int o = 0; o < NOUT; ++o) { acc[o].x += x[o + j].x * wv.x; acc[o].y += x[o + j].y * wv.y; }
    }
#pragma unroll
    for (int o = 0; o < NOUT; ++o) *(float2*)(tile + (tok0 + o * tokstep) * 516 + ch) = make_float2(acc[o].x + bias.x, acc[o].y + bias.y);
}
DEV void phase_conformer(const Params& p, int o, char* smem) {
    const int tid = TID(), lane = tid & 63, w = tid >> 6;
    float* tile = (float*)smem;
    const bf16_t* P = (const bf16_t*)(p.ws + OFF_P);
    bf16_t* ym = (bf16_t*)(p.ws + OFF_HN);
    const float* dw = p.in[PZ() + I_DWW] + (size_t)o * 31 * 512;
    const int pair = tid & 127, sub = tid >> 7, chW = 2 * pair, chV = 256 + 2 * pair;
    float* wl = tile + 32 * 516;
    __syncthreads();
    for (int i = tid; i < 31 * 512; i += 512) wl[i] = dw[i];
    const float2 bW = *(const float2*)(p.in[PZ() + I_DWB] + (size_t)o * 512 + chW), bV = *(const float2*)(p.in[PZ() + I_DWB] + (size_t)o * 512 + chV);
    for (int it = blockIdx.x; it < 1040; it += gridDim.x) {
        __syncthreads();
        int rowtok0, rowstep_r;
        if (it < 1024) {
            const int b = it >> 9, r0 = ((it >> 3) & 63) * 4, w0 = (it & 7) * 8;
            cf_task<8, 1>(P, wl, bW, b * SEQ + (r0 + sub) * 64, w0, 64, chW, tile, sub * 8, 1);
#pragma unroll
            for (int k = 0; k < 2; ++k) { const int ww = 2 * sub + k; cf_task<4, 64>(P, wl, bV, b * SEQ + w0 + ww, r0, 256, chV, tile, ww, 8); }
            rowtok0 = b * SEQ + r0 * 64 + w0; rowstep_r = 64;
        } else {
            const int ci = it - 1024, b = ci >> 3, t0 = (ci & 7) * 32;
            cf_task<8, 1>(P, wl, bW, NLAT + b * CTXL, t0 + sub * 8, CTXL, chW, tile, sub * 8, 1);
            cf_task<8, 1>(P, wl, bV, NLAT + b * CTXL, t0 + sub * 8, CTXL, chV, tile, sub * 8, 1);
            rowtok0 = NLAT + b * CTXL + t0; rowstep_r = 8;
        }
        __syncthreads();
        const float* lg = p.in[PZ() + I_LNG] + (size_t)o * 512 + lane * 8; const float* lbb = p.in[PZ() + I_LNB] + (size_t)o * 512 + lane * 8;
        for (int q = 0; q < 4; ++q) {
            const int tok = w * 4 + q, orow = rowtok0 + (tok >> 3) * rowstep_r + (tok & 7);
            const float4 v0 = *(const float4*)(tile + tok * 516 + lane * 8), v1 = *(const float4*)(tile + tok * 516 + lane * 8 + 4);
            float x[8] = {v0.x, v0.y, v0.z, v0.w, v1.x, v1.y, v1.z, v1.w};
            float s = 0.f;
#pragma unroll
            for (int j = 0; j < 8; ++j) s += x[j];
            const float mean = wave_sum(s) * (1.f / 512.f);
            float vs = 0.f;
#pragma unroll
            for (int j = 0; j < 8; ++j) { x[j] -= mean; vs += x[j] * x[j]; }
            const float rstd = rsqrtf(wave_sum(vs) * (1.f / 512.f) + 1e-6f);
            float y[8];
#pragma unroll
            for (int j = 0; j < 8; ++j) y[j] = silu(x[j] * rstd * lg[j] + lbb[j]);
            pg8::u32x4 wv; wv.x = pack2(y[0], y[1]); wv.y = pack2(y[2], y[3]); wv.z = pack2(y[4], y[5]); wv.w = pack2(y[6], y[7]);
            *(pg8::u32x4*)(ym + (size_t)orow * D + lane * 8) = wv;
        }
    }
}

DEV int hgrn_row(int b, int dir, int bc, int s) {
    if (bc == 0) return NLAT + b * CTXL + (dir ? 255 - s : s);
    const int lc = bc - 1, oc = dir ? 63 - lc : lc; return b * SEQ + oc * 256 + (dir ? 255 - s : s);
}
DEV void phase_h1(const Params& p, int o, char* smem, int skew) {
    const int tid = TID(), lane = tid & 63, w = tid >> 6, l15 = lane & 15, lq = lane >> 4;
    bf16_t* kT = (bf16_t*)smem; bf16_t* vT = kT + 128 * 264; float* seg = (float*)(vT + 128 * 264);
    const bf16_t* P = (const bf16_t*)(p.ws + OFF_P);
    float* dS = (float*)(p.ws + OFF_SCR + SCR_DS); float* Dd = (float*)(p.ws + OFF_SCR + SCR_DD);
    const float* lball = (const float*)(p.ws + OFF_LB) + (size_t)o * 512;
    const int d = tid & 127, tq = tid >> 7;
    for (int it = (int)((blockIdx.x + gridDim.x - skew % gridDim.x) % gridDim.x); it < 16 * NBC; it += gridDim.x) {
        const int chain = it / NBC, bc = it % NBC, dir = chain & 1, h = (chain >> 1) & 3, b = chain >> 3;
        const float lb = lball[h * 128 + d];
        const size_t cf = (size_t)1024 + 512 + dir * 512 + h * 128 + d, cv = (size_t)1024 + 1536 + h * 128 + d;
        lds_barrier();
        float sum = 0.f;
        for (int i8 = 0; i8 < 8; ++i8) {
            unsigned o8[4];
#pragma unroll
            for (int j2 = 0; j2 < 4; ++j2) {
                const size_t r0 = (size_t)hgrn_row(b, dir, bc, tq * 64 + i8 * 8 + 2 * j2) * CDN, r1 = (size_t)hgrn_row(b, dir, bc, tq * 64 + i8 * 8 + 2 * j2 + 1) * CDN;
                const float f0 = lb + (1.f - lb) * sigm(bf2f(P[r0 + cf])), f1 = lb + (1.f - lb) * sigm(bf2f(P[r1 + cf]));
                sum += __logf(f0) + __logf(f1);
                o8[j2] = (unsigned)P[r0 + cv] | ((unsigned)P[r1 + cv] << 16);
            }
            pg8::u32x4 wv; wv.x = o8[0]; wv.y = o8[1]; wv.z = o8[2]; wv.w = o8[3];
            *(pg8::u32x4*)(vT + d * 264 + tq * 64 + i8 * 8) = wv;
        }
        seg[tq * 128 + d] = sum;
        lds_barrier();
        float r = 0.f;
        for (int q = tq + 1; q < 4; ++q) r += seg[q * 128 + d];
        for (int i8 = 7; i8 >= 0; --i8) {
            float ko[8];
#pragma unroll
            for (int j = 7; j >= 0; --j) {
                const size_t r0 = (size_t)hgrn_row(b, dir, bc, tq * 64 + i8 * 8 + j) * CDN;
                const float f = lb + (1.f - lb) * sigm(bf2f(P[r0 + cf]));
                ko[j] = (1.f - f) * __expf(r); r += __logf(f);
            }
            pg8::u32x4 wv; wv.x = pack2(ko[0], ko[1]); wv.y = pack2(ko[2], ko[3]); wv.z = pack2(ko[4], ko[5]); wv.w = pack2(ko[6], ko[7]);
            *(pg8::u32x4*)(kT + d * 264 + tq * 64 + i8 * 8) = wv;
        }
        if (tq == 0) Dd[(size_t)it * 128 + d] = __expf(seg[d] + seg[128 + d] + seg[256 + d] + seg[384 + d]);
        lds_barrier();
        s16x8 af[8];
#pragma unroll
        for (int kq = 0; kq < 8; ++kq) af[kq] = *(const s16x8*)(vT + (16 * w + l15) * 264 + 32 * kq + 8 * lq);
        for (int ni = 0; ni < 8; ++ni) {
            f32x4 acc = {0.f, 0.f, 0.f, 0.f};
#pragma unroll
            for (int kq = 0; kq < 8; ++kq) { const s16x8 bb = *(const s16x8*)(kT + (16 * ni + l15) * 264 + 32 * kq + 8 * lq); acc = __builtin_amdgcn_mfma_f32_16x16x32_bf16(af[kq], bb, acc, 0, 0, 0); }
#pragma unroll
            for (int j = 0; j < 4; ++j) dS[(size_t)it * 16384 + (16 * w + 4 * lq + j) * 128 + 16 * ni + l15] = acc[j];
        }
    }
}
DEV void phase_h2(const Params& p) {
    float* dS = (float*)(p.ws + OFF_SCR + SCR_DS); const float* Dd = (const float*)(p.ws + OFF_SCR + SCR_DD);
    for (int idx = ((int)blockIdx.x + PZ()) * 512 + TID(); idx < 16 * 16384; idx += gridDim.x * 512) {
        const int chain = idx >> 14, de = idx & 16383, d = de & 127;
        float S = 0.f;
        for (int bc = 0; bc < NBC; ++bc) {
            const size_t it = (size_t)chain * NBC + bc;
            const float t = dS[it * 16384 + de];
            dS[it * 16384 + de] = S;
            S = Dd[it * 128 + d] * S + t;
        }
    }
}
DEV void phase_h3(const Params& p, int o, char* smem, bool skipctx) {
    const int tid = TID(), lane = tid & 63, w = tid >> 6, l15 = lane & 15, lq = lane >> 4;
    bf16_t* STb = (bf16_t*)smem; bf16_t* qin = STb + 128 * 136; bf16_t* kin = qin + 32 * 136; bf16_t* koT = kin + 32 * 136; bf16_t* vT = koT + 128 * 40; bf16_t* att = vT + 128 * 40;
    float* seg = (float*)(att + 32 * 40); float* cdv = seg + 512;
    const bf16_t* P = (const bf16_t*)(p.ws + OFF_P);
    const float* dS = (const float*)(p.ws + OFF_SCR + SCR_DS);
    bf16_t* ob = (bf16_t*)p.out;
    const float* lball = (const float*)(p.ws + OFF_LB) + (size_t)o * 512;
    const int d = tid & 127, tq = tid >> 7;
    const int nitems = skipctx ? 16 * (NBC - 1) : 16 * NBC;
    for (int it0 = blockIdx.x; it0 < nitems; it0 += gridDim.x) {
        const int chain = skipctx ? it0 / (NBC - 1) : it0 / NBC, bc = skipctx ? 1 + it0 % (NBC - 1) : it0 % NBC, it = chain * NBC + bc;
        const int dir = chain & 1, h = (chain >> 1) & 3, b = chain >> 3;
        const float lb = lball[h * 128 + d];
        f32x4 Sacc[8];
#pragma unroll
        for (int ni = 0; ni < 8; ++ni)
#pragma unroll
            for (int j = 0; j < 4; ++j) Sacc[ni][j] = dS[(size_t)it * 16384 + (16 * w + 4 * lq + j) * 128 + 16 * ni + l15];
        lds_barrier();
#pragma unroll
        for (int ni = 0; ni < 8; ++ni)
#pragma unroll
            for (int j = 0; j < 4; ++j) STb[(16 * w + 4 * lq + j) * 136 + 16 * ni + l15] = f2bf(Sacc[ni][j]);
        unsigned rf[8], rq[8], rv[8];
        auto fetch = [&](int sub) {
#pragma unroll
            for (int i = 0; i < 8; ++i) {
                const size_t rb = (size_t)hgrn_row(b, dir, bc, sub * 32 + tq * 8 + i) * CDN + 1024 + h * 128 + d;
                rf[i] = P[rb + 512 + dir * 512]; rq[i] = P[rb]; rv[i] = P[rb + 1536];
            }
        };
        fetch(0);
        for (int sub = 0; sub < 8; ++sub) {
            float f[8], c[8]; float run = 0.f;
#pragma unroll
            for (int i = 0; i < 8; ++i) { f[i] = lb + (1.f - lb) * sigm(__uint_as_float(rf[i] << 16)); run += __logf(f[i]); c[i] = run; }
            seg[tq * 128 + d] = run;
            { pg8::u32x4 wv; wv.x = rv[0] | (rv[1] << 16); wv.y = rv[2] | (rv[3] << 16); wv.z = rv[4] | (rv[5] << 16); wv.w = rv[6] | (rv[7] << 16); *(pg8::u32x4*)(vT + d * 40 + tq * 8) = wv; }
            lds_barrier();
            float pre = 0.f, tot = 0.f;
#pragma unroll
            for (int q = 0; q < 4; ++q) { const float sv = seg[q * 128 + d]; tot += sv; if (q < tq) pre += sv; }
            float ko[8];
#pragma unroll
            for (int i = 0; i < 8; ++i) {
                const float bcv = pre + c[i], eb = __expf(bcv), ieb = __expf(-bcv), k1 = 1.f - f[i];
                qin[(tq * 8 + i) * 136 + d] = f2bf(__uint_as_float(rq[i] << 16) * eb);
                kin[(tq * 8 + i) * 136 + d] = f2bf(k1 * ieb);
                ko[i] = k1 * __expf(tot - bcv);
            }
            { pg8::u32x4 wv; wv.x = pack2(ko[0], ko[1]); wv.y = pack2(ko[2], ko[3]); wv.z = pack2(ko[4], ko[5]); wv.w = pack2(ko[6], ko[7]); *(pg8::u32x4*)(koT + d * 40 + tq * 8) = wv; }
            if (tq == 0) cdv[d] = __expf(tot);
            fetch(sub + 1 < 8 ? sub + 1 : 7);
            lds_barrier();
            f32x4 oacc[2] = {{0.f, 0.f, 0.f, 0.f}, {0.f, 0.f, 0.f, 0.f}};
#pragma unroll
            for (int kq = 0; kq < 4; ++kq) {
                const s16x8 bb = *(const s16x8*)(STb + (16 * w + l15) * 136 + 32 * kq + 8 * lq);
#pragma unroll
                for (int mi = 0; mi < 2; ++mi) { const s16x8 a = *(const s16x8*)(qin + (16 * mi + l15) * 136 + 32 * kq + 8 * lq); oacc[mi] = __builtin_amdgcn_mfma_f32_16x16x32_bf16(a, bb, oacc[mi], 0, 0, 0); }
            }
            if (w < 4) {
                const int mi = w >> 1, nj = w & 1;
                f32x4 at = {0.f, 0.f, 0.f, 0.f};
                if (!(mi == 0 && nj == 1)) {
#pragma unroll
                    for (int kq = 0; kq < 4; ++kq) {
                        const s16x8 a = *(const s16x8*)(qin + (16 * mi + l15) * 136 + 32 * kq + 8 * lq), bb = *(const s16x8*)(kin + (16 * nj + l15) * 136 + 32 * kq + 8 * lq);
                        at = __builtin_amdgcn_mfma_f32_16x16x32_bf16(a, bb, at, 0, 0, 0);
                    }
                }
#pragma unroll
                for (int jj = 0; jj < 4; ++jj) { const int t = 16 * mi + 4 * lq + jj, j = 16 * nj + l15; att[t * 40 + j] = f2bf(j <= t ? at[jj] : 0.f); }
            }
            lds_barrier();
            const s16x8 vb = *(const s16x8*)(vT + (16 * w + l15) * 40 + 8 * lq);
#pragma unroll
            for (int mi = 0; mi < 2; ++mi) {
                const s16x8 a = *(const s16x8*)(att + (16 * mi + l15) * 40 + 8 * lq);
                oacc[mi] = __builtin_amdgcn_mfma_f32_16x16x32_bf16(a, vb, oacc[mi], 0, 0, 0);
#pragma unroll
                for (int jj = 0; jj < 4; ++jj)
                    ob[((size_t)dir * NTOK + hgrn_row(b, dir, bc, sub * 32 + 16 * mi + 4 * lq + jj)) * 512 + h * 128 + 16 * w + l15] = f2bf(oacc[mi][jj]);
            }
#pragma unroll
            for (int ni = 0; ni < 8; ++ni) {
                const float cd = cdv[16 * ni + l15];
#pragma unroll
                for (int j = 0; j < 4; ++j) Sacc[ni][j] *= cd;
                const s16x8 bb = *(const s16x8*)(koT + (16 * ni + l15) * 40 + 8 * lq);
                Sacc[ni] = __builtin_amdgcn_mfma_f32_16x16x32_bf16(vb, bb, Sacc[ni], 0, 0, 0);
#pragma unroll
                for (int j = 0; j < 4; ++j) STb[(16 * w + 4 * lq + j) * 136 + 16 * ni + l15] = f2bf(Sacc[ni][j]);
            }
            lds_barrier();
        }
    }
}

#define XB_TMO      128
#define XB_XCNT(j)  (256  + 64 * (j))
#define XB_XSUB(j)  (1280 + 64 * (j))
#define XB_XGEN(j)  (2304 + 64 * (j))
#define XB_TOP      3328
#define XB_TOPGEN   3392
#define XCD_BAR_WORDS 3456
#define XB_SPIN_CAP (1u << 18)
#define XLAS __attribute__((address_space(3)))
__device__ __forceinline__ unsigned xb_ld(unsigned* p)              { return __hip_atomic_load(p, __ATOMIC_RELAXED, __HIP_MEMORY_SCOPE_AGENT); }
__device__ __forceinline__ unsigned xb_add(unsigned* p, unsigned v) { return __hip_atomic_fetch_add(p, v, __ATOMIC_RELAXED, __HIP_MEMORY_SCOPE_AGENT); }
__device__ __forceinline__ unsigned xb_xcc_id() { return (unsigned)__builtin_amdgcn_s_getreg((3 << 11) | 20) & 0xFu; }
#define XB_SPIN(cond, bar) do { unsigned _sp = 0; while (cond) { __builtin_amdgcn_s_sleep(1); \
    if ((++_sp & 255u) == 0u) { if (xb_ld(&(bar)[XB_TMO])) break; if (_sp > XB_SPIN_CAP) { atomicAdd(&(bar)[XB_TMO], 1u); break; } } } } while (0)

struct XcdBarrier {
    unsigned* bar; unsigned x;
    volatile XLAS unsigned* st;
};

__device__ __forceinline__ XcdBarrier xcd_barrier_post(unsigned* bar, volatile XLAS unsigned* st) {
    XcdBarrier b; b.bar = bar; b.x = xb_xcc_id(); b.st = st;
    if (threadIdx.x == 0) (void)xb_add(&bar[XB_XCNT(b.x)], 1u);
    return b;
}
__device__ __forceinline__ void xcd_barrier_complete(unsigned* bar, unsigned x, unsigned& nloc, unsigned& nx) {
    const unsigned G = gridDim.x * gridDim.y * gridDim.z;
    unsigned sum, cnt, mine, sp = 0u;
    for (;;) {
        sum = 0u; cnt = 0u; mine = 0u;
#pragma unroll
        for (unsigned j = 0; j < 16; ++j) { const unsigned c = xb_ld(&bar[XB_XCNT(j)]); sum += c; cnt += (c > 0u) ? 1u : 0u; mine = (j == x) ? c : mine; }
        if (sum == G) break;
        __builtin_amdgcn_s_sleep(1);
        if ((++sp & 255u) == 0u) { if (xb_ld(&bar[XB_TMO])) break; if (sp > XB_SPIN_CAP) { atomicAdd(&bar[XB_TMO], 1u); break; } }
    }
    nloc = mine > 0u ? mine : 1u; nx = cnt > 0u ? cnt : 1u;
}

__device__ __forceinline__ void xcd_barrier(const XcdBarrier& b) {
    asm volatile("s_waitcnt vmcnt(0)" ::: "memory");
    __syncthreads();
    if (threadIdx.x == 0) {
        unsigned* bar = b.bar;
        __builtin_amdgcn_s_waitcnt(0);
        unsigned nloc = b.st[0], nx = b.st[1];
        if (nloc == 0u) { xcd_barrier_complete(bar, b.x, nloc, nx); b.st[0] = nloc; b.st[1] = nx; }
        const unsigned old = xb_add(&bar[XB_XSUB(b.x)], 1u);
        const unsigned gen = old / nloc;
        if (old + 1u == (gen + 1u) * nloc) {
            __builtin_amdgcn_fence(__ATOMIC_RELEASE, "agent");
            asm volatile("s_waitcnt vmcnt(0)" ::: "memory");
            const unsigned og = xb_add(&bar[XB_TOP], 1u);
            const unsigned tg = og / nx;
            if (og + 1u == (tg + 1u) * nx) xb_add(&bar[XB_TOPGEN], 1u);
            else XB_SPIN(xb_ld(&bar[XB_TOPGEN]) == tg, bar);
            __builtin_amdgcn_fence(__ATOMIC_ACQUIRE, "agent");
            xb_add(&bar[XB_XGEN(b.x)], 1u);
            asm volatile("s_waitcnt vmcnt(0)" ::: "memory");
        } else {
            XB_SPIN(xb_ld(&bar[XB_XGEN(b.x)]) == gen, bar);
            __builtin_amdgcn_fence(__ATOMIC_ACQUIRE, "agent");
            asm volatile("s_waitcnt vmcnt(0)" ::: "memory");
        }
    }
    __syncthreads();
}


__device__ __forceinline__ void sub_arrive_wait(unsigned* cnt, unsigned target, bool wait) {
    asm volatile("s_waitcnt vmcnt(0)" ::: "memory");
    __syncthreads();
    if (threadIdx.x == 0) {
        __builtin_amdgcn_fence(__ATOMIC_RELEASE, "agent");
        asm volatile("s_waitcnt vmcnt(0)" ::: "memory");
        (void)xb_add(cnt, 1u);
        if (wait) {
            unsigned sp = 0u;
            while (xb_ld(cnt) < target) { __builtin_amdgcn_s_sleep(2); if (++sp > (1u << 22)) break; }
            __builtin_amdgcn_fence(__ATOMIC_ACQUIRE, "agent");
            asm volatile("s_waitcnt vmcnt(0)" ::: "memory");
        }
    }
    __syncthreads();
}

constexpr int LDS_BYTES = 155648;

template <class Epi> DEV void run_gemm(char* smem, const bf16_t* A, const bf16_t* Bt, int N, int K, const Epi& E, int M = NTOK) {
    pg8::Gemm g{A, Bt, M, N, K};
    pg8::StaticOrder S; S.init(M, N, (int)gridDim.x, (int)blockIdx.x);
    pg8::gemm_phase<Epi, pg8::StaticOrder, false>((PG8_LAS unsigned char*)smem, g, S, E, nullptr);
}


DEV void ctx_res_gemm(const Params& p, const bf16_t* A, const bf16_t* Wt, int K, const float* gate, float scale) {
    const int tid = TID(), lane = tid & 63, w = tid >> 6, l15 = lane & 15, lq = lane >> 4;
    const int rt = blockIdx.x >> 4, ct = blockIdx.x & 15;
    const int row0 = NLAT + rt * 32 + (w >> 2) * 16, col0 = ct * 64 + (w & 3) * 16;
    const bf16_t* ap = A + (size_t)(row0 + l15) * K + 8 * lq;
    const bf16_t* bp = Wt + (size_t)(col0 + l15) * K + 8 * lq;
    f32x4 acc0 = {0.f, 0.f, 0.f, 0.f}, acc1 = {0.f, 0.f, 0.f, 0.f};
    for (int k0 = 0; k0 < K; k0 += 256) {
        s16x8 a[8], bq[8];
#pragma unroll
        for (int q = 0; q < 8; ++q) { a[q] = *(const s16x8*)(ap + k0 + 32 * q); bq[q] = *(const s16x8*)(bp + k0 + 32 * q); }
#pragma unroll
        for (int q = 0; q < 8; q += 2) {
            acc0 = __builtin_amdgcn_mfma_f32_16x16x32_bf16(a[q], bq[q], acc0, 0, 0, 0);
            acc1 = __builtin_amdgcn_mfma_f32_16x16x32_bf16(a[q + 1], bq[q + 1], acc1, 0, 0, 0);
        }
    }
    float* H = (float*)(p.ws + OFF_H);
    const float gv = gate[(size_t)2 * MODW + col0 + l15] * scale;
#pragma unroll
    for (int j = 0; j < 4; ++j) { float* q = H + (size_t)(row0 + 4 * lq + j) * D + col0 + l15; *q = *q + gv * (acc0[j] + acc1[j]); }
}


DEV void run_step(const Params& p, int st, char* smem) {
    const int type = st & 255, l = (st >> 8) & 255, f = st >> 16, eo = l >> 1;
    char* ws = p.ws;
    const float* mod = (const float*)(ws + OFF_MOD) + (size_t)l * 3 * MODW;
#ifdef ONLY
    if (type != ONLY) return;
#endif
    switch (type) {
    case PH_INIT: phase_init(p, smem); break;
    case PH_NORM: phase_norm(p, l, f); break;
    case PH_UP: { EpiUp E{(bf16_t*)(ws + OFF_P)}; run_gemm(smem, (const bf16_t*)(ws + OFF_HN), (const bf16_t*)(ws + OFF_WUP + (size_t)(l * 2 + f) * SZ_WUP), 2 * FFN, D, E, (l == 3 && f == 1) ? NLAT : NTOK); } break;
    case PH_DOWN: { EpiRes E{(float*)(ws + OFF_H), mod + ((f ? 2 : 0) * 3 + 2) * D, 0.5f}; run_gemm(smem, (const bf16_t*)(ws + OFF_P), (const bf16_t*)(ws + OFF_WDN + (size_t)(l * 2 + f) * SZ_WDN), D, FFN, E, ((l == 3 && f == 1) || gridDim.x == 256) ? NLAT : NTOK);
        if (gridDim.x == 256 && !(l == 3 && f == 1)) ctx_res_gemm(p, (const bf16_t*)(ws + OFF_P), (const bf16_t*)(ws + OFF_WDN + (size_t)(l * 2 + f) * SZ_WDN), FFN, mod + ((f ? 2 : 0) * 3 + 2) * D, 0.5f);
        if (f == 1 && l < 3 && gridDim.x < 256) { __syncthreads(); convert_layer(p, l + 1, (float*)smem, (int)blockIdx.x, (int)gridDim.x); }
    } break;
    case PH_ABIN: { EpiP E{(bf16_t*)(ws + OFF_P), ABN}; run_gemm(smem, (const bf16_t*)(ws + OFF_HN), (const bf16_t*)(ws + OFF_WABIN + (size_t)eo * ABN * D * 2), ABN, D, E); } break;
    case PH_CDIN: { EpiPG E{(bf16_t*)(ws + OFF_P), CDN}; run_gemm(smem, (const bf16_t*)(ws + OFF_HN), (const bf16_t*)(ws + OFF_WCDIN + (size_t)eo * CDN * D * 2), CDN, D, E); } break;
    case PH_OUT: { EpiRes E{(float*)(ws + OFF_H), mod + (1 * 3 + 2) * D, 1.0f};
        const bf16_t* W = (const bf16_t*)(ws + ((l & 1) ? OFF_WCDOUT : OFF_WABOUT) + (size_t)eo * D * D * 2);
        run_gemm(smem, (const bf16_t*)(ws + OFF_HN), W, D, D, E, (l == 3 || gridDim.x == 256) ? NLAT : NTOK);
        if (gridDim.x == 256 && l != 3) ctx_res_gemm(p, (const bf16_t*)(ws + OFF_HN), W, D, mod + (1 * 3 + 2) * D, 1.0f); } break;
    case PH_S2: phase_s2(p, eo, (int)blockIdx.x); break;
    case PH_S3: phase_s3(p, eo, smem); break;
    case PH_GLU: { EpiGlu E{(const bf16_t*)(ws + OFF_SCR + SCR_YB), p.in[PZ() + I_GLUB] + (size_t)eo * 512, (bf16_t*)(ws + OFF_HN)};
        run_gemm(smem, (const bf16_t*)(ws + OFF_SCR + SCR_YB), (const bf16_t*)(ws + OFF_WGLU + (size_t)eo * 512 * 512 * 2), 512, 512, E); }
        [[fallthrough]];
    case PH_G3: phase_combine(p, (const bf16_t*)(ws + OFF_P), ABN, 1536, p.in[PZ() + I_GNG] + (size_t)eo * 128, 0, (int)blockIdx.x, (int)gridDim.x); break;
    case PH_G1: phase_g1(p, eo, smem); break;
    case PH_G2:
        if (gridDim.x >= 256) {
            if (blockIdx.x < 128) phase_g2(p, eo, smem);
            else {
                phase_s1(p, eo, smem, (int)blockIdx.x - 128, (int)gridDim.x - 128);
                const bool scan = blockIdx.x - 128 < 16;
                sub_arrive_wait((unsigned*)(ws + OFF_BAR) + 3520 + 64 * eo, gridDim.x - 128, scan);
                if (scan) phase_s2(p, eo, (int)blockIdx.x - 128);
                else {
                    __syncthreads();
                    convert_layer(p, l + 1, (float*)smem, (int)blockIdx.x - 144, (int)gridDim.x - 144);
                    if (l == 0) { __syncthreads(); convert_layer(p, 2, (float*)smem, (int)blockIdx.x - 144, (int)gridDim.x - 144); }
                }
            }
        }
        else { phase_g2(p, eo, smem); phase_s1(p, eo, smem, (int)blockIdx.x, (int)gridDim.x); }
        break;
    case PH_CH1: phase_conformer(p, eo, smem); phase_h1(p, eo, smem, 1040); break;
    case PH_H2: phase_h2(p); break;
    case PH_H3: phase_h3(p, eo, smem, l == 3); break;
    case PH_H4: phase_combine(p, (const bf16_t*)(ws + OFF_P), CDN, 1024 + 2048, p.in[PZ() + I_HNG] + (size_t)eo * 128, 512, (int)blockIdx.x, (int)gridDim.x); break;
    case PH_FINAL: phase_final(p); break;
    default: break;
    }
}

#ifndef MK_MULTI
__global__ __launch_bounds__(512, 2) void mega_kernel(Params p) {
    extern __shared__ __attribute__((aligned(16))) char smem[];
    cg::grid_group grid = cg::this_grid();
    volatile XLAS unsigned* st = (volatile XLAS unsigned*)(smem + LDS_BYTES - 16);
    if (threadIdx.x < 2) st[threadIdx.x] = 0u;
    __syncthreads();
    const XcdBarrier xb = xcd_barrier_post((unsigned*)(p.ws + OFF_BAR), st);
    for (int si = 0; si < p.nsteps; ++si) {
        run_step(p, p.steps[si], smem);
        if (si + 1 < p.nsteps) { if (p.nsteps < 0) grid.sync(); else xcd_barrier(xb); }
    }
}
#else
__global__ __launch_bounds__(512, 2) void step_kernel(Params p, int si) {
    extern __shared__ __attribute__((aligned(16))) char smem[];
    run_step(p, p.steps[si], smem);
}
#endif

extern "C" void kernel_launch(void* const* d_in, const int* in_sizes, int n_in, void* d_out, int out_size, void* d_ws, size_t ws_size, hipStream_t stream) {
    (void)in_sizes; (void)out_size;
    if (n_in < 34 || ws_size < WS_NEED) { fprintf(stderr, "kernel_launch: unexpected inputs (n_in %d, ws %zu < %zu)\n", n_in, ws_size, (size_t)WS_NEED); return; }
    Params p; memset(&p, 0, sizeof(p));
    for (int i = 0; i < 34; ++i) p.in[i] = (const float*)d_in[i];
    p.out = (float*)d_out; p.ws = (char*)d_ws;
#ifndef MK_MULTI
    static int grid_blocks = 0;
    if (!grid_blocks) {
        int dev = 0, cus = 0, per_cu = 0;
        (void)hipGetDevice(&dev);
        (void)hipDeviceGetAttribute(&cus, hipDeviceAttributeMultiprocessorCount, dev);
        (void)hipFuncSetAttribute((const void*)mega_kernel, hipFuncAttributeMaxDynamicSharedMemorySize, LDS_BYTES);
        (void)hipOccupancyMaxActiveBlocksPerMultiprocessor(&per_cu, mega_kernel, 512, LDS_BYTES);
        if (per_cu < 1) per_cu = 1;
        grid_blocks = cus * per_cu;
    }
    int n = 0;
#ifndef DUPMASK
#define DUPMASK 0u
#endif
    auto add = [&](int type, int l, int f) { p.steps[n++] = type | (l << 8) | (f << 16); if ((DUPMASK >> type) & 1u) p.steps[n++] = type | (l << 8) | (f << 16); };
    add(PH_INIT, 0, 0);
    for (int l = 0; l < 4; ++l) {
        add(PH_NORM, l, 0); add(PH_UP, l, 0); add(PH_DOWN, l, 0); add(PH_NORM, l, 1);
        if ((l & 1) == 0) { add(PH_ABIN, l, 0); add(PH_G1, l, 0); add(PH_G2, l, 0); if (grid_blocks < 256) add(PH_S2, l, 0); add(PH_S3, l, 0); add(PH_GLU, l, 0); }
        else { add(PH_CDIN, l, 0); add(PH_CH1, l, 0); add(PH_H2, l, 0); add(PH_H3, l, 0); add(PH_H4, l, 0); }
        add(PH_OUT, l, 0); add(PH_NORM, l, 2); add(PH_UP, l, 1); add(PH_DOWN, l, 1);
    }
    add(PH_FINAL, 0, 0);
    p.nsteps = n;
    (void)hipMemsetAsync((char*)d_ws + OFF_BAR, 0, 16384, stream);
    void* args[] = {&p};
    hipError_t e = hipLaunchCooperativeKernel((const void*)mega_kernel, dim3(grid_blocks), dim3(512), args, LDS_BYTES, stream);
    if (e != hipSuccess) fprintf(stderr, "cooperative launch failed: %s (grid %d)\n", hipGetErrorString(e), grid_blocks);
#else
    const int grid_blocks = 0;
    int n = 0;
#ifndef DUPMASK
#define DUPMASK 0u
#endif
    auto add = [&](int type, int l, int f) { p.steps[n++] = type | (l << 8) | (f << 16); if ((DUPMASK >> type) & 1u) p.steps[n++] = type | (l << 8) | (f << 16); };
    add(PH_INIT, 0, 0);
    for (int l = 0; l < 4; ++l) {
        add(PH_NORM, l, 0); add(PH_UP, l, 0); add(PH_DOWN, l, 0); add(PH_NORM, l, 1);
        if ((l & 1) == 0) { add(PH_ABIN, l, 0); add(PH_G1, l, 0); add(PH_G2, l, 0); if (grid_blocks < 256) add(PH_S2, l, 0); add(PH_S3, l, 0); add(PH_GLU, l, 0); }
        else { add(PH_CDIN, l, 0); add(PH_CH1, l, 0); add(PH_H2, l, 0); add(PH_H3, l, 0); add(PH_H4, l, 0); }
        add(PH_OUT, l, 0); add(PH_NORM, l, 2); add(PH_UP, l, 1); add(PH_DOWN, l, 1);
    }
    add(PH_FINAL, 0, 0);
    p.nsteps = n;
    static int inited = 0;
    if (!inited) { (void)hipFuncSetAttribute((const void*)step_kernel, hipFuncAttributeMaxDynamicSharedMemorySize, LDS_BYTES); inited = 1; }
    for (int si = 0; si < n; ++si) step_kernel<<<256, 512, LDS_BYTES, stream>>>(p, si);
#endif
}
```

```cpp
#include <hip/hip_runtime.h>
#include <hip/hip_cooperative_groups.h>
#include <cstdio>
#include <cstring>
namespace cg = cooperative_groups;

#define DEV __device__ __forceinline__
typedef unsigned short bf16_t;

constexpr int D = 1024, SEQ = 16384, CTXL = 256, NB = 2;
constexpr int NLAT = NB * SEQ;
constexpr int NTOK = NLAT + NB * CTXL;
constexpr int FFN = 2816;
constexpr int ABN = 2816;
constexpr int ABIN = 2576;
constexpr int CDN = 3584;
constexpr int MODW = 9216;
constexpr int NCH = 260;
constexpr int NBC = 65;

constexpr size_t SZ_WUP = (size_t)2 * FFN * D * 2, SZ_WDN = (size_t)D * FFN * 2;
constexpr size_t OFF_WUP = 0;
constexpr size_t OFF_WDN = OFF_WUP + 8 * SZ_WUP;
constexpr size_t OFF_WABIN = OFF_WDN + 8 * SZ_WDN;
constexpr size_t OFF_WCDIN = OFF_WABIN + (size_t)2 * ABN * D * 2;
constexpr size_t OFF_WABOUT = OFF_WCDIN + (size_t)2 * CDN * D * 2;
constexpr size_t OFF_WCDOUT = OFF_WABOUT + (size_t)2 * D * D * 2;
constexpr size_t OFF_WGLU = OFF_WCDOUT + (size_t)2 * D * D * 2;
constexpr size_t OFF_MOD = OFF_WGLU + (size_t)2 * 512 * 512 * 2;
constexpr size_t OFF_LB = OFF_MOD + (size_t)4 * 3 * MODW * 4;
constexpr size_t OFF_DISC = OFF_LB + 8192;
constexpr size_t OFF_H = OFF_DISC + (size_t)8192 * 8 * 4;
constexpr size_t OFF_HN = OFF_H + (size_t)NTOK * D * 4;
constexpr size_t OFF_P = OFF_HN + (size_t)NTOK * D * 2;
constexpr size_t SZ_PAB = (size_t)NTOK * ABN * 2;
constexpr size_t OFF_QN = OFF_P + SZ_PAB;
constexpr size_t OFF_KN = OFF_QN + (size_t)NTOK * 512 * 2;
constexpr size_t SZ_PREG = SZ_PAB + (size_t)2 * NTOK * 512 * 2;
constexpr size_t OFF_SCR = OFF_P + SZ_PREG;
constexpr size_t SCR_T = 0, SCR_QK = (size_t)4160 * 4096 * 2, SCR_GB = 2 * SCR_QK;
constexpr size_t SCR_YB = 0, SCR_CARRY = (size_t)NTOK * 512 * 2;
constexpr size_t SCR_DS = 0, SCR_DD = (size_t)1040 * 16384 * 4;
constexpr size_t SZ_SCR = (size_t)72 * 1024 * 1024;
constexpr size_t OFF_BAR = OFF_SCR + SZ_SCR;
constexpr size_t WS_NEED = OFF_BAR + 16384;
static_assert((size_t)2 * NTOK * 512 * 2 <= (size_t)NLAT * D * 4, "o scratch must fit in d_out");
constexpr size_t OUT_KNT = (size_t)2 * NTOK * 512 * 2;
constexpr size_t OUT_CARRY = OUT_KNT + (size_t)2080 * 8192 * 2;
static_assert(OUT_CARRY + (size_t)128 * 260 * 128 * 4 <= (size_t)NLAT * D * 4, "d_out scratch");
static_assert(SCR_GB + (size_t)4160 * 128 * 4 <= SZ_SCR, "scr");
static_assert(SCR_CARRY + (size_t)128 * 260 * 128 * 4 <= SZ_SCR, "scr");
static_assert(SCR_DD + (size_t)1040 * 128 * 4 <= SZ_SCR, "scr");
static_assert(WS_NEED <= (size_t)737 * 1000 * 1000, "ws");

typedef short s16x8 __attribute__((ext_vector_type(8)));
struct Params { const float* in[34]; float* out; char* ws; int nsteps; int steps[127]; };
enum { I_X = 0, I_C, I_CTX, I_CCTX, I_ADAW, I_ADAB, I_NORMG, I_WUP, I_WDN, I_ABIN, I_ABOUT, I_GCONV, I_GALOG, I_GDT, I_GNG,
       I_LRE, I_LIM, I_LSTEP, I_BRE, I_BIM, I_CRE, I_CIM, I_S5D, I_GLUW, I_GLUB, I_CDIN, I_CDOUT, I_DWW, I_DWB, I_LNG, I_LNB, I_LB, I_HNG, I_FNG };
enum { PH_INIT = 0, PH_NORM, PH_UP, PH_DOWN, PH_ABIN, PH_CDIN, PH_OUT, PH_S1, PH_S2, PH_S3, PH_GLU, PH_G1, PH_G2, PH_G3, PH_CH1, PH_H2, PH_H3, PH_H4, PH_FINAL };

DEV int TID() { int t = threadIdx.x; asm volatile("" : "+v"(t)); return t; }
DEV int PZ() { int z = 0; asm volatile("" : "+s"(z)); return z; }
DEV float bf2f(bf16_t b) { return __uint_as_float(((unsigned)b) << 16); }
typedef float f32x2_ __attribute__((ext_vector_type(2)));
typedef __bf16 bf16x2_ __attribute__((ext_vector_type(2)));
DEV unsigned pack2(float lo, float hi) { const f32x2_ v = {lo, hi}; return __builtin_bit_cast(unsigned, __builtin_convertvector(v, bf16x2_)); }
DEV bf16_t f2bf(float f) { return __builtin_bit_cast(unsigned short, (__bf16)f); }
DEV float sigm(float x) { return __builtin_amdgcn_rcpf(1.f + __expf(-x)); }
DEV float silu(float x) { return x * __builtin_amdgcn_rcpf(1.f + __expf(-x)); }
template <int CTRL> DEV float dpp_f(float v) { return __int_as_float(__builtin_amdgcn_update_dpp(0, __float_as_int(v), CTRL, 0xf, 0xf, true)); }
DEV float sum4(float v) { v += dpp_f<0xB1>(v); v += dpp_f<0x4E>(v); return v; }
DEV float sum8(float v) { v = sum4(v); v += dpp_f<0x141>(v); return v; }
DEV float sum16(float v) { v = sum8(v); v += dpp_f<0x140>(v); return v; }
DEV float wave_sum(float v) {
    v = sum16(v);
    return (__int_as_float(__builtin_amdgcn_readlane(__float_as_int(v), 0)) + __int_as_float(__builtin_amdgcn_readlane(__float_as_int(v), 16))) +
           (__int_as_float(__builtin_amdgcn_readlane(__float_as_int(v), 32)) + __int_as_float(__builtin_amdgcn_readlane(__float_as_int(v), 48)));
}
DEV void lds_barrier() { asm volatile("s_waitcnt lgkmcnt(0)" ::: "memory"); __builtin_amdgcn_s_barrier(); asm volatile("" ::: "memory"); }
DEV int mod_row(int row) { return row < NLAT ? (row >> 14) : 2; }

namespace pg8 {
#define PG8_LAS __attribute__((address_space(3)))
typedef unsigned short bf16_t;
typedef short bf16x8 __attribute__((ext_vector_type(8)));
typedef float f32x4 __attribute__((ext_vector_type(4)));
typedef unsigned u32x4 __attribute__((ext_vector_type(4)));
constexpr int BM = 256, BK = 64, HALF = 128, HTB = HALF * BK * 2  , STAGE_BYTES = 8 * HTB, NXCD = 8, WGM = 4;

__host__ __device__ __forceinline__ int lds_byte(int r, int c) { const int st = (r >> 4) * 2 + (c >> 5), rr = r & 15, cc = c & 31, ob = rr * 64 + cc * 2; return st * 1024 + (ob ^ (((ob >> 9) & 1) << 5)); }
__host__ __device__ __forceinline__ void stage_rc(int b, int& R, int& C) { const int st = b / 1024, sb = b % 1024, swz = sb ^ (((sb >> 9) & 1) << 5); R = (st >> 1) * 16 + swz / 64; C = (st & 1) * 32 + (swz % 64) / 2; }
__host__ __device__ __forceinline__ int perm32(int rho) { const int n = rho >> 4, i = rho & 15; return 8 * (i >> 2) + 4 * n + (i & 3); }

struct Unit { int pm, pn; };
struct Gemm { const bf16_t* A; const bf16_t* Bt; int M, N, K; };
struct StaticOrder {
    int nM, nN, nwg, G, c;
    __host__ __device__ void init(int M, int N, int G_, int c_) { nM = M / BM; nN = N / BM; nwg = nM * nN; G = G_; c = c_; }
    __host__ __device__ bool next(int i, Unit& u) const {
        const long L = (long)i * G + c; if (L >= nwg) return false;
        int wgid = (int)L; { const int q = nwg / NXCD, r = nwg % NXCD, xcd = wgid % NXCD, off = wgid / NXCD; wgid = (xcd < r ? xcd * (q + 1) : r * (q + 1) + (xcd - r) * q) + off; }
        const int nig = WGM * nN, gid = wgid / nig, fm = gid * WGM, gsz = (nM - fm) < WGM ? (nM - fm) : WGM;
        u.pm = fm + ((wgid % nig) % gsz); u.pn = (wgid % nig) / gsz; return true;
    }
    __device__ __forceinline__ void a_ready(const Unit&) const {}
    __device__ __forceinline__ void done(const Unit&) const {}
};
__device__ __forceinline__ unsigned cvt_pk_bf16(float lo, float hi) { unsigned r; asm volatile("v_cvt_pk_bf16_f32 %0, %1, %2" : "=v"(r) : "v"(lo), "v"(hi)); return r; }
template <class Epi, class Sched, bool STAMP = false>
__device__ __forceinline__ void gemm_phase(PG8_LAS unsigned char* lds, const Gemm g, const Sched& S, const Epi& E, unsigned long long* stamps) {
    const int tid = TID(), wid = __builtin_amdgcn_readfirstlane(tid >> 6), lane = tid & 63, wr = wid >> 2, wc = wid & 3, fr = lane & 15, fq = lane >> 4;
    const int K = g.K, nt = K / BK;
    int ts_lo = 0, ts_hi = 0, nts = 0; const unsigned long long rt_entry = STAMP ? (unsigned long long)wall_clock64() : 0ull;
#define PG8_STAMP() do { if (STAMP && wid == 0 && nts < 64) { const unsigned long long _c = (unsigned long long)clock64(); \
        ts_lo = (lane == nts) ? (int)(unsigned)_c : ts_lo; ts_hi = (lane == nts) ? (int)(unsigned)(_c >> 32) : ts_hi; ++nts; } } while (0)
    PG8_STAMP();
    unsigned voffA[2], voffB[2];
#pragma unroll
    for (int i = 0; i < 2; ++i) { int R, C; stage_rc(tid * 16 + i * 8192, R, C); const int Rb = Epi::PERM ? ((R & ~31) + perm32(R & 31)) : R;
        voffA[i] = (unsigned)(R * K + C) * 2u; voffB[i] = (unsigned)(Rb * K + C) * 2u; }
    const size_t kstep = (size_t)(BK * 2);
    const size_t hstep = (size_t)HALF * K * 2;
    const size_t tstep = 2 * hstep;
    const unsigned ldsw = (unsigned)wid * 1024u;
    const int aoff = lds_byte(wr * 64 + fr, fq * 8), boff = lds_byte(wc * 32 + fr, fq * 8);
#define PG8_SA(b, h) (((b) * 2 + (h)) * HTB)
#define PG8_SB(b, h) ((4 + (b) * 2 + (h)) * HTB)
#define PG8_STAGE(bufoff, gbase, voff) do { _Pragma("unroll") for (int _i = 0; _i < 2; ++_i) \
        __builtin_amdgcn_global_load_lds((const unsigned*)((const char*)(gbase) + (voff)[_i]), (PG8_LAS unsigned*)(lds + (bufoff) + ldsw + _i * 8192), 16, 0, 0); } while (0)
#define PG8_LDA(dst, b, h) do { _Pragma("unroll") for (int m = 0; m < 4; ++m) _Pragma("unroll") for (int k = 0; k < 2; ++k) dst[m][k] = *(const PG8_LAS bf16x8*)(lds + PG8_SA(b, h) + aoff + m * 2048 + k * 1024); } while (0)
#define PG8_LDB(dst, b, h) do { _Pragma("unroll") for (int n = 0; n < 2; ++n) _Pragma("unroll") for (int k = 0; k < 2; ++k) dst[n][k] = *(const PG8_LAS bf16x8*)(lds + PG8_SB(b, h) + boff + n * 2048 + k * 1024); } while (0)
#define PG8_MMA(ai, bj, At, Bt) do { __builtin_amdgcn_s_setprio(1); _Pragma("unroll") for (int m = 0; m < 4; ++m) _Pragma("unroll") for (int n = 0; n < 2; ++n) _Pragma("unroll") for (int k = 0; k < 2; ++k) \
        acc[ai][bj][m][n] = __builtin_amdgcn_mfma_f32_16x16x32_bf16(Bt[n][k], At[m][k], acc[ai][bj][m][n], 0, 0, 0); __builtin_amdgcn_s_setprio(0); } while (0)
#define PG8_WAIT_V(n) asm volatile("s_waitcnt vmcnt(" #n ")" ::: "memory")
#define PG8_WAIT_L(n) asm volatile("s_waitcnt lgkmcnt(" #n ")" ::: "memory")
#define PG8_BAR __builtin_amdgcn_s_barrier()
#define PG8_SCHED __builtin_amdgcn_sched_barrier(0)
    Unit cur, nxt; int ui = 0;
    if (!S.next(0, cur)) return;
    f32x4 acc[2][2][4][2];
#pragma unroll
    for (int a = 0; a < 2; ++a)
#pragma unroll
        for (int b = 0; b < 2; ++b)
#pragma unroll
            for (int m = 0; m < 4; ++m)
#pragma unroll
                for (int n = 0; n < 2; ++n) acc[a][b][m][n] = (f32x4){0.f, 0.f, 0.f, 0.f};
    bf16x8 At[4][2], B0[2][2], B1[2][2];
    const char* cA = (const char*)g.A + (size_t)cur.pm * tstep; const char* cB = (const char*)g.Bt + (size_t)cur.pn * tstep;
    S.a_ready(cur);
    PG8_STAGE(PG8_SB(0, 0), cB, voffB); PG8_STAGE(PG8_SA(0, 0), cA, voffA); PG8_STAGE(PG8_SB(0, 1), cB + hstep, voffB); PG8_STAGE(PG8_SA(0, 1), cA + hstep, voffA);
    if (wr == 1) PG8_BAR;
    PG8_WAIT_V(4); PG8_BAR;
    PG8_STAGE(PG8_SB(1, 0), cB + kstep, voffB); PG8_STAGE(PG8_SA(1, 0), cA + kstep, voffA); PG8_STAGE(PG8_SB(1, 1), cB + hstep + kstep, voffB);
    PG8_WAIT_V(6); PG8_BAR;
    PG8_STAMP();
    for (;;) {
        const bool has_next = S.next(ui + 1, nxt);
        const char* nA = has_next ? (const char*)g.A + (size_t)nxt.pm * tstep : cA; const char* nB = has_next ? (const char*)g.Bt + (size_t)nxt.pn * tstep : cB;
        for (int t = 0; t < nt; t += 2) {
            const bool last = (t == nt - 2);
            const char* a1 = cA + (size_t)(t + 1) * kstep;
            const char* a2 = last ? nA : cA + (size_t)(t + 2) * kstep; const char* b2 = last ? nB : cB + (size_t)(t + 2) * kstep;
            const char* a3 = a2 + kstep; const char* b3 = b2 + kstep;
            if (last && has_next) S.a_ready(nxt);
            PG8_LDB(B0, 0, 0); PG8_SCHED; PG8_LDA(At, 0, 0); PG8_STAGE(PG8_SA(1, 1), a1 + hstep, voffA);
            PG8_WAIT_L(8); PG8_BAR; PG8_WAIT_L(0); PG8_MMA(0, 0, At, B0); PG8_BAR; PG8_SCHED;
            PG8_LDB(B1, 0, 1); PG8_STAGE(PG8_SB(0, 0), b2, voffB);
            PG8_BAR; PG8_WAIT_L(0); PG8_MMA(0, 1, At, B1); PG8_BAR;
            PG8_LDA(At, 0, 1); PG8_STAGE(PG8_SA(0, 0), a2, voffA);
            PG8_BAR; PG8_WAIT_L(0); PG8_MMA(1, 0, At, B0); PG8_BAR; PG8_SCHED;
            PG8_STAGE(PG8_SB(0, 1), b2 + hstep, voffB);
            PG8_WAIT_V(6); PG8_BAR; PG8_MMA(1, 1, At, B1); PG8_BAR;
            PG8_LDB(B0, 1, 0); PG8_SCHED; PG8_LDA(At, 1, 0); PG8_STAGE(PG8_SA(0, 1), a2 + hstep, voffA);
            PG8_WAIT_L(8); PG8_BAR; PG8_WAIT_L(0); PG8_MMA(0, 0, At, B0); PG8_BAR; PG8_SCHED;
            PG8_LDB(B1, 1, 1); PG8_STAGE(PG8_SB(1, 0), b3, voffB);
            PG8_BAR; PG8_WAIT_L(0); PG8_MMA(0, 1, At, B1); PG8_BAR;
            PG8_LDA(At, 1, 1); PG8_STAGE(PG8_SA(1, 0), a3, voffA);
            PG8_BAR; PG8_WAIT_L(0); PG8_MMA(1, 0, At, B0); PG8_BAR; PG8_SCHED;
            PG8_STAGE(PG8_SB(1, 1), b3 + hstep, voffB);
            PG8_WAIT_V(6); PG8_BAR; PG8_MMA(1, 1, At, B1); PG8_BAR;
        }
        PG8_STAMP();
        if constexpr (!Epi::AFTER_DRAIN) { E(acc, cur, wr, wc, fr, fq);
#ifdef EPIDUP
            if constexpr (Epi::PERM) { asm volatile("" ::: "memory"); E(acc, cur, wr, wc, fr, fq); }
#endif
            S.done(cur); }
        PG8_STAMP();
        if (!has_next) break;
#pragma unroll
        for (int a = 0; a < 2; ++a)
#pragma unroll
            for (int b = 0; b < 2; ++b)
#pragma unroll
                for (int m = 0; m < 4; ++m)
#pragma unroll
                    for (int n = 0; n < 2; ++n) acc[a][b][m][n] = (f32x4){0.f, 0.f, 0.f, 0.f};
        cur = nxt; cA = nA; cB = nB; ++ui;
    }
    PG8_WAIT_V(0);
    if (wr == 0) PG8_BAR;
    PG8_BAR;
    if constexpr (Epi::AFTER_DRAIN) { E.fused(acc, cur, wr, wc, fr, fq, lds, wid, lane); S.done(cur); }
    PG8_STAMP();
    if (STAMP && wid == 0) { stamps[lane] = lane < nts ? (((unsigned long long)(unsigned)ts_hi << 32) | (unsigned)ts_lo) : 0ull;
        if (lane == 62) stamps[62] = rt_entry; if (lane == 63) stamps[63] = (unsigned long long)wall_clock64(); }
#undef PG8_STAMP
#undef PG8_SA
#undef PG8_SB
#undef PG8_STAGE
#undef PG8_LDA
#undef PG8_LDB
#undef PG8_MMA
#undef PG8_WAIT_V
#undef PG8_WAIT_L
#undef PG8_BAR
#undef PG8_SCHED
}
}

using pg8::f32x4; using pg8::u32x4; using pg8::Unit; using pg8::cvt_pk_bf16;
typedef unsigned u32x2 __attribute__((ext_vector_type(2)));

struct EpiUp {
    static constexpr bool PERM = true, AFTER_DRAIN = false;
    bf16_t* O;
    DEV void operator()(const f32x4 (&acc)[2][2][4][2], const Unit& u, int wr, int wc, int fr, int fq) const {
        const int row0 = u.pm * 256 + wr * 64 + fr, ocol = u.pn * 128 + wc * 32 + 8 * fq;
#pragma unroll
        for (int ai = 0; ai < 2; ++ai)
#pragma unroll
            for (int m = 0; m < 4; ++m) {
                const f32x4 g0 = acc[ai][0][m][0], g1 = acc[ai][0][m][1], v0 = acc[ai][1][m][0], v1 = acc[ai][1][m][1];
                u32x4 w;
                w.x = cvt_pk_bf16(silu(g0[0]) * v0[0], silu(g0[1]) * v0[1]); w.y = cvt_pk_bf16(silu(g0[2]) * v0[2], silu(g0[3]) * v0[3]);
                w.z = cvt_pk_bf16(silu(g1[0]) * v1[0], silu(g1[1]) * v1[1]); w.w = cvt_pk_bf16(silu(g1[2]) * v1[2], silu(g1[3]) * v1[3]);
                *(u32x4*)(O + (size_t)(row0 + ai * 128 + m * 16) * FFN + ocol) = w;
            }
    }
};
struct EpiRes {
    static constexpr bool PERM = false, AFTER_DRAIN = false;
    float* H; const float* gate; float scale;
    DEV void operator()(const f32x4 (&acc)[2][2][4][2], const Unit& u, int wr, int wc, int fr, int fq) const {
        const int row0 = u.pm * 256 + wr * 64 + fr, col0 = u.pn * 256 + wc * 32 + 4 * fq;
        const int r = u.pm < 64 ? 0 : (u.pm < 128 ? 1 : 2);
        f32x4 gv[2][2];
#pragma unroll
        for (int bj = 0; bj < 2; ++bj)
#pragma unroll
            for (int n = 0; n < 2; ++n) gv[bj][n] = *(const f32x4*)(gate + (size_t)r * MODW + col0 + bj * 128 + n * 16) * scale;
#pragma unroll
        for (int ai = 0; ai < 2; ++ai)
#pragma unroll
            for (int m = 0; m < 4; ++m) {
                float* rowp = H + (size_t)(row0 + ai * 128 + m * 16) * D + col0;
#pragma unroll
                for (int bj = 0; bj < 2; ++bj)
#pragma unroll
                    for (int n = 0; n < 2; ++n) { f32x4* q = (f32x4*)(rowp + bj * 128 + n * 16); *q = *q + gv[bj][n] * acc[ai][bj][m][n]; }
            }
    }
};
struct EpiP {
    static constexpr bool PERM = true, AFTER_DRAIN = false;
    bf16_t* O; int ldc;
    DEV void operator()(const f32x4 (&acc)[2][2][4][2], const Unit& u, int wr, int wc, int fr, int fq) const {
        const int row0 = u.pm * 256 + wr * 64 + fr, col0 = u.pn * 256 + wc * 32 + 8 * fq;
#pragma unroll
        for (int ai = 0; ai < 2; ++ai)
#pragma unroll
            for (int m = 0; m < 4; ++m) {
                bf16_t* rowp = O + (size_t)(row0 + ai * 128 + m * 16) * ldc + col0;
#pragma unroll
                for (int bj = 0; bj < 2; ++bj) {
                    const f32x4 v0 = acc[ai][bj][m][0], v1 = acc[ai][bj][m][1];
                    u32x4 w; w.x = cvt_pk_bf16(v0[0], v0[1]); w.y = cvt_pk_bf16(v0[2], v0[3]); w.z = cvt_pk_bf16(v1[0], v1[1]); w.w = cvt_pk_bf16(v1[2], v1[3]);
                    *(u32x4*)(rowp + bj * 128) = w;
                }
            }
    }
};
struct EpiGlu {
    static constexpr bool PERM = true, AFTER_DRAIN = false;
    const bf16_t* Y; const float* bias; bf16_t* O;
    DEV void operator()(const f32x4 (&acc)[2][2][4][2], const Unit& u, int wr, int wc, int fr, int fq) const {
        const int row0 = u.pm * 256 + wr * 64 + fr, col0 = u.pn * 256 + wc * 32 + 8 * fq;
#pragma unroll
        for (int ai = 0; ai < 2; ++ai)
#pragma unroll
            for (int m = 0; m < 4; ++m) {
                const int row = row0 + ai * 128 + m * 16;
#pragma unroll
                for (int bj = 0; bj < 2; ++bj) {
                    const int col = col0 + bj * 128;
                    const u32x4 yv = *(const u32x4*)(Y + (size_t)row * 512 + col);
                    const f32x4 b0 = *(const f32x4*)(bias + col), b1 = *(const f32x4*)(bias + col + 4);
                    const f32x4 v0 = acc[ai][bj][m][0] + b0, v1 = acc[ai][bj][m][1] + b1;
                    float y[8];
#pragma unroll
                    for (int j = 0; j < 4; ++j) { y[2 * j] = __uint_as_float(yv[j] << 16); y[2 * j + 1] = __uint_as_float(yv[j] & 0xffff0000u); }
                    u32x4 w;
                    w.x = cvt_pk_bf16(y[0] * sigm(v0[0]), y[1] * sigm(v0[1])); w.y = cvt_pk_bf16(y[2] * sigm(v0[2]), y[3] * sigm(v0[3]));
                    w.z = cvt_pk_bf16(y[4] * sigm(v1[0]), y[5] * sigm(v1[1])); w.w = cvt_pk_bf16(y[6] * sigm(v1[2]), y[7] * sigm(v1[3]));
                    *(u32x4*)(O + (size_t)row * D + 512 + col) = w;
                }
            }
    }
};

struct EpiPG {
    static constexpr bool PERM = true, AFTER_DRAIN = false;
    bf16_t* O; int ldc;
    DEV void operator()(const f32x4 (&acc)[2][2][4][2], const Unit& u, int wr, int wc, int fr, int fq) const {
        const int row0 = u.pm * 256 + wr * 64 + fr, col0 = u.pn * 256 + wc * 32 + 8 * fq;
        if (u.pn < 4) {
#pragma unroll
            for (int ai = 0; ai < 2; ++ai)
#pragma unroll
                for (int m = 0; m < 4; ++m) {
                    const f32x4 a0 = acc[ai][0][m][0], a1 = acc[ai][0][m][1], g0 = acc[ai][1][m][0], g1 = acc[ai][1][m][1];
                    u32x4 w;
                    w.x = cvt_pk_bf16(a0[0] * sigm(g0[0]), a0[1] * sigm(g0[1])); w.y = cvt_pk_bf16(a0[2] * sigm(g0[2]), a0[3] * sigm(g0[3]));
                    w.z = cvt_pk_bf16(a1[0] * sigm(g1[0]), a1[1] * sigm(g1[1])); w.w = cvt_pk_bf16(a1[2] * sigm(g1[2]), a1[3] * sigm(g1[3]));
                    *(u32x4*)(O + (size_t)(row0 + ai * 128 + m * 16) * ldc + u.pn * 128 + wc * 32 + 8 * fq) = w;
                }
        } else {
#pragma unroll
            for (int ai = 0; ai < 2; ++ai)
#pragma unroll
                for (int m = 0; m < 4; ++m) {
                    bf16_t* rowp = O + (size_t)(row0 + ai * 128 + m * 16) * ldc + col0;
#pragma unroll
                    for (int bj = 0; bj < 2; ++bj) {
                        const f32x4 v0 = acc[ai][bj][m][0], v1 = acc[ai][bj][m][1];
                        u32x4 w; w.x = cvt_pk_bf16(v0[0], v0[1]); w.y = cvt_pk_bf16(v0[2], v0[3]); w.z = cvt_pk_bf16(v1[0], v1[1]); w.w = cvt_pk_bf16(v1[2], v1[3]);
                        *(u32x4*)(rowp + bj * 128) = w;
                    }
                }
        }
    }
};

DEV void convert_job(const float* __restrict__ src, int Nsrc, int K, bf16_t* __restrict__ dst, int Nv, int mode, int& base, float* tile, int bid, int G) {
    const int tid = TID();
    const int tv = Nv / 256, ntiles = (K / 64) * tv;
    const int first = (int)(((long)bid - (long)(base % G) + G) % G);
    for (int t = first; t < ntiles; t += G) {
        const int v0 = (t % tv) * 256, k0 = (t / tv) * 64;
        {
            const int v = tid & 255, kh = (tid >> 8) * 32, vv = v0 + v;
            int sc;
            if (mode == 1) { const int T = vv >> 8, tt = vv & 255; sc = tt < 128 ? 128 * T + tt : FFN + 128 * T + (tt - 128); }
            else if (mode == 2 && vv < 1024) { const int T = vv >> 8, tt = vv & 255; sc = tt < 128 ? 128 * T + tt : 512 + 128 * T + (tt - 128); }
            else sc = vv < Nsrc ? vv : -1;
            float x[32];
#pragma unroll
            for (int i = 0; i < 32; ++i) x[i] = sc >= 0 ? src[(size_t)(k0 + kh + i) * Nsrc + sc] : 0.f;
#pragma unroll
            for (int i = 0; i < 32; ++i) tile[(kh + i) * 257 + v] = x[i];
        }
        __syncthreads();
        {
            const int vo = tid >> 1, kq = (tid & 1) * 32;
#pragma unroll
            for (int q = 0; q < 4; ++q) {
                const int kk = kq + q * 8;
                pg8::u32x4 w;
                w.x = pack2(tile[(kk + 0) * 257 + vo], tile[(kk + 1) * 257 + vo]); w.y = pack2(tile[(kk + 2) * 257 + vo], tile[(kk + 3) * 257 + vo]);
                w.z = pack2(tile[(kk + 4) * 257 + vo], tile[(kk + 5) * 257 + vo]); w.w = pack2(tile[(kk + 6) * 257 + vo], tile[(kk + 7) * 257 + vo]);
                *(pg8::u32x4*)(dst + (size_t)(v0 + vo) * K + k0 + kk) = w;
            }
        }
        __syncthreads();
    }
    base += ntiles;
}

DEV void convert_layer(const Params& p, int l, float* tile, int bid, int G) {
    char* ws = p.ws; int base = 0; const int eo = l >> 1;
    for (int f = 0; f < 2; ++f) {
        const int i = l * 2 + f;
        convert_job(p.in[PZ() + I_WUP] + (size_t)i * D * 2 * FFN, 2 * FFN, D, (bf16_t*)(ws + OFF_WUP + i * SZ_WUP), 2 * FFN, 1, base, tile, bid, G);
        convert_job(p.in[PZ() + I_WDN] + (size_t)i * FFN * D, D, FFN, (bf16_t*)(ws + OFF_WDN + i * SZ_WDN), D, 0, base, tile, bid, G);
    }
    if ((l & 1) == 0) {
        convert_job(p.in[PZ() + I_ABIN] + (size_t)eo * D * ABIN, ABIN, D, (bf16_t*)(ws + OFF_WABIN + (size_t)eo * ABN * D * 2), ABN, 0, base, tile, bid, G);
        convert_job(p.in[PZ() + I_ABOUT] + (size_t)eo * D * D, D, D, (bf16_t*)(ws + OFF_WABOUT + (size_t)eo * D * D * 2), D, 0, base, tile, bid, G);
        convert_job(p.in[PZ() + I_GLUW] + (size_t)eo * 512 * 512, 512, 512, (bf16_t*)(ws + OFF_WGLU + (size_t)eo * 512 * 512 * 2), 512, 0, base, tile, bid, G);
    } else {
        convert_job(p.in[PZ() + I_CDIN] + (size_t)eo * D * CDN, CDN, D, (bf16_t*)(ws + OFF_WCDIN + (size_t)eo * CDN * D * 2), CDN, 2, base, tile, bid, G);
        convert_job(p.in[PZ() + I_CDOUT] + (size_t)eo * D * D, D, D, (bf16_t*)(ws + OFF_WCDOUT + (size_t)eo * D * D * 2), D, 0, base, tile, bid, G);
    }
}

DEV void phase_init(const Params& p, char* smem) {
    const int tid = TID(), G = gridDim.x, bid = blockIdx.x;
    char* ws = p.ws;
    float* tile = (float*)smem;
    convert_layer(p, 0, tile, bid, G);
    {
        float* sc = (float*)smem;
        float* red = sc + 3 * 1024;
        __syncthreads();
        for (int i = tid; i < 3 * 1024; i += 512) { const float v = i < 2048 ? p.in[PZ() + I_C][i] : p.in[PZ() + I_CCTX][i - 2048]; sc[i] = silu(v); }
        __syncthreads();
        float* mod = (float*)(ws + OFF_MOD);
        const int col = tid & 63, ks = tid >> 6;
        for (int u = bid; u < 4 * 144; u += G) {
            const int l = u / 144, cg0 = (u % 144) * 64;
            const float* w = p.in[PZ() + I_ADAW] + ((size_t)l * D + ks * 128) * MODW + cg0 + col;
            float a0 = 0.f, a1 = 0.f, a2 = 0.f;
#pragma unroll 8
            for (int k = 0; k < 128; ++k) { const float wv = w[(size_t)k * MODW]; const int kk = ks * 128 + k; a0 += sc[kk] * wv; a1 += sc[1024 + kk] * wv; a2 += sc[2048 + kk] * wv; }
            red[(ks * 3 + 0) * 64 + col] = a0; red[(ks * 3 + 1) * 64 + col] = a1; red[(ks * 3 + 2) * 64 + col] = a2;
            __syncthreads();
            if (tid < 192) {
                const int r = tid >> 6, cc = tid & 63; float s = p.in[PZ() + I_ADAB][(size_t)l * MODW + cg0 + cc];
#pragma unroll
                for (int k = 0; k < 8; ++k) s += red[(k * 3 + r) * 64 + cc];
                mod[((size_t)l * 3 + r) * MODW + cg0 + cc] = s;
            }
            __syncthreads();
        }
    }
    if (bid == G - 1) {
        float* lb = (float*)(ws + OFF_LB);
        const float a = p.in[PZ() + I_LB][tid], b = p.in[PZ() + I_LB][512 + tid], c = p.in[PZ() + I_LB][1024 + tid];
        const float mx = fmaxf(a, fmaxf(b, c)); const float ea = expf(a - mx), eb = expf(b - mx), ec = expf(c - mx); const float inv = 1.f / (ea + eb + ec);
        lb[tid] = ea * inv; lb[512 + tid] = (ea + eb) * inv; lb[1024 + tid] = 1.f;
    }
    for (int i = (bid + PZ()) * 512 + tid; i < 8192; i += G * 512) {
        const int gidx = i >> 6;
        const double lr = (double)p.in[PZ() + I_LRE][i], li = (double)p.in[PZ() + I_LIM][i], step = exp((double)p.in[PZ() + I_LSTEP][gidx]);
        const double mag = exp(lr * step), ar = mag * cos(li * step), ai = mag * sin(li * step);
        const double den = lr * lr + li * li, nr = ar - 1.0, ni = ai;
        double pr = ar, pi = ai;
#pragma unroll
        for (int q = 0; q < 6; ++q) { const double tr = pr * pr - pi * pi, ti = 2.0 * pr * pi; pr = tr; pi = ti; }
        float* dt = (float*)(ws + OFF_DISC) + (size_t)i * 8;
        dt[0] = (float)ar; dt[1] = (float)ai; dt[2] = (float)((nr * lr + ni * li) / den); dt[3] = (float)((ni * lr - nr * li) / den);
        dt[4] = (float)pr; dt[5] = (float)pi; dt[6] = 0.f; dt[7] = 0.f;
    }
}

DEV void phase_norm(const Params& p, int l, int j) {
    const int tid = TID(), lane = tid & 63, wid = tid >> 6;
    const float* h = (const float*)(p.ws + OFF_H);
    bf16_t* hn = (bf16_t*)(p.ws + OFF_HN);
    const float* g = p.in[PZ() + I_NORMG] + (size_t)(l * 3 + j) * D;
    const float* mod = (const float*)(p.ws + OFF_MOD) + (size_t)l * 3 * MODW;
    const bool first = (l == 0 && j == 0);
    for (int row = blockIdx.x * 8 + wid; row < NTOK; row += gridDim.x * 8) {
        const float* hr = first ? (row < NLAT ? p.in[PZ() + I_X] + (size_t)row * D : p.in[PZ() + I_CTX] + (size_t)(row - NLAT) * D) : h + (size_t)row * D;
        float4 v[4]; float ss = 0.f;
#pragma unroll
        for (int i = 0; i < 4; ++i) { v[i] = *(const float4*)(hr + i * 256 + lane * 4); ss += v[i].x * v[i].x + v[i].y * v[i].y + v[i].z * v[i].z + v[i].w * v[i].w; }
        if (first) {
#pragma unroll
            for (int i = 0; i < 4; ++i) *(float4*)((float*)(p.ws + OFF_H) + (size_t)row * D + i * 256 + lane * 4) = v[i];
        }
        ss = wave_sum(ss);
        const float rstd = rsqrtf(ss * (1.f / D) + 1e-6f);
        const float* m = mod + (size_t)mod_row(row) * MODW + (j * 3) * D;
#pragma unroll
        for (int i = 0; i < 4; ++i) {
            const int c = i * 256 + lane * 4;
            const float4 gg = *(const float4*)(g + c), sh = *(const float4*)(m + c), sc = *(const float4*)(m + D + c);
            u32x2 w;
            w.x = pack2(v[i].x * rstd * gg.x * (1.f + sc.x) + sh.x, v[i].y * rstd * gg.y * (1.f + sc.y) + sh.y);
            w.y = pack2(v[i].z * rstd * gg.z * (1.f + sc.z) + sh.z, v[i].w * rstd * gg.w * (1.f + sc.w) + sh.w);
            *(u32x2*)(hn + (size_t)row * D + c) = w;
        }
    }
}

DEV void phase_final(const Params& p) {
    const int tid = TID(), lane = tid & 63, wid = tid >> 6;
    const float* h = (const float*)(p.ws + OFF_H);
    const float* g = p.in[PZ() + I_FNG];
    for (int row = blockIdx.x * 8 + wid; row < NLAT; row += gridDim.x * 8) {
        const float* hr = h + (size_t)row * D;
        float4 v[4]; float ss = 0.f;
#pragma unroll
        for (int i = 0; i < 4; ++i) { v[i] = *(const float4*)(hr + i * 256 + lane * 4); ss += v[i].x * v[i].x + v[i].y * v[i].y + v[i].z * v[i].z + v[i].w * v[i].w; }
        ss = wave_sum(ss);
        const float rstd = rsqrtf(ss * (1.f / D) + 1e-6f);
#pragma unroll
        for (int i = 0; i < 4; ++i) {
            const int c = i * 256 + lane * 4;
            const float4 gg = *(const float4*)(g + c);
            float4 o; o.x = v[i].x * rstd * gg.x; o.y = v[i].y * rstd * gg.y; o.z = v[i].z * rstd * gg.z; o.w = v[i].w * rstd * gg.w;
            *(float4*)(p.out + (size_t)row * D + c) = o;
        }
    }
}

DEV int stream_row64(int b, int dir, int sc, int s) {
    if (sc < 4) { const int oc = dir ? 3 - sc : sc; return NLAT + b * CTXL + oc * 64 + (dir ? 63 - s : s); }
    const int lc = sc - 4, oc = dir ? 255 - lc : lc; return b * SEQ + oc * 64 + (dir ? 63 - s : s);
}

DEV const float* s5_dt(const Params& p, int e, int dir, int g, int pp) { return (const float*)(p.ws + OFF_DISC) + ((size_t)((e * 2 + dir) * 32 + g) * 64 + pp) * 8; }
DEV void s5_bfrag(const Params& p, int e, int dir, int g, int l15, int lq, s16x8 (&bf)[8]) {
#pragma unroll
    for (int q = 0; q < 4; ++q) {
        const int pp = 16 * q + l15;
        const float* dt = s5_dt(p, e, dir, g, pp); const float cr = dt[2], ci = dt[3];
        const float* br = p.in[PZ() + I_BRE] + ((size_t)(e * 32 + g) * 64 + pp) * 16 + 8 * (lq & 1); const float* bi = p.in[PZ() + I_BIM] + ((size_t)(e * 32 + g) * 64 + pp) * 16 + 8 * (lq & 1);
        const float4 r0 = *(const float4*)br, r1 = *(const float4*)(br + 4), q0 = *(const float4*)bi, q1 = *(const float4*)(bi + 4);
        const float rr[8] = {r0.x, r0.y, r0.z, r0.w, r1.x, r1.y, r1.z, r1.w}, qq[8] = {q0.x, q0.y, q0.z, q0.w, q1.x, q1.y, q1.z, q1.w};
#pragma unroll
        for (int i = 0; i < 8; ++i) {
            const float wre = cr * rr[i] - ci * qq[i], wim = cr * qq[i] + ci * rr[i];
            const bf16_t hre = f2bf(wre), him = f2bf(wim);
            bf[q][i] = (short)(lq < 2 ? hre : f2bf(wre - bf2f(hre)));
            bf[q + 4][i] = (short)(lq < 2 ? him : f2bf(wim - bf2f(him)));
        }
    }
}
template <class RowF> DEV void s5_load_u(const Params& p, bf16_t* us, int gq, RowF rowf) {
    const int tid = TID(), s = tid >> 3, part = tid & 7;
    const bf16_t* P = (const bf16_t*)(p.ws + OFF_P);
    const pg8::u32x4* src = (const pg8::u32x4*)(P + (size_t)rowf(s) * ABN + 2064 + gq * 128 + part * 16);
    pg8::u32x4* dst = (pg8::u32x4*)(us + s * 128 + part * 16);
    dst[0] = src[0]; dst[1] = src[1];
}
DEV void wave_sync() { __builtin_amdgcn_fence(__ATOMIC_RELEASE, "wavefront"); __builtin_amdgcn_wave_barrier(); __builtin_amdgcn_fence(__ATOMIC_ACQUIRE, "wavefront"); }
DEV void s5_bu(const bf16_t* us, int r0, int w, int l15, int lq, const s16x8 (&bf)[8], float* bub) {
    const s16x8 a = *(const s16x8*)(us + (r0 + l15) * 128 + w * 16 + (lq & 1) * 8);
#pragma unroll
    for (int nt = 0; nt < 8; ++nt) {
        f32x4 acc = {0.f, 0.f, 0.f, 0.f};
        acc = __builtin_amdgcn_mfma_f32_16x16x32_bf16(a, bf[nt], acc, 0, 0, 0);
#pragma unroll
        for (int j = 0; j < 4; ++j) bub[(4 * lq + j) * 132 + 16 * nt + l15] = acc[j];
    }
}

DEV void s5_disc(const Params& p, int e, int dir, int g, int pp, float& abr, float& abi, float& cr, float& ci) {
    const int i = ((e * 2 + dir) * 32 + g) * 64 + pp;
    const double lr = (double)p.in[PZ() + I_LRE][i], li = (double)p.in[PZ() + I_LIM][i], step = exp((double)p.in[PZ() + I_LSTEP][(e * 2 + dir) * 32 + g]);
    const double mag = exp(lr * step), ar = mag * cos(li * step), ai = mag * sin(li * step);
    const double den = lr * lr + li * li, nr = ar - 1.0, ni = ai;
    abr = (float)ar; abi = (float)ai; cr = (float)((nr * lr + ni * li) / den); ci = (float)((ni * lr - nr * li) / den);
}
DEV void s5_bbar(const Params& p, int e, int g, int pp, float cr, float ci, float (&bbr)[16], float (&bbi)[16]) {
    const float* br = p.in[PZ() + I_BRE] + ((size_t)(e * 32 + g) * 64 + pp) * 16; const float* bi = p.in[PZ() + I_BIM] + ((size_t)(e * 32 + g) * 64 + pp) * 16;
#pragma unroll
    for (int c4 = 0; c4 < 4; ++c4) {
        const float4 r = *(const float4*)(br + c4 * 4), q = *(const float4*)(bi + c4 * 4);
        bbr[c4 * 4 + 0] = cr * r.x - ci * q.x; bbi[c4 * 4 + 0] = cr * q.x + ci * r.x;
        bbr[c4 * 4 + 1] = cr * r.y - ci * q.y; bbi[c4 * 4 + 1] = cr * q.y + ci * r.y;
        bbr[c4 * 4 + 2] = cr * r.z - ci * q.z; bbi[c4 * 4 + 2] = cr * q.z + ci * r.z;
        bbr[c4 * 4 + 3] = cr * r.w - ci * q.w; bbi[c4 * 4 + 3] = cr * q.w + ci * r.w;
    }
}
DEV void s5_step(const bf16_t* urow, const float (&bbr)[16], const float (&bbi)[16], float abr, float abi, float& hr, float& hi) {
    float bur = 0.f, bui = 0.f;
#pragma unroll
    for (int c8 = 0; c8 < 2; ++c8) {
        const pg8::u32x4 uv = *(const pg8::u32x4*)(urow + c8 * 8);
#pragma unroll
        for (int j = 0; j < 4; ++j) {
            const float u0 = __uint_as_float(uv[j] << 16), u1 = __uint_as_float(uv[j] & 0xffff0000u);
            bur += bbr[c8 * 8 + 2 * j] * u0 + bbr[c8 * 8 + 2 * j + 1] * u1; bui += bbi[c8 * 8 + 2 * j] * u0 + bbi[c8 * 8 + 2 * j + 1] * u1;
        }
    }
    const float nr = abr * hr - abi * hi + bur, ni = abr * hi + abi * hr + bui;
    hr = nr; hi = ni;
}

DEV void phase_s1(const Params& p, int e, char* smem, int first, int stride) {
    const int tid = TID(), lane = tid & 63, w = tid >> 6;
    bf16_t* us = (bf16_t*)smem;
    float2* carry = (float2*)((char*)p.out + OUT_CARRY);
    for (int ib = first; ib < 4 * NCH * 4; ib += stride) {
        const int gq = ib & 3, rest = ib >> 2, sc = rest % NCH, bd = rest / NCH, dir = bd & 1, b = bd >> 1, g = gq * 8 + w;
        __syncthreads();
        s5_load_u(p, us, gq, [&](int s) { return stream_row64(b, dir, sc, s); });
        float abr, abi, cr, ci; s5_disc(p, e, dir, g, lane, abr, abi, cr, ci);
        float bbr[16], bbi[16]; s5_bbar(p, e, g, lane, cr, ci, bbr, bbi);
        __syncthreads();
        float hr = 0.f, hi = 0.f;
        for (int s = 0; s < 64; ++s) s5_step(us + s * 128 + w * 16, bbr, bbi, abr, abi, hr, hi);
        carry[((size_t)((b * 2 + dir) * 32 + g) * NCH + sc) * 64 + lane] = make_float2(hr, hi);
    }
}

DEV void phase_s2(const Params& p, int e, int bid) {
    const int gid = (bid + PZ()) * 512 + TID();
    if (gid < 128 * 64) {
    const int pp = gid & 63, chain = gid >> 6, dir = (chain >> 5) & 1, g = chain & 31;
    const float* dt = s5_dt(p, e, dir, g, pp); const float ar = dt[4], ai = dt[5];
    float2* E = (float2*)((char*)p.out + OUT_CARRY) + (size_t)chain * NCH * 64 + pp;
    float hr = 0.f, hi = 0.f;
    for (int sc = 0; sc < NCH; ++sc) {
        const float2 t = E[(size_t)sc * 64];
        E[(size_t)sc * 64] = make_float2(hr, hi);
        const float nr = ar * hr - ai * hi + t.x, ni = ar * hi + ai * hr + t.y;
        hr = nr; hi = ni;
    }
    }
}

DEV float gelu_tanh(float x) {
    const float z = 0.7978845608028654f * (x + 0.044715f * x * x * x);
    const float t = 1.f - 2.f * __builtin_amdgcn_rcpf(__expf(2.f * z) + 1.f);
    return 0.5f * x * (1.f + t);
}

DEV void phase_s3(const Params& p, int e, char* smem) {
    const int tid = TID(), lane = tid & 63, w = tid >> 6, l15 = lane & 15, lq = lane >> 4;
    bf16_t* us = (bf16_t*)smem;
    float* bub = (float*)(smem + 16384) + (size_t)w * 3200;
    bf16_t* hb = (bf16_t*)(bub + 16 * 132);
    const float2* carry = (const float2*)((char*)p.out + OUT_CARRY);
    bf16_t* ybuf = (bf16_t*)(p.ws + OFF_SCR + SCR_YB);
    for (int ib = blockIdx.x; ib < NB * NCH * 4; ib += gridDim.x) {
        const int gq = ib & 3, rest = ib >> 2, qc = rest % NCH, b = rest / NCH, g = gq * 8 + w;
        const int row0 = qc < 4 ? NLAT + b * CTXL + qc * 64 : b * SEQ + (qc - 4) * 64;
        __syncthreads();
        s5_load_u(p, us, gq, [&](int s) { return row0 + s; });
        s16x8 cm[4];
        {
            const float* cre = p.in[PZ() + I_CRE] + ((size_t)(e * 32 + g) * 16 + l15) * 64; const float* cim = p.in[PZ() + I_CIM] + ((size_t)(e * 32 + g) * 16 + l15) * 64;
#pragma unroll
            for (int ks = 0; ks < 4; ++ks) {
                const float* src = (ks < 2 ? cre : cim) + (32 * ks + 8 * lq) % 64; const float sg = ks < 2 ? 1.f : -1.f;
                const float4 c0 = *(const float4*)src, c1 = *(const float4*)(src + 4);
                cm[ks][0] = (short)f2bf(sg * c0.x); cm[ks][1] = (short)f2bf(sg * c0.y); cm[ks][2] = (short)f2bf(sg * c0.z); cm[ks][3] = (short)f2bf(sg * c0.w);
                cm[ks][4] = (short)f2bf(sg * c1.x); cm[ks][5] = (short)f2bf(sg * c1.y); cm[ks][6] = (short)f2bf(sg * c1.z); cm[ks][7] = (short)f2bf(sg * c1.w);
            }
        }
        f32x4 yacc[4];
#pragma unroll
        for (int i = 0; i < 4; ++i) yacc[i] = (f32x4){0.f, 0.f, 0.f, 0.f};
        __syncthreads();
#pragma unroll
        for (int dir = 0; dir < 2; ++dir) {
            s16x8 bf[8]; s5_bfrag(p, e, dir, g, l15, lq, bf);
            const float* dt = s5_dt(p, e, dir, g, lane); const float abr = dt[0], abi = dt[1];
            const int sc = dir ? (qc < 4 ? 3 - qc : 4 + (255 - (qc - 4))) : qc;
            const float2 h0 = carry[((size_t)((b * 2 + dir) * 32 + g) * NCH + sc) * 64 + lane];
            float hr = h0.x, hi = h0.y;
#pragma unroll
            for (int bi = 0; bi < 4; ++bi) {
                const int blk = dir ? 3 - bi : bi;
                s5_bu(us, blk * 16, w, l15, lq, bf, bub);
                wave_sync();
#pragma unroll
                for (int tt = 0; tt < 16; ++tt) {
                    const int t = dir ? 15 - tt : tt;
                    const float bur = bub[t * 132 + lane], bui = bub[t * 132 + 64 + lane];
                    const float nr = abr * hr - abi * hi + bur, ni = abr * hi + abi * hr + bui; hr = nr; hi = ni;
                    hb[t * 136 + lane] = f2bf(hr); hb[t * 136 + 64 + lane] = f2bf(hi);
                }
                wave_sync();
#pragma unroll
                for (int ks = 0; ks < 4; ++ks) {
                    const s16x8 a = *(const s16x8*)(hb + l15 * 136 + 32 * ks + 8 * lq);
                    yacc[blk] = __builtin_amdgcn_mfma_f32_16x16x32_bf16(a, cm[ks], yacc[blk], 0, 0, 0);
                }
                wave_sync();
            }
        }
        {
            const float dsk = p.in[PZ() + I_S5D][(size_t)e * 512 + g * 16 + l15];
#pragma unroll
            for (int blk = 0; blk < 4; ++blk)
#pragma unroll
                for (int j = 0; j < 4; ++j) {
                    const int t = 16 * blk + 4 * lq + j;
                    const float y = yacc[blk][j] + dsk * bf2f(us[t * 128 + w * 16 + l15]);
                    ybuf[(size_t)(row0 + t) * 512 + g * 16 + l15] = f2bf(gelu_tanh(y));
                }
        }
    }
}

DEV float gdn_conv(const bf16_t* P, const float* cw, int row, int t, int L, int col) {
    float acc = 0.f;
#pragma unroll
    for (int j = 0; j < 5; ++j) { const int tt = t + j - 2; if (tt >= 0 && tt < L) acc += bf2f(P[(size_t)(row + j - 2) * ABN + col]) * cw[j * 1536 + col]; }
    return acc;
}

static_assert(OUT_KNT + (size_t)2080 * 8192 * 2 <= (size_t)NLAT * D * 4, "knT must fit in d_out");

DEV void phase_g1(const Params& p, int e, char* smem) {
    const int tid = TID(), lane = tid & 63, w = tid >> 6;
    float* qs = (float*)smem; float* ks = qs + 64 * 132; float* KKr = ks + 64 * 132; float* QKr = KKr + 64 * 68; float* gcA = QKr + 64 * 68; float* btA = gcA + 128;
    float* As = qs; float* Xs = qs + 64 * 68;
    const bf16_t* P = (const bf16_t*)(p.ws + OFF_P);
    bf16_t* qn = (bf16_t*)(p.ws + OFF_QN); bf16_t* kn = (bf16_t*)(p.ws + OFF_KN); bf16_t* vc = (bf16_t*)(p.ws + OFF_HN);
    bf16_t* knT = (bf16_t*)((char*)p.out + OUT_KNT);
    bf16_t* Tg = (bf16_t*)(p.ws + OFF_SCR + SCR_T); bf16_t* QKg = (bf16_t*)(p.ws + OFF_SCR + SCR_QK); float* gb = (float*)(p.ws + OFF_SCR + SCR_GB);
    const float* cw = p.in[PZ() + I_GCONV] + (size_t)e * 5 * 1536;
    for (int item = blockIdx.x; item < 2080; item += gridDim.x) {
        const int qc = item % NCH, bh = item / NCH, h = bh & 3, b = bh >> 2;
        const int oc = qc < 4 ? qc : qc - 4;
        const int base = qc < 4 ? NLAT + b * CTXL : b * SEQ, L = qc < 4 ? CTXL : SEQ;
        const int sc1 = qc < 4 ? 3 - qc : 4 + (255 - oc);
        lds_barrier();
        {
            for (int ps = 0; ps < 2; ++ps) {
                if (ps == 1 && tid >= 256) break;
                const int pair = ps == 0 ? (tid & 127) : (tid & 63), tg = ps == 0 ? (tid >> 7) : (tid >> 6);
                const int cidx = 2 * pair;
                const int col = ps == 1 ? 1024 + h * 128 + cidx : (cidx < 128 ? h * 128 + cidx : 512 + h * 128 + (cidx - 128));
                float2 wv[5];
#pragma unroll
                for (int j = 0; j < 5; ++j) wv[j] = *(const float2*)(cw + j * 1536 + col);
                auto ld = [&](int n) -> float2 {
                    const int t = oc * 64 + n;
                    if (t < 0 || t >= L) return make_float2(0.f, 0.f);
                    const unsigned raw = *(const unsigned*)(P + (size_t)(base + t) * ABN + col);
                    return make_float2(__uint_as_float(raw << 16), __uint_as_float(raw & 0xffff0000u));
                };
                const int n0 = tg * 16;
                float2 xm2 = ld(n0 - 2), xm1 = ld(n0 - 1), x0 = ld(n0), xp1 = ld(n0 + 1);
#pragma unroll
                for (int i = 0; i < 16; ++i) {
                    const float2 xp2 = ld(n0 + i + 2);
                    const float a0 = xm2.x * wv[0].x + xm1.x * wv[1].x + x0.x * wv[2].x + xp1.x * wv[3].x + xp2.x * wv[4].x;
                    const float a1 = xm2.y * wv[0].y + xm1.y * wv[1].y + x0.y * wv[2].y + xp1.y * wv[3].y + xp2.y * wv[4].y;
                    const int n = n0 + i;
                    if (ps == 0) *(float2*)((cidx < 128 ? qs : ks) + n * 132 + (cidx & 127)) = make_float2(silu(a0), silu(a1));
                    else *(unsigned*)(vc + (size_t)(base + oc * 64 + n) * D + h * 128 + cidx) = pack2(silu(a0), silu(a1));
                    xm2 = xm1; xm1 = x0; x0 = xp1; xp1 = xp2;
                }
            }
        }
        lds_barrier();
        {
            const int vec = tid >> 2, isk = vec >> 6, s = vec & 63, qt = tid & 3;
            float* x = (isk ? ks : qs) + s * 132 + qt * 32;
            float4 v4[8]; float ss = 0.f;
#pragma unroll
            for (int i = 0; i < 8; ++i) { v4[i] = *(const float4*)(x + 4 * i); ss += v4[i].x * v4[i].x + v4[i].y * v4[i].y + v4[i].z * v4[i].z + v4[i].w * v4[i].w; }
            ss = sum4(ss);
            const float scl = rsqrtf(ss + 1e-6f) * (isk ? 1.f : 0.08838834764831845f);
            pg8::u32x4* o = (pg8::u32x4*)((isk ? kn : qn) + (size_t)(base + oc * 64 + s) * 512 + h * 128 + qt * 32);
#pragma unroll
            for (int i = 0; i < 4; ++i) {
                float4 a = v4[2 * i], c = v4[2 * i + 1];
                a.x *= scl; a.y *= scl; a.z *= scl; a.w *= scl; c.x *= scl; c.y *= scl; c.z *= scl; c.w *= scl;
                *(float4*)(x + 8 * i) = a; *(float4*)(x + 8 * i + 4) = c;
                pg8::u32x4 wv; wv.x = pack2(a.x, a.y); wv.y = pack2(a.z, a.w); wv.z = pack2(c.x, c.y); wv.w = pack2(c.z, c.w);
                o[i] = wv;
            }
        }
        if (tid < 128) {
            const int dir = tid >> 6, s = tid & 63, n = dir ? 63 - s : s, row = base + oc * 64 + n;
            const int ci = ((b * 4 + h) * 2 + dir) * NCH + (dir ? sc1 : qc);
            const float a = bf2f(P[(size_t)row * ABN + 2048 + dir * 4 + h]), bb = bf2f(P[(size_t)row * ABN + 2056 + dir * 4 + h]);
            const float x = a + p.in[PZ() + I_GDT][(e * 2 + dir) * 4 + h];
            const float sp = x > 20.f ? x : __logf(1.f + __expf(x));
            float la = -__expf(p.in[PZ() + I_GALOG][(e * 2 + dir) * 4 + h]) * sp;
#pragma unroll
            for (int o = 1; o < 64; o <<= 1) { const float t = __shfl_up(la, o, 64); if (lane >= o) la += t; }
            const float be = sigm(bb);
            gcA[dir * 64 + s] = la; btA[dir * 64 + s] = be; gb[(size_t)ci * 128 + s] = la; gb[(size_t)ci * 128 + 64 + s] = be;
        }
        lds_barrier();
        {
            const int d = tid >> 2, tq = (tid & 3) * 16;
            unsigned o[8];
#pragma unroll
            for (int i = 0; i < 8; ++i) o[i] = pack2(ks[(tq + 2 * i) * 132 + d], ks[(tq + 2 * i + 1) * 132 + d]);
            pg8::u32x4* dst = (pg8::u32x4*)(knT + ((size_t)(bh * NCH + qc) * 128 + d) * 64 + tq);
            pg8::u32x4 w0, w1; w0.x = o[0]; w0.y = o[1]; w0.z = o[2]; w0.w = o[3]; w1.x = o[4]; w1.y = o[5]; w1.z = o[6]; w1.w = o[7];
            dst[0] = w0; dst[1] = w1;
        }
        {
            const int l15 = lane & 15, lq = lane >> 4;
            for (int job = w; job < 26; job += 8) {
                int mi, ni; const bool isq = job >= 10;
                if (isq) { mi = (job - 10) >> 2; ni = (job - 10) & 3; }
                else { mi = job >= 6 ? 3 : (job >= 3 ? 2 : (job >= 1 ? 1 : 0)); ni = job - (mi * (mi + 1)) / 2; }
                const float* X = isq ? qs : ks;
                f32x4 acc = {0.f, 0.f, 0.f, 0.f};
#pragma unroll
                for (int dd = 0; dd < 8; ++dd) {
                    const float4 a4 = *(const float4*)(X + (16 * mi + l15) * 132 + 16 * dd + 4 * lq), b4 = *(const float4*)(ks + (16 * ni + l15) * 132 + 16 * dd + 4 * lq);
                    acc = __builtin_amdgcn_mfma_f32_16x16x4f32(a4.x, b4.x, acc, 0, 0, 0); acc = __builtin_amdgcn_mfma_f32_16x16x4f32(a4.y, b4.y, acc, 0, 0, 0);
                    acc = __builtin_amdgcn_mfma_f32_16x16x4f32(a4.z, b4.z, acc, 0, 0, 0); acc = __builtin_amdgcn_mfma_f32_16x16x4f32(a4.w, b4.w, acc, 0, 0, 0);
                }
                const int jc = 16 * ni + l15;
#pragma unroll
                for (int j = 0; j < 4; ++j) {
                    const int i = 16 * mi + 4 * lq + j;
                    if (isq) QKr[i * 68 + jc] = acc[j];
                    else { KKr[i * 68 + jc] = acc[j]; if (mi != ni) KKr[jc * 68 + i] = acc[j]; }
                }
            }
        }
        lds_barrier();
        for (int dir = 0; dir < 2; ++dir) {
            const int ci = ((b * 4 + h) * 2 + dir) * NCH + (dir ? sc1 : qc);
            const float* gc = gcA + dir * 64; const float* bt = btA + dir * 64;
            {
                const int si = tid >> 3, jg = tid & 7, ni_ = dir ? 63 - si : si;
                const float gi = gc[si], bi = bt[si];
                unsigned o[4];
#pragma unroll
                for (int j2 = 0; j2 < 4; ++j2) {
                    float q2[2];
#pragma unroll
                    for (int jj = 0; jj < 2; ++jj) {
                        const int sj = jg * 8 + j2 * 2 + jj, nj = dir ? 63 - sj : sj;
                        const float dec = sj <= si ? __expf(gi - gc[sj]) : 0.f;
                        As[si * 68 + (sj & 7) * 8 + (sj >> 3)] = sj < si ? KKr[ni_ * 68 + nj] * dec * bi : 0.f;
                        q2[jj] = QKr[ni_ * 68 + nj] * dec;
                    }
                    o[j2] = pack2(q2[0], q2[1]);
                }
                pg8::u32x4 wv; wv.x = o[0]; wv.y = o[1]; wv.z = o[2]; wv.w = o[3];
                *(pg8::u32x4*)(QKg + (size_t)ci * 4096 + si * 64 + jg * 8) = wv;
            }
            lds_barrier();
            {
                const int c = 8 * w + (lane >> 3), part = lane & 7;
                float X[8];
#pragma unroll
                for (int m = 0; m < 8; ++m) X[m] = 0.f;
#pragma unroll
                for (int i = 0; i < 64; ++i) {
                    const float4 a0 = *(const float4*)(As + i * 68 + part * 8), a1 = *(const float4*)(As + i * 68 + part * 8 + 4);
                    float acc = a0.x * X[0] + a0.y * X[1] + a0.z * X[2] + a0.w * X[3] + a1.x * X[4] + a1.y * X[5] + a1.z * X[6] + a1.w * X[7];
                    acc = sum8(acc);
                    const float x = (i == c ? 1.f : 0.f) - acc;
                    if (part == (i & 7)) X[i >> 3] = x;
                }
#pragma unroll
                for (int m = 0; m < 8; ++m) Xs[(part + 8 * m) * 65 + c] = X[m];
            }
            lds_barrier();
            {
                const int i = tid >> 3, jg = tid & 7;
                pg8::u32x4 wv;
                wv.x = pack2(Xs[i * 65 + jg * 8 + 0], Xs[i * 65 + jg * 8 + 1]); wv.y = pack2(Xs[i * 65 + jg * 8 + 2], Xs[i * 65 + jg * 8 + 3]);
                wv.z = pack2(Xs[i * 65 + jg * 8 + 4], Xs[i * 65 + jg * 8 + 5]); wv.w = pack2(Xs[i * 65 + jg * 8 + 6], Xs[i * 65 + jg * 8 + 7]);
                *(pg8::u32x4*)(Tg + (size_t)ci * 4096 + i * 64 + jg * 8) = wv;
            }
            lds_barrier();
        }
    }
}

DEV void phase_g2(const Params& p, int e, char* smem) {
    (void)e;
    const int tid = TID(), lane = tid & 63, w = tid >> 6, l15 = lane & 15, lq = lane >> 4;
    bf16_t* Kc = (bf16_t*)smem; bf16_t* Qc = Kc + 64 * 136; bf16_t* KT = Qc + 64 * 136; bf16_t* Tc = KT + 128 * 72; bf16_t* QKc = Tc + 64 * 72;
    bf16_t* ST = QKc + 64 * 72; bf16_t* rT = ST + 16 * 136; bf16_t* uT = rT + 16 * 72; bf16_t* u2T = uT + 16 * 72;
    float* vS = (float*)(u2T + 16 * 72); float* gc = vS + 64 * 17; float* bt = gc + 64; bf16_t* oS = (bf16_t*)(bt + 64);
    const bf16_t* qn = (const bf16_t*)(p.ws + OFF_QN); const bf16_t* kn = (const bf16_t*)(p.ws + OFF_KN); const bf16_t* vc = (const bf16_t*)(p.ws + OFF_HN);
    const bf16_t* knT = (const bf16_t*)((const char*)p.out + OUT_KNT);
    const bf16_t* Tg = (const bf16_t*)(p.ws + OFF_SCR + SCR_T); const bf16_t* QKg = (const bf16_t*)(p.ws + OFF_SCR + SCR_QK); const float* gb = (const float*)(p.ws + OFF_SCR + SCR_GB);
    bf16_t* ob = (bf16_t*)p.out;
    for (int item = blockIdx.x; item < 128; item += gridDim.x) {
        const int chain = (item & 7) * 2 + ((item >> 3) & 1), e0 = (item >> 4) * 16, dir = chain & 1, h = (chain >> 1) & 3, b = chain >> 3, bh = chain >> 1;
        struct Pf { pg8::u32x4 rk[2], rq[2], rkt[2], rt, rqk; unsigned rv; float rg; };
        Pf R0, R1;
        const int ls = tid >> 3, lp = tid & 7;
        const int kd = tid >> 2, ktq = (tid & 3) * 16;
        auto fetch = [&](Pf& R, int sc) {
            const int ci = chain * NCH + sc, row = stream_row64(b, dir, sc, ls);
            const int oc = sc < 4 ? (dir ? 3 - sc : sc) : (dir ? 255 - (sc - 4) : sc - 4), qc = sc < 4 ? oc : 4 + oc;
            const pg8::u32x4* sk = (const pg8::u32x4*)(kn + (size_t)row * 512 + h * 128 + lp * 16); R.rk[0] = sk[0]; R.rk[1] = sk[1];
            const pg8::u32x4* sq = (const pg8::u32x4*)(qn + (size_t)row * 512 + h * 128 + lp * 16); R.rq[0] = sq[0]; R.rq[1] = sq[1];
            const pg8::u32x4* st = (const pg8::u32x4*)(knT + ((size_t)(bh * NCH + qc) * 128 + kd) * 64 + ktq); R.rkt[0] = st[0]; R.rkt[1] = st[1];
            R.rt = *(const pg8::u32x4*)(Tg + (size_t)ci * 4096 + ls * 64 + lp * 8); R.rqk = *(const pg8::u32x4*)(QKg + (size_t)ci * 4096 + ls * 64 + lp * 8);
            R.rv = *(const unsigned*)(vc + (size_t)row * D + h * 128 + e0 + 2 * lp);
            R.rg = gb[(size_t)ci * 128 + (tid & 127)];
        };
        auto stash = [&](const Pf& R) {
            pg8::u32x4* dk = (pg8::u32x4*)(Kc + ls * 136 + lp * 16); dk[0] = R.rk[0]; dk[1] = R.rk[1];
            pg8::u32x4* dq = (pg8::u32x4*)(Qc + ls * 136 + lp * 16); dq[0] = R.rq[0]; dq[1] = R.rq[1];
            pg8::u32x4* dt = (pg8::u32x4*)(KT + kd * 72 + ktq); dt[0] = R.rkt[0]; dt[1] = R.rkt[1];
            *(pg8::u32x4*)(Tc + ls * 72 + lp * 8) = R.rt; *(pg8::u32x4*)(QKc + ls * 72 + lp * 8) = R.rqk;
            vS[ls * 17 + 2 * lp] = __uint_as_float(R.rv << 16); vS[ls * 17 + 2 * lp + 1] = __uint_as_float(R.rv & 0xffff0000u);
            if (tid < 64) gc[tid] = R.rg; else if (tid < 128) bt[tid - 64] = R.rg;
        };
        f32x4 Sreg = {0.f, 0.f, 0.f, 0.f};
        lds_barrier();
        for (int i = tid; i < 16 * 136 / 2; i += 512) ((unsigned*)ST)[i] = 0u;
        fetch(R0, 0); stash(R0); fetch(R0, 1);
        lds_barrier();
        auto step = [&](int sc) {
            const int sel = w >> 2, mt = w & 3;
            const bf16_t* Xc = sel ? Qc : Kc;
            f32x4 acc = {0.f, 0.f, 0.f, 0.f};
#pragma unroll
            for (int kq = 0; kq < 4; ++kq) {
                const s16x8 a = *(const s16x8*)(Xc + (16 * mt + l15) * 136 + 32 * kq + 8 * lq), bb = *(const s16x8*)(ST + l15 * 136 + 32 * kq + 8 * lq);
                acc = __builtin_amdgcn_mfma_f32_16x16x32_bf16(a, bb, acc, 0, 0, 0);
            }
            const int t0 = 16 * mt + 4 * lq;
            float eg[4];
#pragma unroll
            for (int j = 0; j < 4; ++j) eg[j] = __expf(gc[t0 + j]);
            const float gl = gc[63];
            if (sel == 0) {
                float r[4];
#pragma unroll
                for (int j = 0; j < 4; ++j) r[j] = bt[t0 + j] * (vS[(t0 + j) * 17 + l15] - eg[j] * acc[j]);
                u32x2 wv; wv.x = pack2(r[0], r[1]); wv.y = pack2(r[2], r[3]);
                *(u32x2*)(rT + l15 * 72 + t0) = wv;
            } else {
#pragma unroll
                for (int j = 0; j < 4; ++j) acc[j] *= eg[j];
            }
            lds_barrier();
            if (sel == 0) {
                f32x4 ua = {0.f, 0.f, 0.f, 0.f};
#pragma unroll
                for (int kq = 0; kq < 2; ++kq) {
                    const s16x8 a = *(const s16x8*)(Tc + (16 * mt + l15) * 72 + 32 * kq + 8 * lq), bb = *(const s16x8*)(rT + l15 * 72 + 32 * kq + 8 * lq);
                    ua = __builtin_amdgcn_mfma_f32_16x16x32_bf16(a, bb, ua, 0, 0, 0);
                }
                u32x2 wv; wv.x = pack2(ua[0], ua[1]); wv.y = pack2(ua[2], ua[3]);
                *(u32x2*)(uT + l15 * 72 + t0) = wv;
                float u2[4];
#pragma unroll
                for (int j = 0; j < 4; ++j) u2[j] = __expf(gl - gc[t0 + j]) * ua[j];
                if (dir == 0) { wv.x = pack2(u2[0], u2[1]); wv.y = pack2(u2[2], u2[3]); *(u32x2*)(u2T + l15 * 72 + t0) = wv; }
                else { wv.x = pack2(u2[3], u2[2]); wv.y = pack2(u2[1], u2[0]); *(u32x2*)(u2T + l15 * 72 + (60 - t0)) = wv; }
            }
            lds_barrier();
            if (sel == 1) {
#pragma unroll
                for (int kq = 0; kq < 2; ++kq) {
                    const s16x8 a = *(const s16x8*)(QKc + (16 * mt + l15) * 72 + 32 * kq + 8 * lq), bb = *(const s16x8*)(uT + l15 * 72 + 32 * kq + 8 * lq);
                    acc = __builtin_amdgcn_mfma_f32_16x16x32_bf16(a, bb, acc, 0, 0, 0);
                }
#pragma unroll
                for (int j = 0; j < 4; ++j) oS[(t0 + j) * 16 + l15] = f2bf(acc[j]);
            }
            {
                const float egl = __expf(gl);
#pragma unroll
                for (int j = 0; j < 4; ++j) Sreg[j] *= egl;
#pragma unroll
                for (int kq = 0; kq < 2; ++kq) {
                    const s16x8 a = *(const s16x8*)(u2T + l15 * 72 + 32 * kq + 8 * lq), bb = *(const s16x8*)(KT + (16 * w + l15) * 72 + 32 * kq + 8 * lq);
                    Sreg = __builtin_amdgcn_mfma_f32_16x16x32_bf16(a, bb, Sreg, 0, 0, 0);
                }
#pragma unroll
                for (int j = 0; j < 4; ++j) ST[(4 * lq + j) * 136 + 16 * w + l15] = f2bf(Sreg[j]);
            }
            lds_barrier();
            *(unsigned*)(ob + ((size_t)dir * NTOK + stream_row64(b, dir, sc, ls)) * 512 + h * 128 + e0 + 2 * lp) = *(const unsigned*)(oS + ls * 16 + 2 * lp);
        };
        for (int sc = 0; sc < NCH; sc += 2) {
            fetch(R1, sc + 2 < NCH ? sc + 2 : NCH - 1);
            step(sc);
            stash(R0); lds_barrier();
            fetch(R0, sc + 3 < NCH ? sc + 3 : NCH - 1);
            step(sc + 1);
            stash(R1);
            lds_barrier();
        }
    }
}

DEV void phase_combine(const Params& p, const bf16_t* G, int ldg, int gcol, const float* ng, int ocol, int bfirst, int nblk) {
    const int tid = TID(), lane = tid & 63, wid = tid >> 6;
    const bf16_t* ob = (const bf16_t*)p.out;
    bf16_t* ym = (bf16_t*)(p.ws + OFF_HN);
    const int c0 = lane * 8, d0 = c0 & 127;
    for (int row = bfirst * 8 + wid; row < NTOK; row += nblk * 8) {
        const pg8::u32x4 a = *(const pg8::u32x4*)(ob + (size_t)row * 512 + c0), bq = *(const pg8::u32x4*)(ob + ((size_t)NTOK + row) * 512 + c0);
        const pg8::u32x4 gv = *(const pg8::u32x4*)(G + (size_t)row * ldg + gcol + c0);
        float o[8], gt[8]; float ss = 0.f;
#pragma unroll
        for (int j = 0; j < 4; ++j) {
            o[2 * j] = __uint_as_float(a[j] << 16) + __uint_as_float(bq[j] << 16); o[2 * j + 1] = __uint_as_float(a[j] & 0xffff0000u) + __uint_as_float(bq[j] & 0xffff0000u);
            gt[2 * j] = __uint_as_float(gv[j] << 16); gt[2 * j + 1] = __uint_as_float(gv[j] & 0xffff0000u);
            ss += o[2 * j] * o[2 * j] + o[2 * j + 1] * o[2 * j + 1];
        }
        ss = sum16(ss);
        const float rstd = rsqrtf(ss * (1.f / 128.f) + 1e-6f);
        pg8::u32x4 wv;
        float y[8];
#pragma unroll
        for (int j = 0; j < 8; ++j) y[j] = o[j] * rstd * ng[d0 + j] * silu(gt[j]);
        wv.x = pack2(y[0], y[1]); wv.y = pack2(y[2], y[3]); wv.z = pack2(y[4], y[5]); wv.w = pack2(y[6], y[7]);
        *(pg8::u32x4*)(ym + (size_t)row * D + ocol + c0) = wv;
    }
}

DEV float2 cf_ld(const bf16_t* P, int row, int ch) { const unsigned v = *(const unsigned*)(P + (size_t)row * CDN + ch); return make_float2(__uint_as_float(v << 16), __uint_as_float(v & 0xffff0000u)); }
template <int NOUT, int STRIDE> DEV void cf_task(const bf16_t* P, const float* wl, float2 bias, int rowbase, int pos0, int len, int ch, float* tile, int tok0, int tokstep) {
    float2 x[NOUT + 30];
#pragma unroll
    for (int i = 0; i < NOUT + 30; ++i) {
        const int pp = pos0 - 15 + i;
        const bool ok = pp >= 0 && pp < len;
        x[i] = cf_ld(P, rowbase + (ok ? pp : pos0) * STRIDE, ch);
        x[i].x = ok ? x[i].x : 0.f; x[i].y = ok ? x[i].y : 0.f;
    }
    float2 acc[NOUT];
#pragma unroll
    for (int o = 0; o < NOUT; ++o) acc[o] = make_float2(0.f, 0.f);
#pragma unroll
    for (int j = 0; j < 31; ++j) {
        const float2 wv = *(const float2*)(wl + j * 512 + ch);
#pragma unroll
        for (int o = 0; o < NOUT; ++o) { acc[o].x += x[o + j].x * wv.x; acc[o].y += x[o + j].y * wv.y; }
    }
#pragma unroll
    for (int o = 0; o < NOUT; ++o) *(float2*)(tile + (tok0 + o * tokstep) * 516 + ch) = make_float2(acc[o].x + bias.x, acc[o].y + bias.y);
}
DEV void phase_conformer(const Params& p, int o, char* smem) {
    const int tid = TID(), lane = tid & 63, w = tid >> 6;
    float* tile = (float*)smem;
    const bf16_t* P = (const bf16_t*)(p.ws + OFF_P);
    bf16_t* ym = (bf16_t*)(p.ws + OFF_HN);
    const float* dw = p.in[PZ() + I_DWW] + (size_t)o * 31 * 512;
    const int pair = tid & 127, sub = tid >> 7, chW = 2 * pair, chV = 256 + 2 * pair;
    float* wl = tile + 32 * 516;
    __syncthreads();
    for (int i = tid; i < 31 * 512; i += 512) wl[i] = dw[i];
    const float2 bW = *(const float2*)(p.in[PZ() + I_DWB] + (size_t)o * 512 + chW), bV = *(const float2*)(p.in[PZ() + I_DWB] + (size_t)o * 512 + chV);
    for (int it = blockIdx.x; it < 1040; it += gridDim.x) {
        __syncthreads();
        int rowtok0, rowstep_r;
        if (it < 1024) {
            const int b = it >> 9, r0 = ((it >> 3) & 63) * 4, w0 = (it & 7) * 8;
            cf_task<8, 1>(P, wl, bW, b * SEQ + (r0 + sub) * 64, w0, 64, chW, tile, sub * 8, 1);
#pragma unroll
            for (int k = 0; k < 2; ++k) { const int ww = 2 * sub + k; cf_task<4, 64>(P, wl, bV, b * SEQ + w0 + ww, r0, 256, chV, tile, ww, 8); }
            rowtok0 = b * SEQ + r0 * 64 + w0; rowstep_r = 64;
        } else {
            const int ci = it - 1024, b = ci >> 3, t0 = (ci & 7) * 32;
            cf_task<8, 1>(P, wl, bW, NLAT + b * CTXL, t0 + sub * 8, CTXL, chW, tile, sub * 8, 1);
            cf_task<8, 1>(P, wl, bV, NLAT + b * CTXL, t0 + sub * 8, CTXL, chV, tile, sub * 8, 1);
            rowtok0 = NLAT + b * CTXL + t0; rowstep_r = 8;
        }
        __syncthreads();
        const float* lg = p.in[PZ() + I_LNG] + (size_t)o * 512 + lane * 8; const float* lbb = p.in[PZ() + I_LNB] + (size_t)o * 512 + lane * 8;
        for (int q = 0; q < 4; ++q) {
            const int tok = w * 4 + q, orow = rowtok0 + (tok >> 3) * rowstep_r + (tok & 7);
            const float4 v0 = *(const float4*)(tile + tok * 516 + lane * 8), v1 = *(const float4*)(tile + tok * 516 + lane * 8 + 4);
            float x[8] = {v0.x, v0.y, v0.z, v0.w, v1.x, v1.y, v1.z, v1.w};
            float s = 0.f;
#pragma unroll
            for (int j = 0; j < 8; ++j) s += x[j];
            const float mean = wave_sum(s) * (1.f / 512.f);
            float vs = 0.f;
#pragma unroll
            for (int j = 0; j < 8; ++j) { x[j] -= mean; vs += x[j] * x[j]; }
            const float rstd = rsqrtf(wave_sum(vs) * (1.f / 512.f) + 1e-6f);
            float y[8];
#pragma unroll
            for (int j = 0; j < 8; ++j) y[j] = silu(x[j] * rstd * lg[j] + lbb[j]);
            pg8::u32x4 wv; wv.x = pack2(y[0], y[1]); wv.y = pack2(y[2], y[3]); wv.z = pack2(y[4], y[5]); wv.w = pack2(y[6], y[7]);
            *(pg8::u32x4*)(ym + (size_t)orow * D + lane * 8) = wv;
        }
    }
}

DEV int hgrn_row(int b, int dir, int bc, int s) {
    if (bc == 0) return NLAT + b * CTXL + (dir ? 255 - s : s);
    const int lc = bc - 1, oc = dir ? 63 - lc : lc; return b * SEQ + oc * 256 + (dir ? 255 - s : s);
}
DEV void phase_h1(const Params& p, int o, char* smem, int skew) {
    const int tid = TID(), lane = tid & 63, w = tid >> 6, l15 = lane & 15, lq = lane >> 4;
    bf16_t* kT = (bf16_t*)smem; bf16_t* vT = kT + 128 * 264; float* seg = (float*)(vT + 128 * 264);
    const bf16_t* P = (const bf16_t*)(p.ws + OFF_P);
    float* dS = (float*)(p.ws + OFF_SCR + SCR_DS); float* Dd = (float*)(p.ws + OFF_SCR + SCR_DD);
    const float* lball = (const float*)(p.ws + OFF_LB) + (size_t)o * 512;
    const int d = tid & 127, tq = tid >> 7;
    for (int it = (int)((blockIdx.x + gridDim.x - skew % gridDim.x) % gridDim.x); it < 16 * NBC; it += gridDim.x) {
        const int chain = it / NBC, bc = it % NBC, dir = chain & 1, h = (chain >> 1) & 3, b = chain >> 3;
        const float lb = lball[h * 128 + d];
        const size_t cf = (size_t)1024 + 512 + dir * 512 + h * 128 + d, cv = (size_t)1024 + 1536 + h * 128 + d;
        lds_barrier();
        float sum = 0.f;
        for (int i8 = 0; i8 < 8; ++i8) {
            unsigned o8[4];
#pragma unroll
            for (int j2 = 0; j2 < 4; ++j2) {
                const size_t r0 = (size_t)hgrn_row(b, dir, bc, tq * 64 + i8 * 8 + 2 * j2) * CDN, r1 = (size_t)hgrn_row(b, dir, bc, tq * 64 + i8 * 8 + 2 * j2 + 1) * CDN;
                const float f0 = lb + (1.f - lb) * sigm(bf2f(P[r0 + cf])), f1 = lb + (1.f - lb) * sigm(bf2f(P[r1 + cf]));
                sum += __logf(f0) + __logf(f1);
                o8[j2] = (unsigned)P[r0 + cv] | ((unsigned)P[r1 + cv] << 16);
            }
            pg8::u32x4 wv; wv.x = o8[0]; wv.y = o8[1]; wv.z = o8[2]; wv.w = o8[3];
            *(pg8::u32x4*)(vT + d * 264 + tq * 64 + i8 * 8) = wv;
        }
        seg[tq * 128 + d] = sum;
        lds_barrier();
        float r = 0.f;
        for (int q = tq + 1; q < 4; ++q) r += seg[q * 128 + d];
        for (int i8 = 7; i8 >= 0; --i8) {
            float ko[8];
#pragma unroll
            for (int j = 7; j >= 0; --j) {
                const size_t r0 = (size_t)hgrn_row(b, dir, bc, tq * 64 + i8 * 8 + j) * CDN;
                const float f = lb + (1.f - lb) * sigm(bf2f(P[r0 + cf]));
                ko[j] = (1.f - f) * __expf(r); r += __logf(f);
            }
            pg8::u32x4 wv; wv.x = pack2(ko[0], ko[1]); wv.y = pack2(ko[2], ko[3]); wv.z = pack2(ko[4], ko[5]); wv.w = pack2(ko[6], ko[7]);
            *(pg8::u32x4*)(kT + d * 264 + tq * 64 + i8 * 8) = wv;
        }
        if (tq == 0) Dd[(size_t)it * 128 + d] = __expf(seg[d] + seg[128 + d] + seg[256 + d] + seg[384 + d]);
        lds_barrier();
        s16x8 af[8];
#pragma unroll
        for (int kq = 0; kq < 8; ++kq) af[kq] = *(const s16x8*)(vT + (16 * w + l15) * 264 + 32 * kq + 8 * lq);
        for (int ni = 0; ni < 8; ++ni) {
            f32x4 acc = {0.f, 0.f, 0.f, 0.f};
#pragma unroll
            for (int kq = 0; kq < 8; ++kq) { const s16x8 bb = *(const s16x8*)(kT + (16 * ni + l15) * 264 + 32 * kq + 8 * lq); acc = __builtin_amdgcn_mfma_f32_16x16x32_bf16(af[kq], bb, acc, 0, 0, 0); }
#pragma unroll
            for (int j = 0; j < 4; ++j) dS[(size_t)it * 16384 + (16 * w + 4 * lq + j) * 128 + 16 * ni + l15] = acc[j];
        }
    }
}
DEV void phase_h2(const Params& p) {
    float* dS = (float*)(p.ws + OFF_SCR + SCR_DS); const float* Dd = (const float*)(p.ws + OFF_SCR + SCR_DD);
    for (int idx = ((int)blockIdx.x + PZ()) * 512 + TID(); idx < 16 * 16384; idx += gridDim.x * 512) {
        const int chain = idx >> 14, de = idx & 16383, d = de & 127;
        float* base = dS + (size_t)chain * NBC * 16384 + de; const float* db = Dd + (size_t)chain * NBC * 128 + d;
        float S = 0.f;
#pragma unroll
        for (int b0 = 0; b0 < NBC; b0 += 22) {
            float t[22], dv[22];
#pragma unroll
            for (int q = 0; q < 22; ++q) { const int bc = b0 + q < NBC ? b0 + q : NBC - 1; t[q] = base[(size_t)bc * 16384]; dv[q] = db[bc * 128]; }
#pragma unroll
            for (int q = 0; q < 22; ++q) if (b0 + q < NBC) { base[(size_t)(b0 + q) * 16384] = S; S = dv[q] * S + t[q]; }
        }
    }
}
DEV void phase_h3(const Params& p, int o, char* smem, bool skipctx) {
    const int tid = TID(), lane = tid & 63, w = tid >> 6, l15 = lane & 15, lq = lane >> 4;
    bf16_t* STb = (bf16_t*)smem; bf16_t* qin = STb + 128 * 136; bf16_t* kin = qin + 32 * 136; bf16_t* koT = kin + 32 * 136; bf16_t* vT = koT + 128 * 40; bf16_t* att = vT + 128 * 40;
    float* seg = (float*)(att + 32 * 40); float* cdv = seg + 512;
    const bf16_t* P = (const bf16_t*)(p.ws + OFF_P);
    const float* dS = (const float*)(p.ws + OFF_SCR + SCR_DS);
    bf16_t* ob = (bf16_t*)p.out;
    const float* lball = (const float*)(p.ws + OFF_LB) + (size_t)o * 512;
    const int d = tid & 127, tq = tid >> 7;
    const int nitems = skipctx ? 16 * (NBC - 1) : 16 * NBC;
    for (int it0 = blockIdx.x; it0 < nitems; it0 += gridDim.x) {
        const int chain = skipctx ? it0 / (NBC - 1) : it0 / NBC, bc = skipctx ? 1 + it0 % (NBC - 1) : it0 % NBC, it = chain * NBC + bc;
        const int dir = chain & 1, h = (chain >> 1) & 3, b = chain >> 3;
        const float lb = lball[h * 128 + d];
        f32x4 Sacc[8];
#pragma unroll
        for (int ni = 0; ni < 8; ++ni)
#pragma unroll
            for (int j = 0; j < 4; ++j) Sacc[ni][j] = dS[(size_t)it * 16384 + (16 * w + 4 * lq + j) * 128 + 16 * ni + l15];
        lds_barrier();
#pragma unroll
        for (int ni = 0; ni < 8; ++ni)
#pragma unroll
            for (int j = 0; j < 4; ++j) STb[(16 * w + 4 * lq + j) * 136 + 16 * ni + l15] = f2bf(Sacc[ni][j]);
        unsigned rf[8], rq[8], rv[8];
        auto fetch = [&](int sub) {
#pragma unroll
            for (int i = 0; i < 8; ++i) {
                const size_t rb = (size_t)hgrn_row(b, dir, bc, sub * 32 + tq * 8 + i) * CDN + 1024 + h * 128 + d;
                rf[i] = P[rb + 512 + dir * 512]; rq[i] = P[rb]; rv[i] = P[rb + 1536];
            }
        };
        fetch(0);
        for (int sub = 0; sub < 8; ++sub) {
            float f[8], c[8]; float run = 0.f;
#pragma unroll
            for (int i = 0; i < 8; ++i) { f[i] = lb + (1.f - lb) * sigm(__uint_as_float(rf[i] << 16)); run += __logf(f[i]); c[i] = run; }
            seg[tq * 128 + d] = run;
            { pg8::u32x4 wv; wv.x = rv[0] | (rv[1] << 16); wv.y = rv[2] | (rv[3] << 16); wv.z = rv[4] | (rv[5] << 16); wv.w = rv[6] | (rv[7] << 16); *(pg8::u32x4*)(vT + d * 40 + tq * 8) = wv; }
            lds_barrier();
            float pre = 0.f, tot = 0.f;
#pragma unroll
            for (int q = 0; q < 4; ++q) { const float sv = seg[q * 128 + d]; tot += sv; if (q < tq) pre += sv; }
            float ko[8];
#pragma unroll
            for (int i = 0; i < 8; ++i) {
                const float bcv = pre + c[i], eb = __expf(bcv), ieb = __expf(-bcv), k1 = 1.f - f[i];
                qin[(tq * 8 + i) * 136 + d] = f2bf(__uint_as_float(rq[i] << 16) * eb);
                kin[(tq * 8 + i) * 136 + d] = f2bf(k1 * ieb);
                ko[i] = k1 * __expf(tot - bcv);
            }
            { pg8::u32x4 wv; wv.x = pack2(ko[0], ko[1]); wv.y = pack2(ko[2], ko[3]); wv.z = pack2(ko[4], ko[5]); wv.w = pack2(ko[6], ko[7]); *(pg8::u32x4*)(koT + d * 40 + tq * 8) = wv; }
            if (tq == 0) cdv[d] = __expf(tot);
            fetch(sub + 1 < 8 ? sub + 1 : 7);
            lds_barrier();
            f32x4 oacc[2] = {{0.f, 0.f, 0.f, 0.f}, {0.f, 0.f, 0.f, 0.f}};
#pragma unroll
            for (int kq = 0; kq < 4; ++kq) {
                const s16x8 bb = *(const s16x8*)(STb + (16 * w + l15) * 136 + 32 * kq + 8 * lq);
#pragma unroll
                for (int mi = 0; mi < 2; ++mi) { const s16x8 a = *(const s16x8*)(qin + (16 * mi + l15) * 136 + 32 * kq + 8 * lq); oacc[mi] = __builtin_amdgcn_mfma_f32_16x16x32_bf16(a, bb, oacc[mi], 0, 0, 0); }
            }
            if (w < 4) {
                const int mi = w >> 1, nj = w & 1;
                f32x4 at = {0.f, 0.f, 0.f, 0.f};
                if (!(mi == 0 && nj == 1)) {
#pragma unroll
                    for (int kq = 0; kq < 4; ++kq) {
                        const s16x8 a = *(const s16x8*)(qin + (16 * mi + l15) * 136 + 32 * kq + 8 * lq), bb = *(const s16x8*)(kin + (16 * nj + l15) * 136 + 32 * kq + 8 * lq);
                        at = __builtin_amdgcn_mfma_f32_16x16x32_bf16(a, bb, at, 0, 0, 0);
                    }
                }
#pragma unroll
                for (int jj = 0; jj < 4; ++jj) { const int t = 16 * mi + 4 * lq + jj, j = 16 * nj + l15; att[t * 40 + j] = f2bf(j <= t ? at[jj] : 0.f); }
            }
            lds_barrier();
            const s16x8 vb = *(const s16x8*)(vT + (16 * w + l15) * 40 + 8 * lq);
#pragma unroll
            for (int mi = 0; mi < 2; ++mi) {
                const s16x8 a = *(const s16x8*)(att + (16 * mi + l15) * 40 + 8 * lq);
                oacc[mi] = __builtin_amdgcn_mfma_f32_16x16x32_bf16(a, vb, oacc[mi], 0, 0, 0);
#pragma unroll
                for (int jj = 0; jj < 4; ++jj)
                    ob[((size_t)dir * NTOK + hgrn_row(b, dir, bc, sub * 32 + 16 * mi + 4 * lq + jj)) * 512 + h * 128 + 16 * w + l15] = f2bf(oacc[mi][jj]);
            }
#pragma unroll
            for (int ni = 0; ni < 8; ++ni) {
                const float cd = cdv[16 * ni + l15];
#pragma unroll
                for (int j = 0; j < 4; ++j) Sacc[ni][j] *= cd;
                const s16x8 bb = *(const s16x8*)(koT + (16 * ni + l15) * 40 + 8 * lq);
                Sacc[ni] = __builtin_amdgcn_mfma_f32_16x16x32_bf16(vb, bb, Sacc[ni], 0, 0, 0);
#pragma unroll
                for (int j = 0; j < 4; ++j) STb[(16 * w + 4 * lq + j) * 136 + 16 * ni + l15] = f2bf(Sacc[ni][j]);
            }
            lds_barrier();
        }
    }
}

#define XB_TMO      128
#define XB_XCNT(j)  (256  + 64 * (j))
#define XB_XSUB(j)  (1280 + 64 * (j))
#define XB_XGEN(j)  (2304 + 64 * (j))
#define XB_TOP      3328
#define XB_TOPGEN   3392
#define XCD_BAR_WORDS 3456
#define XB_SPIN_CAP (1u << 18)
#define XLAS __attribute__((address_space(3)))
__device__ __forceinline__ unsigned xb_ld(unsigned* p)              { return __hip_atomic_load(p, __ATOMIC_RELAXED, __HIP_MEMORY_SCOPE_AGENT); }
__device__ __forceinline__ unsigned xb_add(unsigned* p, unsigned v) { return __hip_atomic_fetch_add(p, v, __ATOMIC_RELAXED, __HIP_MEMORY_SCOPE_AGENT); }
__device__ __forceinline__ unsigned xb_xcc_id() { return (unsigned)__builtin_amdgcn_s_getreg((3 << 11) | 20) & 0xFu; }
#define XB_SPIN(cond, bar) do { unsigned _sp = 0; while (cond) { __builtin_amdgcn_s_sleep(1); \
    if ((++_sp & 255u) == 0u) { if (xb_ld(&(bar)[XB_TMO])) break; if (_sp > XB_SPIN_CAP) { atomicAdd(&(bar)[XB_TMO], 1u); break; } } } } while (0)

struct XcdBarrier {
    unsigned* bar; unsigned x;
    volatile XLAS unsigned* st;
};

__device__ __forceinline__ XcdBarrier xcd_barrier_post(unsigned* bar, volatile XLAS unsigned* st) {
    XcdBarrier b; b.bar = bar; b.x = xb_xcc_id(); b.st = st;
    if (threadIdx.x == 0) (void)xb_add(&bar[XB_XCNT(b.x)], 1u);
    return b;
}
__device__ __forceinline__ void xcd_barrier_complete(unsigned* bar, unsigned x, unsigned& nloc, unsigned& nx) {
    const unsigned G = gridDim.x * gridDim.y * gridDim.z;
    unsigned sum, cnt, mine, sp = 0u;
    for (;;) {
        sum = 0u; cnt = 0u; mine = 0u;
#pragma unroll
        for (unsigned j = 0; j < 16; ++j) { const unsigned c = xb_ld(&bar[XB_XCNT(j)]); sum += c; cnt += (c > 0u) ? 1u : 0u; mine = (j == x) ? c : mine; }
        if (sum == G) break;
        __builtin_amdgcn_s_sleep(1);
        if ((++sp & 255u) == 0u) { if (xb_ld(&bar[XB_TMO])) break; if (sp > XB_SPIN_CAP) { atomicAdd(&bar[XB_TMO], 1u); break; } }
    }
    nloc = mine > 0u ? mine : 1u; nx = cnt > 0u ? cnt : 1u;
}

__device__ __forceinline__ void xcd_barrier(const XcdBarrier& b) {
    asm volatile("s_waitcnt vmcnt(0)" ::: "memory");
    __syncthreads();
    if (threadIdx.x == 0) {
        unsigned* bar = b.bar;
        __builtin_amdgcn_s_waitcnt(0);
        unsigned nloc = b.st[0], nx = b.st[1];
        if (nloc == 0u) { xcd_barrier_complete(bar, b.x, nloc, nx); b.st[0] = nloc; b.st[1] = nx; }
        const unsigned old = xb_add(&bar[XB_XSUB(b.x)], 1u);
        const unsigned gen = old / nloc;
        if (old + 1u == (gen + 1u) * nloc) {
            __builtin_amdgcn_fence(__ATOMIC_RELEASE, "agent");
            asm volatile("s_waitcnt vmcnt(0)" ::: "memory");
            const unsigned og = xb_add(&bar[XB_TOP], 1u);
            const unsigned tg = og / nx;
            if (og + 1u == (tg + 1u) * nx) xb_add(&bar[XB_TOPGEN], 1u);
            else XB_SPIN(xb_ld(&bar[XB_TOPGEN]) == tg, bar);
            __builtin_amdgcn_fence(__ATOMIC_ACQUIRE, "agent");
            xb_add(&bar[XB_XGEN(b.x)], 1u);
            asm volatile("s_waitcnt vmcnt(0)" ::: "memory");
        } else {
            XB_SPIN(xb_ld(&bar[XB_XGEN(b.x)]) == gen, bar);
            __builtin_amdgcn_fence(__ATOMIC_ACQUIRE, "agent");
            asm volatile("s_waitcnt vmcnt(0)" ::: "memory");
        }
    }
    __syncthreads();
}


__device__ __forceinline__ void sub_arrive_wait(unsigned* cnt, unsigned target, bool wait) {
    asm volatile("s_waitcnt vmcnt(0)" ::: "memory");
    __syncthreads();
    if (threadIdx.x == 0) {
        __builtin_amdgcn_fence(__ATOMIC_RELEASE, "agent");
        asm volatile("s_waitcnt vmcnt(0)" ::: "memory");
        (void)xb_add(cnt, 1u);
        if (wait) {
            unsigned sp = 0u;
            while (xb_ld(cnt) < target) { __builtin_amdgcn_s_sleep(2); if (++sp > (1u << 22)) break; }
            __builtin_amdgcn_fence(__ATOMIC_ACQUIRE, "agent");
            asm volatile("s_waitcnt vmcnt(0)" ::: "memory");
        }
    }
    __syncthreads();
}

constexpr int LDS_BYTES = 155648;

template <class Epi> DEV void run_gemm(char* smem, const bf16_t* A, const bf16_t* Bt, int N, int K, const Epi& E, int M = NTOK) {
    pg8::Gemm g{A, Bt, M, N, K};
    pg8::StaticOrder S; S.init(M, N, (int)gridDim.x, (int)blockIdx.x);
    pg8::gemm_phase<Epi, pg8::StaticOrder, false>((PG8_LAS unsigned char*)smem, g, S, E, nullptr);
}


DEV void ctx_res_gemm(const Params& p, const bf16_t* A, const bf16_t* Wt, int K, const float* gate, float scale) {
    const int tid = TID(), lane = tid & 63, w = tid >> 6, l15 = lane & 15, lq = lane >> 4;
    const int rt = blockIdx.x >> 4, ct = blockIdx.x & 15;
    const int row0 = NLAT + rt * 32 + (w >> 2) * 16, col0 = ct * 64 + (w & 3) * 16;
    const bf16_t* ap = A + (size_t)(row0 + l15) * K + 8 * lq;
    const bf16_t* bp = Wt + (size_t)(col0 + l15) * K + 8 * lq;
    f32x4 acc0 = {0.f, 0.f, 0.f, 0.f}, acc1 = {0.f, 0.f, 0.f, 0.f};
    for (int k0 = 0; k0 < K; k0 += 256) {
        s16x8 a[8], bq[8];
#pragma unroll
        for (int q = 0; q < 8; ++q) { a[q] = *(const s16x8*)(ap + k0 + 32 * q); bq[q] = *(const s16x8*)(bp + k0 + 32 * q); }
#pragma unroll
        for (int q = 0; q < 8; q += 2) {
            acc0 = __builtin_amdgcn_mfma_f32_16x16x32_bf16(a[q], bq[q], acc0, 0, 0, 0);
            acc1 = __builtin_amdgcn_mfma_f32_16x16x32_bf16(a[q + 1], bq[q + 1], acc1, 0, 0, 0);
        }
    }
    float* H = (float*)(p.ws + OFF_H);
    const float gv = gate[(size_t)2 * MODW + col0 + l15] * scale;
#pragma unroll
    for (int j = 0; j < 4; ++j) { float* q = H + (size_t)(row0 + 4 * lq + j) * D + col0 + l15; *q = *q + gv * (acc0[j] + acc1[j]); }
}


DEV void run_step(const Params& p, int st, char* smem) {
    const int type = st & 255, l = (st >> 8) & 255, f = st >> 16, eo = l >> 1;
    char* ws = p.ws;
    const float* mod = (const float*)(ws + OFF_MOD) + (size_t)l * 3 * MODW;
#ifdef ONLY
    if (type != ONLY) return;
#endif
    switch (type) {
    case PH_INIT: phase_init(p, smem); break;
    case PH_NORM: phase_norm(p, l, f); break;
    case PH_UP: { EpiUp E{(bf16_t*)(ws + OFF_P)}; run_gemm(smem, (const bf16_t*)(ws + OFF_HN), (const bf16_t*)(ws + OFF_WUP + (size_t)(l * 2 + f) * SZ_WUP), 2 * FFN, D, E, (l == 3 && f == 1) ? NLAT : NTOK); } break;
    case PH_DOWN: { EpiRes E{(float*)(ws + OFF_H), mod + ((f ? 2 : 0) * 3 + 2) * D, 0.5f}; run_gemm(smem, (const bf16_t*)(ws + OFF_P), (const bf16_t*)(ws + OFF_WDN + (size_t)(l * 2 + f) * SZ_WDN), D, FFN, E, ((l == 3 && f == 1) || gridDim.x == 256) ? NLAT : NTOK);
        if (gridDim.x == 256 && !(l == 3 && f == 1)) ctx_res_gemm(p, (const bf16_t*)(ws + OFF_P), (const bf16_t*)(ws + OFF_WDN + (size_t)(l * 2 + f) * SZ_WDN), FFN, mod + ((f ? 2 : 0) * 3 + 2) * D, 0.5f);
        if (f == 1 && l < 3 && gridDim.x < 256) { __syncthreads(); convert_layer(p, l + 1, (float*)smem, (int)blockIdx.x, (int)gridDim.x); }
    } break;
    case PH_ABIN: { EpiP E{(bf16_t*)(ws + OFF_P), ABN}; run_gemm(smem, (const bf16_t*)(ws + OFF_HN), (const bf16_t*)(ws + OFF_WABIN + (size_t)eo * ABN * D * 2), ABN, D, E); } break;
    case PH_CDIN: { EpiPG E{(bf16_t*)(ws + OFF_P), CDN}; run_gemm(smem, (const bf16_t*)(ws + OFF_HN), (const bf16_t*)(ws + OFF_WCDIN + (size_t)eo * CDN * D * 2), CDN, D, E); } break;
    case PH_OUT: { EpiRes E{(float*)(ws + OFF_H), mod + (1 * 3 + 2) * D, 1.0f};
        const bf16_t* W = (const bf16_t*)(ws + ((l & 1) ? OFF_WCDOUT : OFF_WABOUT) + (size_t)eo * D * D * 2);
        run_gemm(smem, (const bf16_t*)(ws + OFF_HN), W, D, D, E, (l == 3 || gridDim.x == 256) ? NLAT : NTOK);
        if (gridDim.x == 256 && l != 3) ctx_res_gemm(p, (const bf16_t*)(ws + OFF_HN), W, D, mod + (1 * 3 + 2) * D, 1.0f); } break;
    case PH_S2: phase_s2(p, eo, (int)blockIdx.x); break;
    case PH_S3: phase_s3(p, eo, smem); break;
    case PH_GLU: { EpiGlu E{(const bf16_t*)(ws + OFF_SCR + SCR_YB), p.in[PZ() + I_GLUB] + (size_t)eo * 512, (bf16_t*)(ws + OFF_HN)};
        run_gemm(smem, (const bf16_t*)(ws + OFF_SCR + SCR_YB), (const bf16_t*)(ws + OFF_WGLU + (size_t)eo * 512 * 512 * 2), 512, 512, E); }
        [[fallthrough]];
    case PH_G3: phase_combine(p, (const bf16_t*)(ws + OFF_P), ABN, 1536, p.in[PZ() + I_GNG] + (size_t)eo * 128, 0, (int)blockIdx.x, (int)gridDim.x); break;
    case PH_G1: phase_g1(p, eo, smem); break;
    case PH_G2:
        if (gridDim.x >= 256) {
            if (blockIdx.x < 128) phase_g2(p, eo, smem);
            else {
                phase_s1(p, eo, smem, (int)blockIdx.x - 128, (int)gridDim.x - 128);
                const bool scan = blockIdx.x - 128 < 16;
                sub_arrive_wait((unsigned*)(ws + OFF_BAR) + 3520 + 64 * eo, gridDim.x - 128, scan);
                if (scan) phase_s2(p, eo, (int)blockIdx.x - 128);
                else {
                    __syncthreads();
                    convert_layer(p, l + 1, (float*)smem, (int)blockIdx.x - 144, (int)gridDim.x - 144);
                    if (l == 0) { __syncthreads(); convert_layer(p, 2, (float*)smem, (int)blockIdx.x - 144, (int)gridDim.x - 144); }
                }
            }
        }
        else { phase_g2(p, eo, smem); phase_s1(p, eo, smem, (int)blockIdx.x, (int)gridDim.x); }
        break;
    case PH_CH1: phase_conformer(p, eo, smem); phase_h1(p, eo, smem, 1040); break;
    case PH_H2: phase_h2(p); break;
    case PH_H3: phase_h3(p, eo, smem, l == 3); break;
    case PH_H4: phase_combine(p, (const bf16_t*)(ws + OFF_P), CDN, 1024 + 2048, p.in[PZ() + I_HNG] + (size_t)eo * 128, 512, (int)blockIdx.x, (int)gridDim.x); break;
    case PH_FINAL: phase_final(p); break;
    default: break;
    }
}

#ifndef MK_MULTI
__global__ __launch_bounds__(512, 2) void mega_kernel(Params p) {
    extern __shared__ __attribute__((aligned(16))) char smem[];
    cg::grid_group grid = cg::this_grid();
    volatile XLAS unsigned* st = (volatile XLAS unsigned*)(smem + LDS_BYTES - 16);
    if (threadIdx.x < 2) st[threadIdx.x] = 0u;
    __syncthreads();
    const XcdBarrier xb = xcd_barrier_post((unsigned*)(p.ws + OFF_BAR), st);
    for (int si = 0; si < p.nsteps; ++si) {
        run_step(p, p.steps[si], smem);
        if (si + 1 < p.nsteps) { if (p.nsteps < 0) grid.sync(); else xcd_barrier(xb); }
    }
}
#else
__global__ __launch_bounds__(512, 2) void step_kernel(Params p, int si) {
    extern __shared__ __attribute__((aligned(16))) char smem[];
    run_step(p, p.steps[si], smem);
}
#endif

extern "C" void kernel_launch(void* const* d_in, const int* in_sizes, int n_in, void* d_out, int out_size, void* d_ws, size_t ws_size, hipStream_t stream) {
    (void)in_sizes; (void)out_size;
    if (n_in < 34 || ws_size < WS_NEED) { fprintf(stderr, "kernel_launch: unexpected inputs (n_in %d, ws %zu < %zu)\n", n_in, ws_size, (size_t)WS_NEED); return; }
    Params p; memset(&p, 0, sizeof(p));
    for (int i = 0; i < 34; ++i) p.in[i] = (const float*)d_in[i];
    p.out = (float*)d_out; p.ws = (char*)d_ws;
#ifndef MK_MULTI
    static int grid_blocks = 0;
    if (!grid_blocks) {
        int dev = 0, cus = 0, per_cu = 0;
        (void)hipGetDevice(&dev);
        (void)hipDeviceGetAttribute(&cus, hipDeviceAttributeMultiprocessorCount, dev);
        (void)hipFuncSetAttribute((const void*)mega_kernel, hipFuncAttributeMaxDynamicSharedMemorySize, LDS_BYTES);
        (void)hipOccupancyMaxActiveBlocksPerMultiprocessor(&per_cu, mega_kernel, 512, LDS_BYTES);
        if (per_cu < 1) per_cu = 1;
        grid_blocks = cus * per_cu;
    }
    int n = 0;
#ifndef DUPMASK
#define DUPMASK 0u
#endif
    auto add = [&](int type, int l, int f) { p.steps[n++] = type | (l << 8) | (f << 16); if ((DUPMASK >> type) & 1u) p.steps[n++] = type | (l << 8) | (f << 16); };
    add(PH_INIT, 0, 0);
    for (int l = 0; l < 4; ++l) {
        add(PH_NORM, l, 0); add(PH_UP, l, 0); add(PH_DOWN, l, 0); add(PH_NORM, l, 1);
        if ((l & 1) == 0) { add(PH_ABIN, l, 0); add(PH_G1, l, 0); add(PH_G2, l, 0); if (grid_blocks < 256) add(PH_S2, l, 0); add(PH_S3, l, 0); add(PH_GLU, l, 0); }
        else { add(PH_CDIN, l, 0); add(PH_CH1, l, 0); add(PH_H2, l, 0); add(PH_H3, l, 0); add(PH_H4, l, 0); }
        add(PH_OUT, l, 0); add(PH_NORM, l, 2); add(PH_UP, l, 1); add(PH_DOWN, l, 1);
    }
    add(PH_FINAL, 0, 0);
    p.nsteps = n;
    (void)hipMemsetAsync((char*)d_ws + OFF_BAR, 0, 16384, stream);
    void* args[] = {&p};
    hipError_t e = hipLaunchCooperativeKernel((const void*)mega_kernel, dim3(grid_blocks), dim3(512), args, LDS_BYTES, stream);
    if (e != hipSuccess) fprintf(stderr, "cooperative launch failed: %s (grid %d)\n", hipGetErrorString(e), grid_blocks);
#else
    const int grid_blocks = 0;
    int n = 0;
#ifndef DUPMASK
#define DUPMASK 0u
#endif
    auto add = [&](int type, int l, int f) { p.steps[n++] = type | (l << 8) | (f << 16); if ((DUPMASK >> type) & 1u) p.steps[n++] = type | (l << 8) | (f << 16); };
    add(PH_INIT, 0, 0);
    for (int l = 0; l < 4; ++l) {
        add(PH_NORM, l, 0); add(PH_UP, l, 0); add(PH_DOWN, l, 0); add(PH_NORM, l, 1);
        if ((l & 1) == 0) { add(PH_ABIN, l, 0); add(PH_G1, l, 0); add(PH_G2, l, 0); if (grid_blocks < 256) add(PH_S2, l, 0); add(PH_S3, l, 0); add(PH_GLU, l, 0); }
        else { add(PH_CDIN, l, 0); add(PH_CH1, l, 0); add(PH_H2, l, 0); add(PH_H3, l, 0); add(PH_H4, l, 0); }
        add(PH_OUT, l, 0); add(PH_NORM, l, 2); add(PH_UP, l, 1); add(PH_DOWN, l, 1);
    }
    add(PH_FINAL, 0, 0);
    p.nsteps = n;
    static int inited = 0;
    if (!inited) { (void)hipFuncSetAttribute((const void*)step_kernel, hipFuncAttributeMaxDynamicSharedMemorySize, LDS_BYTES); inited = 1; }
    for (int si = 0; si < n; ++si) step_kernel<<<256, 512, LDS_BYTES, stream>>>(p, si);
#endif
}
```
